# Optimizing an MI355X kernel written in HIP

```python
import jax, jax.numpy as jnp
from jax import lax
import numpy as np

D_MODEL = 1024
BATCH = 4
SEQ = 4096
DEPTH = 2

CTX_LEN = 256
GRID_W = 64
HEAD_DIM = 64
ROPE_BASE = 10000.0
BLOCK = 128
A_HEADS = 8
A_KV = 2
WINDOW = 128
B_HEADS = 8
B_KV = 2
LRU_WIDTH = D_MODEL
LRU_BLOCKS = 16
LRU_BLOCK_DIM = LRU_WIDTH // LRU_BLOCKS
CONV_W = 4
LRU_C = 8.0
D_FF = 4 * D_MODEL
N_BRANCH = 3
ALPHA = (2 * DEPTH) ** 0.25
BETA = (8 * DEPTH) ** -0.25
LN_EPS = 1e-5
RMS_EPS = 1e-6
NEG_INF = -1e30
IN_COLS = (A_HEADS + 2 * A_KV + B_HEADS + 2 * B_KV) * HEAD_DIM + 2 * LRU_WIDTH + N_BRANCH * D_MODEL

kernel_name = "hybrid_parallel_gated_dit_block"


def _split_cols(z):
    sizes = (A_HEADS * HEAD_DIM, A_KV * HEAD_DIM, A_KV * HEAD_DIM,
             B_HEADS * HEAD_DIM, B_KV * HEAD_DIM, B_KV * HEAD_DIM,
             LRU_WIDTH, LRU_WIDTH, N_BRANCH * D_MODEL)
    return jnp.split(z, np.cumsum(sizes)[:-1].tolist(), axis=-1)


def _layernorm(x, g, b):
    xf = x.astype(jnp.float32)
    mu = jnp.mean(xf, -1, keepdims=True)
    xc = xf - mu
    var = jnp.mean(xc * xc, -1, keepdims=True)
    return (xc * lax.rsqrt(var + LN_EPS) * g + b).astype(x.dtype)


def _rmsnorm(x, g):
    xf = x.astype(jnp.float32)
    return (xf * lax.rsqrt(jnp.mean(xf * xf, -1, keepdims=True) + RMS_EPS) * g).astype(x.dtype)


def _axial_rope_tables(rows):
    row = jnp.repeat(jnp.arange(rows), GRID_W).astype(jnp.float32)
    col = jnp.tile(jnp.arange(GRID_W), rows).astype(jnp.float32)
    nf = HEAD_DIM // 4
    inv = ROPE_BASE ** (-jnp.arange(nf, dtype=jnp.float32) / nf)
    ang_r = row[:, None] * inv
    ang_c = col[:, None] * inv
    return (jnp.cos(ang_r), jnp.sin(ang_r), jnp.cos(ang_c), jnp.sin(ang_c))


def _rotate(x, cos, sin):
    x1, x2 = jnp.split(x, 2, axis=-1)
    return jnp.concatenate([x1 * cos - x2 * sin, x1 * sin + x2 * cos], axis=-1)


def _axial_rope(x, tabs):
    cr, sr, cc, sc = tabs
    half = HEAD_DIM // 2
    xr = _rotate(x[..., :half], cr[:, None, :], sr[:, None, :])
    xcol = _rotate(x[..., half:], cc[:, None, :], sc[:, None, :])
    return jnp.concatenate([xr, xcol], axis=-1).astype(x.dtype)


def _gqa_attend(q, k, v, sink, mask):
    s = jnp.einsum('bqkgd,bjkd->bkgqj', q, k).astype(jnp.float32) * (HEAD_DIM ** -0.5)
    if mask is not None:
        s = jnp.where(mask, s, NEG_INF)
    m = jnp.max(s, -1, keepdims=True)
    if sink is not None:
        sk = sink.astype(jnp.float32)[None, :, :, None, None]
        m = jnp.maximum(m, sk)
    p = jnp.exp(s - m)
    den = jnp.sum(p, -1, keepdims=True)
    if sink is not None:
        den = den + jnp.exp(sk - m)
    o = jnp.einsum('bkgqj,bjkd->bkgqd', p, v.astype(jnp.float32)) / den
    return o.transpose(0, 3, 1, 2, 4).astype(q.dtype)


def _banded_attention(q, k, v, k_ctx, v_ctx, sink):
    bsz, n = q.shape[:2]
    nb = n // BLOCK
    m = k_ctx.shape[1]
    qb = q.reshape(bsz, nb, BLOCK, *q.shape[2:])

    def band(t):
        tp = jnp.pad(t, ((0, 0), (BLOCK, BLOCK), (0, 0), (0, 0))).reshape(bsz, nb + 2, BLOCK, *t.shape[2:])
        return jnp.concatenate([tp[:, :-2], tp[:, 1:-1], tp[:, 2:]], axis=2)

    kb = jnp.concatenate([band(k), jnp.broadcast_to(k_ctx[:, None], (bsz, nb) + k_ctx.shape[1:])], axis=2)
    vb = jnp.concatenate([band(v), jnp.broadcast_to(v_ctx[:, None], (bsz, nb) + v_ctx.shape[1:])], axis=2)
    blk = jnp.arange(nb)[:, None, None]
    qpos = blk * BLOCK + jnp.arange(BLOCK)[None, :, None]
    kpos = blk * BLOCK - BLOCK + jnp.arange(3 * BLOCK)[None, None, :]
    lat_mask = (jnp.abs(kpos - qpos) <= WINDOW) & (kpos >= 0) & (kpos < n)
    mask = jnp.concatenate([lat_mask, jnp.ones((nb, BLOCK, m), dtype=bool)], axis=-1)
    o = jax.vmap(_gqa_attend, in_axes=(1, 1, 1, None, 0), out_axes=1)(qb, kb, vb, sink, mask)
    return o.reshape(bsz, n, -1)


def _blocked_global_attention(q, k_all, v_all):
    bsz, n = q.shape[:2]
    nb = n // BLOCK
    qb = jnp.moveaxis(q.reshape(bsz, nb, BLOCK, *q.shape[2:]), 1, 0)
    o = lax.map(lambda qq: _gqa_attend(qq, k_all, v_all, None, None), qb)
    return jnp.moveaxis(o, 0, 1).reshape(bsz, n, -1)


def _short_conv(x, w, b):
    out = lax.conv_general_dilated(x, w[:, None, :], window_strides=(1,),
                                   padding=[((CONV_W - 1) // 2, CONV_W // 2)],
                                   dimension_numbers=('NWC', 'WIO', 'NWC'),
                                   feature_group_count=x.shape[-1])
    return out + b


def _rglru_gates(x, w_r, b_r, w_i, b_i, lam):
    bsz, n, _ = x.shape
    xb = x.reshape(bsz, n, LRU_BLOCKS, LRU_BLOCK_DIM)
    r = jax.nn.sigmoid(jnp.einsum('bnhd,hde->bnhe', xb, w_r).reshape(bsz, n, LRU_WIDTH) + b_r)
    i = jax.nn.sigmoid(jnp.einsum('bnhd,hde->bnhe', xb, w_i).reshape(bsz, n, LRU_WIDTH) + b_i)
    log_a = -LRU_C * r * jax.nn.softplus(-lam.astype(jnp.float32))
    a = jnp.exp(log_a)
    u = jnp.sqrt(-jnp.expm1(2.0 * log_a)) * (i * x)
    return a, u


def _linear_scan(a, u, h0):
    u = u.at[:, 0].add(a[:, 0] * h0)

    def combine(left, right):
        return left[0] * right[0], right[0] * left[1] + right[1]

    return lax.associative_scan(combine, (a, u), axis=1)[1]


def _rglru_direction(x_ctx, x_lat, w_r, b_r, w_i, b_i, lam, reverse):
    flip = (lambda t: jnp.flip(t, 1)) if reverse else (lambda t: t)
    a_c, u_c = _rglru_gates(x_ctx, w_r, b_r, w_i, b_i, lam)
    h_c = _linear_scan(flip(a_c), flip(u_c), jnp.zeros_like(x_ctx[:, 0]))
    a_l, u_l = _rglru_gates(x_lat, w_r, b_r, w_i, b_i, lam)
    h_l = _linear_scan(flip(a_l), flip(u_l), h_c[:, -1])
    return flip(h_c), flip(h_l)


def _merge(ya, yb, yc, g, w_br_a, w_br_b, w_br_c, w_out):
    ga, gb, gc = jnp.split(jax.nn.sigmoid(g), N_BRANCH, axis=-1)
    return (ga * (ya @ w_br_a) + gb * (yb @ w_br_b) + gc * (yc @ w_br_c)) @ w_out


def _token_mixer(h_lat, h_ctx, rope, w_in, a_sink, b_q_gain, b_k_gain, c_conv_w, c_conv_b,
                 c_wr, c_br, c_wi, c_bi, c_lam, w_br_a, w_br_b, w_br_c, w_out, with_ctx):
    bsz, n, _ = h_lat.shape
    m = h_ctx.shape[1]
    ga, gb = A_HEADS // A_KV, B_HEADS // B_KV
    qa_l, ka_l, va_l, qb_l, kb_l, vb_l, xr_l, yr_l, g_l = _split_cols(h_lat @ w_in)
    qa_c, ka_c, va_c, qb_c, kb_c, vb_c, xr_c, yr_c, g_c = _split_cols(h_ctx @ w_in)

    sink = a_sink.reshape(A_KV, ga)
    qa_l = _axial_rope(qa_l.reshape(bsz, n, A_HEADS, HEAD_DIM), rope).reshape(bsz, n, A_KV, ga, HEAD_DIM)
    ka_l = _axial_rope(ka_l.reshape(bsz, n, A_KV, HEAD_DIM), rope)
    va_l = va_l.reshape(bsz, n, A_KV, HEAD_DIM)
    ka_c = ka_c.reshape(bsz, m, A_KV, HEAD_DIM)
    va_c = va_c.reshape(bsz, m, A_KV, HEAD_DIM)
    ya_l = _banded_attention(qa_l, ka_l, va_l, ka_c, va_c, sink)

    qb_l = _axial_rope(_rmsnorm(qb_l.reshape(bsz, n, B_HEADS, HEAD_DIM), b_q_gain), rope)
    qb_l = qb_l.reshape(bsz, n, B_KV, gb, HEAD_DIM)
    kb_l = _axial_rope(_rmsnorm(kb_l.reshape(bsz, n, B_KV, HEAD_DIM), b_k_gain), rope)
    kb_c = _rmsnorm(kb_c.reshape(bsz, m, B_KV, HEAD_DIM), b_k_gain)
    vb_c = vb_c.reshape(bsz, m, B_KV, HEAD_DIM)
    kb_all = jnp.concatenate([kb_l, kb_c], axis=1)
    vb_all = jnp.concatenate([vb_l.reshape(bsz, n, B_KV, HEAD_DIM), vb_c], axis=1)
    yb_l = _blocked_global_attention(qb_l, kb_all, vb_all)

    xr_l = _short_conv(xr_l, c_conv_w, c_conv_b).astype(jnp.float32)
    xr_c = _short_conv(xr_c, c_conv_w, c_conv_b).astype(jnp.float32)
    hc_f, hl_f = _rglru_direction(xr_c, xr_l, c_wr[0], c_br[0], c_wi[0], c_bi[0], c_lam[0], False)
    hc_b, hl_b = _rglru_direction(xr_c, xr_l, c_wr[1], c_br[1], c_wi[1], c_bi[1], c_lam[1], True)
    yc_l = (hl_f + hl_b).astype(h_lat.dtype) * jax.nn.gelu(yr_l)

    out_lat = _merge(ya_l, yb_l, yc_l, g_l, w_br_a, w_br_b, w_br_c, w_out)
    if not with_ctx:
        return out_lat, None

    ya_c = _gqa_attend(qa_c.reshape(bsz, m, A_KV, ga, HEAD_DIM), ka_c, va_c, sink, None).reshape(bsz, m, -1)
    qb_c = _rmsnorm(qb_c.reshape(bsz, m, B_HEADS, HEAD_DIM), b_q_gain).reshape(bsz, m, B_KV, gb, HEAD_DIM)
    yb_c = _gqa_attend(qb_c, kb_c, vb_c, None, None).reshape(bsz, m, -1)
    yc_c = (hc_f + hc_b).astype(h_ctx.dtype) * jax.nn.gelu(yr_c)
    out_ctx = _merge(ya_c, yb_c, yc_c, g_c, w_br_a, w_br_b, w_br_c, w_out)
    return out_lat, out_ctx


def _sq_relu_mlp(h, w1, w2):
    return jnp.square(jax.nn.relu(h @ w1)) @ w2


def setup_inputs(seed: int = 0) -> dict:
    key = jax.random.key(seed)
    ks = jax.random.split(key, 32)
    f32 = jnp.float32
    L = DEPTH
    bd = LRU_BLOCK_DIM

    def nrm(k, shape, scale):
        return jax.random.normal(k, shape, f32) * scale

    u = jax.random.uniform(ks[17], (L, 2, LRU_WIDTH), f32, 0.9, 0.999)
    p = u ** (1.0 / LRU_C)
    c_lam = jnp.log(p) - jnp.log1p(-p)
    return {
        "x": nrm(ks[0], (BATCH, SEQ, D_MODEL), 1.0),
        "c": nrm(ks[1], (BATCH, D_MODEL), 1.0),
        "ctx": nrm(ks[2], (BATCH, CTX_LEN, D_MODEL), 1.0),
        "c_ctx": nrm(ks[3], (D_MODEL,), 1.0),
        "w_ada": nrm(ks[4], (L, D_MODEL, 6 * D_MODEL), D_MODEL ** -0.5),
        "b_ada": nrm(ks[5], (L, 6 * D_MODEL), 0.02),
        "w_in": nrm(ks[6], (L, D_MODEL, IN_COLS), D_MODEL ** -0.5),
        "a_sink": nrm(ks[7], (L, A_HEADS), 0.5),
        "b_q_gain": 1.0 + nrm(ks[8], (L, HEAD_DIM), 0.02),
        "b_k_gain": 1.0 + nrm(ks[9], (L, HEAD_DIM), 0.02),
        "c_conv_w": nrm(ks[10], (L, CONV_W, LRU_WIDTH), CONV_W ** -0.5),
        "c_conv_b": nrm(ks[11], (L, LRU_WIDTH), 0.02),
        "c_wr": nrm(ks[12], (L, 2, LRU_BLOCKS, bd, bd), bd ** -0.5),
        "c_br": nrm(ks[13], (L, 2, LRU_WIDTH), 0.02),
        "c_wi": nrm(ks[14], (L, 2, LRU_BLOCKS, bd, bd), bd ** -0.5),
        "c_bi": nrm(ks[15], (L, 2, LRU_WIDTH), 0.02),
        "c_lam": c_lam,
        "w_br_a": nrm(ks[18], (L, A_HEADS * HEAD_DIM, D_MODEL), BETA * (A_HEADS * HEAD_DIM) ** -0.5),
        "w_br_b": nrm(ks[19], (L, B_HEADS * HEAD_DIM, D_MODEL), BETA * (B_HEADS * HEAD_DIM) ** -0.5),
        "w_br_c": nrm(ks[20], (L, LRU_WIDTH, D_MODEL), BETA * LRU_WIDTH ** -0.5),
        "w_out": nrm(ks[21], (L, D_MODEL, D_MODEL), BETA * D_MODEL ** -0.5),
        "ln1_g": 1.0 + nrm(ks[22], (L, D_MODEL), 0.02),
        "ln1_b": nrm(ks[23], (L, D_MODEL), 0.02),
        "w_ff1": nrm(ks[24], (L, D_MODEL, D_FF), D_MODEL ** -0.5),
        "w_ff2": nrm(ks[25], (L, D_FF, D_MODEL), BETA * D_FF ** -0.5),
        "ln2_g": 1.0 + nrm(ks[26], (L, D_MODEL), 0.02),
        "ln2_b": nrm(ks[27], (L, D_MODEL), 0.02),
    }


def reference(x, c, ctx, c_ctx, w_ada, b_ada, w_in, a_sink, b_q_gain, b_k_gain, c_conv_w, c_conv_b,
              c_wr, c_br, c_wi, c_bi, c_lam, w_br_a, w_br_b, w_br_c, w_out, ln1_g, ln1_b,
              w_ff1, w_ff2, ln2_g, ln2_b):
    rows = x.shape[1] // GRID_W
    rope = _axial_rope_tables(rows)
    for l in range(DEPTH):
        with_ctx = l < DEPTH - 1
        mod_lat = (jax.nn.silu(c) @ w_ada[l] + b_ada[l])[:, None, :]
        mod_ctx = (jax.nn.silu(c_ctx) @ w_ada[l] + b_ada[l])[None, None, :]
        sh1, sc1, g1, sh2, sc2, g2 = jnp.split(mod_lat, 6, axis=-1)
        csh1, csc1, cg1, csh2, csc2, cg2 = jnp.split(mod_ctx, 6, axis=-1)

        o_lat, o_ctx = _token_mixer(x * (1.0 + sc1) + sh1, ctx * (1.0 + csc1) + csh1, rope,
                                    w_in[l], a_sink[l], b_q_gain[l], b_k_gain[l], c_conv_w[l], c_conv_b[l],
                                    c_wr[l], c_br[l], c_wi[l], c_bi[l], c_lam[l],
                                    w_br_a[l], w_br_b[l], w_br_c[l], w_out[l], with_ctx)
        x = _layernorm(ALPHA * x + g1 * o_lat, ln1_g[l], ln1_b[l])
        x = _layernorm(ALPHA * x + g2 * _sq_relu_mlp(x * (1.0 + sc2) + sh2, w_ff1[l], w_ff2[l]),
                       ln2_g[l], ln2_b[l])
        if with_ctx:
            ctx = _layernorm(ALPHA * ctx + cg1 * o_ctx, ln1_g[l], ln1_b[l])
            ctx = _layernorm(ALPHA * ctx + cg2 * _sq_relu_mlp(ctx * (1.0 + csc2) + csh2, w_ff1[l], w_ff2[l]),
                             ln2_g[l], ln2_b[l])
    return x
```

```cpp
#include <hip/hip_runtime.h>
#include <cstdio>
#include <cstdint>
#include <cmath>
#include <cstring>

typedef unsigned short bf16;
constexpr int DM = 1024, BATCH = 4, SEQ = 4096, CTXL = 256, DEPTH = 2;
constexpr int NLAT = BATCH * SEQ, NCTX = BATCH * CTXL, NROW = NLAT + NCTX;
constexpr int HD = 64, GRIDW = 64, WINDOW = 128;
constexpr int INC = 6656, DFF = 4096, YC = 2048, GC = 3072;
constexpr int C_QA = 0, C_KA = 512, C_VA = 640, C_QB = 768, C_KB = 1280, C_VB = 1408, C_XR = 1536, C_YR = 2560, C_G = 3584;
constexpr float ALPHA = 1.41421356237309515f;
constexpr float LN_EPS = 1e-5f, RMS_EPS = 1e-6f;
constexpr float QSCALE = 0.125f * 1.4426950408889634f;
constexpr float LOG2E = 1.4426950408889634f;

constexpr size_t MiB = 1u << 20;
constexpr size_t WS_CTL = 0;
constexpr size_t WS_MOD = 37 * MiB;
constexpr size_t WS_ROPE = WS_MOD + 512 * 1024;
constexpr size_t WS_CTXS = 38 * MiB;
constexpr size_t WS_AGG = 42 * MiB;
constexpr size_t WS_H = 47 * MiB;
constexpr size_t WS_Y = 81 * MiB;
constexpr size_t WS_KA = 149 * MiB, WS_VA = WS_KA + 4352 * 1024, WS_KB = WS_VA + 4352 * 1024, WS_VB = WS_KB + 4352 * 1024;
constexpr size_t WS_XR = 166 * MiB;
constexpr size_t WS_G = 149 * MiB;
constexpr size_t WS_HID = 81 * MiB;
constexpr size_t WS_ZRAW = 200 * MiB;
constexpr size_t WS_HF = 200 * MiB;
constexpr size_t WS_END = 252 * MiB;

__device__ __forceinline__ float bf2f(bf16 v) { return __uint_as_float(((unsigned)v) << 16); }
__device__ __forceinline__ bf16 f2bf(float f) { unsigned u = __float_as_uint(f); return (bf16)((u + 0x7fffu + ((u >> 16) & 1u)) >> 16); }
__device__ __forceinline__ float bfr(float f) { return bf2f(f2bf(f)); }
__device__ __forceinline__ float sigmoidf_(float x) { return 1.f / (1.f + __expf(-x)); }
__device__ __forceinline__ float gelu_tanh(float x) { const float u = 0.7978845608028654f * (x + 0.044715f * x * x * x); return 0.5f * x * (1.f + tanhf(u)); }
__device__ __forceinline__ int row_batch(int row) { return row < NLAT ? row / SEQ : (row - NLAT) / CTXL; }
__device__ __forceinline__ int row_modidx(int row) { return row < NLAT ? row / SEQ : 4; }

__global__ void nk_mod(const float* c, const float* c_ctx, const float* w_ada, const float* b_ada, float* mod) {
    const int gid = blockIdx.x * blockDim.x + threadIdx.x; if (gid >= DEPTH * 6144) return;
    const int l = gid / 6144, n = gid % 6144;
    float acc[5] = {0, 0, 0, 0, 0};
    for (int k = 0; k < DM; ++k) {
        const float w = w_ada[((size_t)l * DM + k) * 6144 + n];
        for (int v = 0; v < 5; ++v) { const float x = v < 4 ? c[v * DM + k] : c_ctx[k]; acc[v] += (x / (1.f + __expf(-x))) * w; }
    }
    for (int v = 0; v < 5; ++v) mod[((size_t)l * 5 + v) * 6144 + n] = acc[v] + b_ada[l * 6144 + n];
}
__global__ void nk_rope(float* rope) {
    const int i = threadIdx.x; if (i >= 64 * 16) return;
    const int pos = i / 16, f = i % 16;
    const double inv = pow(10000.0, -(double)f / 16.0), ang = (double)pos * (double)(float)inv;
    rope[i] = (float)cos(ang); rope[1024 + i] = (float)sin(ang);
}
__global__ void nk_modulate(const float* xin, const float* cin, const float* mod  , int sh_off, int sc_off, bf16* H) {
    const size_t gid = (size_t)blockIdx.x * blockDim.x + threadIdx.x; if (gid >= (size_t)NROW * DM) return;
    const int row = (int)(gid / DM), col = (int)(gid % DM);
    const float* m = mod + (size_t)row_modidx(row) * 6144;
    const float x = row < NLAT ? xin[gid] : cin[(size_t)(row - NLAT) * DM + col];
    H[gid] = f2bf(x * (1.f + m[sc_off + col]) + m[sh_off + col]);
}
struct Acc44 { float v[4][4]; };
__device__ __forceinline__ void ngemm_core(Acc44& acc, const bf16* A, int lda, const float* W, int ldw, int K, int m0, int n0, float* As, float* Bs) {
    const int tid = threadIdx.x, tx = tid & 15, ty = tid >> 4;
    for (int k0 = 0; k0 < K; k0 += 16) {
        { const int r = tid >> 2, kk = (tid & 3) * 4; const bf16* ap = A + (size_t)(m0 + r) * lda + k0 + kk;
          for (int j = 0; j < 4; ++j) As[(kk + j) * 68 + r] = bf2f(ap[j]); }
        { const int kk = tid >> 4, n = (tid & 15) * 4; const float* wp = W + (size_t)(k0 + kk) * ldw + n0 + n;
          for (int j = 0; j < 4; ++j) Bs[kk * 68 + n + j] = bfr(wp[j]); }
        __syncthreads();
#pragma unroll
        for (int kk = 0; kk < 16; ++kk) {
            float a[4], b[4];
#pragma unroll
            for (int j = 0; j < 4; ++j) { a[j] = As[kk * 68 + ty * 4 + j]; b[j] = Bs[kk * 68 + tx * 4 + j]; }
#pragma unroll
            for (int i = 0; i < 4; ++i)
#pragma unroll
                for (int j = 0; j < 4; ++j) acc.v[i][j] += a[i] * b[j];
        }
        __syncthreads();
    }
}
enum { E_RAW = 0, E_BF16 = 1, E_GELU = 2, E_SIGMOID = 3, E_RELU2 = 4, E_RESID = 5 };
struct NGemmArgs { const bf16* A; const float* W; void* out; const float* base_lat; const float* base_ctx; float* out_ctx; const float* mod; int lda, ldw, K, M, N, mode, ldo, gate_off; };
static NGemmArgs mkargs(const bf16* A, int lda, const float* W, int ldw, int K, int M, int N, int mode, void* out, int ldo, const float* base_lat, const float* base_ctx, float* out_ctx, const float* mod, int gate_off) {
    NGemmArgs g; memset(&g, 0, sizeof(g)); g.A = A; g.W = W; g.out = out; g.base_lat = base_lat; g.base_ctx = base_ctx; g.out_ctx = out_ctx; g.mod = mod; g.lda = lda; g.ldw = ldw; g.K = K; g.M = M; g.N = N; g.mode = mode; g.ldo = ldo; g.gate_off = gate_off; return g; }
__global__ void __launch_bounds__(256) nk_gemm(NGemmArgs g) {
    __shared__ float As[16 * 68], Bs[16 * 68];
    const int m0 = blockIdx.y * 64, n0 = blockIdx.x * 64;
    Acc44 acc; for (int i = 0; i < 4; ++i) for (int j = 0; j < 4; ++j) acc.v[i][j] = 0.f;
    ngemm_core(acc, g.A, g.lda, g.W, g.ldw, g.K, m0, n0, As, Bs);
    const int tx = threadIdx.x & 15, ty = threadIdx.x >> 4;
    for (int i = 0; i < 4; ++i) for (int j = 0; j < 4; ++j) {
        const int row = m0 + ty * 4 + i, col = n0 + tx * 4 + j; const float v = acc.v[i][j];
        if (g.mode == E_RAW) ((float*)g.out)[(size_t)row * g.ldo + col] = v;
        else if (g.mode == E_BF16) ((bf16*)g.out)[(size_t)row * g.ldo + col] = f2bf(v);
        else if (g.mode == E_GELU) ((bf16*)g.out)[(size_t)row * g.ldo + col] = f2bf(gelu_tanh(v));
        else if (g.mode == E_SIGMOID) ((bf16*)g.out)[(size_t)row * g.ldo + col] = f2bf(sigmoidf_(v));
        else if (g.mode == E_RELU2) { const float r = v > 0.f ? v : 0.f; ((bf16*)g.out)[(size_t)row * g.ldo + col] = f2bf(r * r); }
        else if (g.mode == E_RESID) {
            const float gate = g.mod[(size_t)row_modidx(row) * 6144 + g.gate_off + col];
            if (row < NLAT) ((float*)g.out)[(size_t)row * DM + col] = ALPHA * g.base_lat[(size_t)row * DM + col] + gate * v;
            else g.out_ctx[(size_t)(row - NLAT) * DM + col] = ALPHA * g.base_ctx[(size_t)(row - NLAT) * DM + col] + gate * v;
        }
    }
}
__global__ void __launch_bounds__(256) nk_merge(const bf16* Y, const bf16* G, const float* wa, const float* wb, const float* wc, bf16* Mo) {
    __shared__ float As[16 * 68], Bs[16 * 68];
    const int m0 = blockIdx.y * 64, n0 = blockIdx.x * 64;
    const int tx = threadIdx.x & 15, ty = threadIdx.x >> 4;
    float tot[4][4]; for (int i = 0; i < 4; ++i) for (int j = 0; j < 4; ++j) tot[i][j] = 0.f;
    for (int s = 0; s < 3; ++s) {
        Acc44 acc; for (int i = 0; i < 4; ++i) for (int j = 0; j < 4; ++j) acc.v[i][j] = 0.f;
        const bf16* A = Y + (s == 0 ? 0 : s == 1 ? 512 : 1024); const float* W = s == 0 ? wa : s == 1 ? wb : wc; const int K = s == 2 ? 1024 : 512;
        ngemm_core(acc, A, YC, W, DM, K, m0, n0, As, Bs);
        for (int i = 0; i < 4; ++i) for (int j = 0; j < 4; ++j) {
            const int row = m0 + ty * 4 + i, col = n0 + tx * 4 + j;
            tot[i][j] += bf2f(G[(size_t)row * GC + s * 1024 + col]) * acc.v[i][j];
        }
    }
    for (int i = 0; i < 4; ++i) for (int j = 0; j < 4; ++j) Mo[(size_t)(m0 + ty * 4 + i) * DM + n0 + tx * 4 + j] = f2bf(tot[i][j]);
}
__global__ void __launch_bounds__(256) nk_qkv_epi(const float* zraw, int half, const float* rope, const float* qgain, const float* kgain, bf16* Y, bf16* Kd, bf16* Vd) {
    const int wave = (blockIdx.x * blockDim.x + threadIdx.x) >> 6, d = threadIdx.x & 63; if (wave >= NROW * 12) return;
    const int row = wave / 12, hs = wave % 12;
    float v = zraw[(size_t)row * 768 + hs * 64 + d];
    const bool isq = hs < 8, isk = hs >= 8 && hs < 10;
    if (half == 1 && (isq || isk)) {
        float ss = v * v; for (int o = 32; o; o >>= 1) ss += __shfl_xor(ss, o);
        v = v * rsqrtf(ss * (1.f / 64.f) + RMS_EPS) * (isq ? qgain[d] : kgain[d]);
    }
    if ((isq || isk) && row < NLAT) {
        const int t = row % SEQ, pos = (d < 32) ? t / GRIDW : t % GRIDW, i = d & 15; const bool x2 = (d & 16) != 0;
        const float c = rope[pos * 16 + i], s = rope[1024 + pos * 16 + i], p = __shfl_xor(v, 16);
        v = x2 ? p * s + v * c : v * c - p * s;
    }
    if (isq) Y[(size_t)row * YC + half * 512 + hs * 64 + d] = f2bf(v * QSCALE);
    else if (isk) Kd[(size_t)row * 128 + (hs - 8) * 64 + d] = f2bf(v);
    else Vd[(size_t)row * 128 + (hs - 10) * 64 + d] = f2bf(v);
}
__global__ void __launch_bounds__(256) nk_attn(bf16* Y, const bf16* Kb, const bf16* Vb, int kind, const float* sink, int row_lo, int row_hi) {
    const int wave = (blockIdx.x * blockDim.x + threadIdx.x) >> 6, lane = threadIdx.x & 63;
    const int nrows = row_hi - row_lo; if (wave >= nrows * 8) return;
    const int row = row_lo + wave / 8, h = wave % 8, kvh = h / 4;
    bf16* qp = Y + (size_t)row * YC + kind * 512 + h * 64;
    float q[64]; _Pragma("unroll") for (int d = 0; d < 64; ++d) q[d] = bf2f(qp[d]);
    const bool lat = row < NLAT; const int b = row_batch(row);
    int jlo = 0, jhi = -1;
    if (lat) { const int t = row % SEQ; if (kind == 0) { jlo = t - WINDOW < 0 ? 0 : t - WINDOW; jhi = t + WINDOW > SEQ - 1 ? SEQ - 1 : t + WINDOW; } else { jlo = 0; jhi = SEQ - 1; } }
    const int nl = jhi - jlo + 1, nk = nl + CTXL;
    float mx = -INFINITY;
    for (int j = lane; j < nk; j += 64) {
        const int kr = j < nl ? b * SEQ + jlo + j : NLAT + b * CTXL + (j - nl);
        const bf16* kp = Kb + (size_t)kr * 128 + kvh * 64; float s = 0.f;
        _Pragma("unroll") for (int d = 0; d < 64; ++d) s += q[d] * bf2f(kp[d]);
        mx = fmaxf(mx, s);
    }
    for (int o = 32; o; o >>= 1) mx = fmaxf(mx, __shfl_xor(mx, o));
    float sk = 0.f; if (kind == 0) { sk = sink[h] * LOG2E; mx = fmaxf(mx, sk); }
    float den = 0.f; float o[64]; _Pragma("unroll") for (int d = 0; d < 64; ++d) o[d] = 0.f;
    for (int j = lane; j < nk; j += 64) {
        const int kr = j < nl ? b * SEQ + jlo + j : NLAT + b * CTXL + (j - nl);
        const bf16* kp = Kb + (size_t)kr * 128 + kvh * 64; float s = 0.f;
        _Pragma("unroll") for (int d = 0; d < 64; ++d) s += q[d] * bf2f(kp[d]);
        const float p = exp2f(s - mx); den += p;
        const bf16* vp = Vb + (size_t)kr * 128 + kvh * 64;
        _Pragma("unroll") for (int d = 0; d < 64; ++d) o[d] += p * bf2f(vp[d]);
    }
    for (int of = 32; of; of >>= 1) den += __shfl_xor(den, of);
    if (kind == 0) den += exp2f(sk - mx);
    const float inv = 1.f / den;
    _Pragma("unroll") for (int d = 0; d < 64; ++d) { float s = o[d]; for (int of = 32; of; of >>= 1) s += __shfl_xor(s, of); if (lane == (d & 63)) qp[d] = f2bf(s * inv); }
}
__global__ void __launch_bounds__(64) nk_lru(const bf16* XR, const float* convw, const float* convb, const float* wr, const float* br, const float* wi, const float* bi, const float* lam,
                                              int dir, bf16* HF, bf16* Y) {
    __shared__ float xs[64];
    const int b = blockIdx.x / 16, blk = blockIdx.x % 16, lane = threadIdx.x, ch = blk * 64 + lane;
    float wR[64], wI[64];
    _Pragma("unroll") for (int d = 0; d < 64; ++d) { wR[d] = bfr(wr[((size_t)(dir * 16 + blk) * 64 + d) * 64 + lane]); wI[d] = bfr(wi[((size_t)(dir * 16 + blk) * 64 + d) * 64 + lane]); }
    const float bR = br[dir * DM + ch], bI = bi[dir * DM + ch], lm = lam[dir * DM + ch];
    const float nsp = -8.f * log1pf(expf(-lm));
    const float cw0 = convw[0 * DM + ch], cw1 = convw[1 * DM + ch], cw2 = convw[2 * DM + ch], cw3 = convw[3 * DM + ch], cb = convb[ch];
    float h = 0.f;
    for (int seg = 0; seg < 2; ++seg) {
        const int L = seg == 0 ? CTXL : SEQ; const int rbase = seg == 0 ? NLAT + b * CTXL : b * SEQ;
        for (int st = 0; st < L; ++st) {
            const int t = dir == 0 ? st : L - 1 - st;
            float xc = cb;
            if (t - 1 >= 0) xc += cw0 * bf2f(XR[(size_t)(rbase + t - 1) * DM + ch]);
            xc += cw1 * bf2f(XR[(size_t)(rbase + t) * DM + ch]);
            if (t + 1 < L) xc += cw2 * bf2f(XR[(size_t)(rbase + t + 1) * DM + ch]);
            if (t + 2 < L) xc += cw3 * bf2f(XR[(size_t)(rbase + t + 2) * DM + ch]);
            __syncthreads(); xs[lane] = bfr(xc); __syncthreads();
            float r = bR, ig = bI;
            _Pragma("unroll") for (int d = 0; d < 64; ++d) { const float xv = xs[d]; r += xv * wR[d]; ig += xv * wI[d]; }
            r = sigmoidf_(r); ig = sigmoidf_(ig);
            const float la = nsp * r, a = expf(la), u = sqrtf(-expm1f(2.f * la)) * (ig * xc);
            h = a * h + u;
            const size_t off = (size_t)(rbase + t) * DM + ch;
            if (dir == 0) HF[off] = f2bf(h);
            else { const size_t yo = (size_t)(rbase + t) * YC + 1024 + ch; Y[yo] = f2bf((bf2f(HF[off]) + h) * bf2f(Y[yo])); }
        }
    }
}
__global__ void __launch_bounds__(256) nk_ln(float* xlat, float* xctx, const float* g, const float* bta, const float* mod, int sh_off, int sc_off, bf16* H) {
    const int wave = (blockIdx.x * blockDim.x + threadIdx.x) >> 6, lane = threadIdx.x & 63; if (wave >= NROW) return;
    const int row = wave; float* xr = row < NLAT ? xlat + (size_t)row * DM : xctx + (size_t)(row - NLAT) * DM;
    float v[16]; float s = 0.f;
    _Pragma("unroll") for (int j = 0; j < 16; ++j) { v[j] = xr[lane + 64 * j]; s += v[j]; }
    for (int o = 32; o; o >>= 1) s += __shfl_xor(s, o);
    const float mean = s * (1.f / DM); float q = 0.f;
    _Pragma("unroll") for (int j = 0; j < 16; ++j) { v[j] -= mean; q += v[j] * v[j]; }
    for (int o = 32; o; o >>= 1) q += __shfl_xor(q, o);
    const float rstd = rsqrtf(q * (1.f / DM) + LN_EPS);
    const float* m = mod ? mod + (size_t)row_modidx(row) * 6144 : nullptr;
    _Pragma("unroll") for (int j = 0; j < 16; ++j) { const int c = lane + 64 * j; const float y = v[j] * rstd * g[c] + bta[c]; xr[c] = y;
        if (H) H[(size_t)row * DM + c] = f2bf(y * (1.f + m[sc_off + c]) + m[sh_off + c]); }
}

extern "C" void kernel_launch(void* const* d_in, const int* in_sizes, int n_in, void* d_out, int out_size, void* d_ws, size_t ws_size, hipStream_t stream) {
    if (n_in != 27 || ws_size < WS_END) { fprintf(stderr, "kernel_launch: unexpected n_in %d / ws_size %zu\n", n_in, ws_size); return; }
    const float* x = (const float*)d_in[0]; const float* c = (const float*)d_in[1]; const float* ctx = (const float*)d_in[2]; const float* c_ctx = (const float*)d_in[3];
    const float* w_ada = (const float*)d_in[4]; const float* b_ada = (const float*)d_in[5]; const float* w_in = (const float*)d_in[6]; const float* a_sink = (const float*)d_in[7];
    const float* qgain = (const float*)d_in[8]; const float* kgain = (const float*)d_in[9]; const float* convw = (const float*)d_in[10]; const float* convb = (const float*)d_in[11];
    const float* c_wr = (const float*)d_in[12]; const float* c_br = (const float*)d_in[13]; const float* c_wi = (const float*)d_in[14]; const float* c_bi = (const float*)d_in[15];
    const float* c_lam = (const float*)d_in[16]; const float* w_br_a = (const float*)d_in[17]; const float* w_br_b = (const float*)d_in[18]; const float* w_br_c = (const float*)d_in[19];
    const float* w_out = (const float*)d_in[20]; const float* ln1_g = (const float*)d_in[21]; const float* ln1_b = (const float*)d_in[22]; const float* w_ff1 = (const float*)d_in[23];
    const float* w_ff2 = (const float*)d_in[24]; const float* ln2_g = (const float*)d_in[25]; const float* ln2_b = (const float*)d_in[26];
    char* ws = (char*)d_ws; float* out = (float*)d_out;
    float* mod = (float*)(ws + WS_MOD); float* rope = (float*)(ws + WS_ROPE); float* ctxs = (float*)(ws + WS_CTXS);
    bf16* H = (bf16*)(ws + WS_H); bf16* Y = (bf16*)(ws + WS_Y); bf16* KA = (bf16*)(ws + WS_KA); bf16* VA = (bf16*)(ws + WS_VA); bf16* KB = (bf16*)(ws + WS_KB); bf16* VB = (bf16*)(ws + WS_VB);
    bf16* XR = (bf16*)(ws + WS_XR); bf16* G = (bf16*)(ws + WS_G); bf16* HID = (bf16*)(ws + WS_HID); float* ZRAW = (float*)(ws + WS_ZRAW); bf16* HF = (bf16*)(ws + WS_HF);

    nk_mod<<<(DEPTH * 6144 + 255) / 256, 256, 0, stream>>>(c, c_ctx, w_ada, b_ada, mod);
    nk_rope<<<1, 1024, 0, stream>>>(rope);
    nk_modulate<<<(unsigned)(((size_t)NROW * DM + 255) / 256), 256, 0, stream>>>(x, ctx, mod, 0, 1024, H);
    for (int l = 0; l < DEPTH; ++l) {
        const float* modl = mod + (size_t)l * 5 * 6144;
        const float* win = w_in + (size_t)l * DM * INC;
        for (int half = 0; half < 2; ++half) {
            NGemmArgs g = mkargs(H, DM, win + (half ? C_QB : C_QA), INC, DM, NROW, 768, E_RAW, ZRAW, 768, nullptr, nullptr, nullptr, nullptr, 0);
            nk_gemm<<<dim3(768 / 64, NROW / 64), 256, 0, stream>>>(g);
            nk_qkv_epi<<<(NROW * 12 * 64 + 255) / 256, 256, 0, stream>>>(ZRAW, half, rope, qgain + l * 64, kgain + l * 64, Y, half ? KB : KA, half ? VB : VA);
        }
        { NGemmArgs g = mkargs(H, DM, win + C_XR, INC, DM, NROW, 1024, E_BF16, XR, DM, nullptr, nullptr, nullptr, nullptr, 0); nk_gemm<<<dim3(1024 / 64, NROW / 64), 256, 0, stream>>>(g); }
        { NGemmArgs g = mkargs(H, DM, win + C_YR, INC, DM, NROW, 1024, E_GELU, Y + 1024, YC, nullptr, nullptr, nullptr, nullptr, 0); nk_gemm<<<dim3(1024 / 64, NROW / 64), 256, 0, stream>>>(g); }
        nk_attn<<<(NROW * 8 * 64 + 255) / 256, 256, 0, stream>>>(Y, KA, VA, 0, a_sink + l * 8, 0, NROW);
        nk_attn<<<(NROW * 8 * 64 + 255) / 256, 256, 0, stream>>>(Y, KB, VB, 1, a_sink + l * 8, 0, NROW);
        for (int dir = 0; dir < 2; ++dir)
            nk_lru<<<BATCH * 16, 64, 0, stream>>>(XR, convw + (size_t)l * 4 * DM, convb + (size_t)l * DM, c_wr + (size_t)l * 2 * 16 * 4096, c_br + (size_t)l * 2 * DM, c_wi + (size_t)l * 2 * 16 * 4096,
                                                    c_bi + (size_t)l * 2 * DM, c_lam + (size_t)l * 2 * DM, dir, HF, Y);
        { NGemmArgs g = mkargs(H, DM, win + C_G, INC, DM, NROW, GC, E_SIGMOID, G, GC, nullptr, nullptr, nullptr, nullptr, 0); nk_gemm<<<dim3(GC / 64, NROW / 64), 256, 0, stream>>>(g); }
        nk_merge<<<dim3(DM / 64, NROW / 64), 256, 0, stream>>>(Y, G, w_br_a + (size_t)l * 512 * DM, w_br_b + (size_t)l * 512 * DM, w_br_c + (size_t)l * DM * DM, H);
        { NGemmArgs g = mkargs(H, DM, w_out + (size_t)l * DM * DM, DM, DM, NROW, DM, E_RESID, out, DM, l == 0 ? x : out, l == 0 ? ctx : ctxs, ctxs, modl, 2048); nk_gemm<<<dim3(DM / 64, NROW / 64), 256, 0, stream>>>(g); }
        nk_ln<<<(NROW * 64 + 255) / 256, 256, 0, stream>>>(out, ctxs, ln1_g + l * DM, ln1_b + l * DM, modl, 3072, 4096, H);
        { NGemmArgs g = mkargs(H, DM, w_ff1 + (size_t)l * DM * DFF, DFF, DM, NROW, DFF, E_RELU2, HID, DFF, nullptr, nullptr, nullptr, nullptr, 0); nk_gemm<<<dim3(DFF / 64, NROW / 64), 256, 0, stream>>>(g); }
        { NGemmArgs g = mkargs(HID, DFF, w_ff2 + (size_t)l * DFF * DM, DM, DFF, NROW, DM, E_RESID, out, DM, out, ctxs, ctxs, modl, 5120); nk_gemm<<<dim3(DM / 64, NROW / 64), 256, 0, stream>>>(g); }
        if (l + 1 < DEPTH) nk_ln<<<(NROW * 64 + 255) / 256, 256, 0, stream>>>(out, ctxs, ln2_g + l * DM, ln2_b + l * DM, mod + (size_t)(l + 1) * 5 * 6144, 0, 1024, H);
        else nk_ln<<<(NROW * 64 + 255) / 256, 256, 0, stream>>>(out, ctxs, ln2_g + l * DM, ln2_b + l * DM, nullptr, 0, 0, nullptr);
    }
}
```

```cpp
#include <hip/hip_runtime.h>
#include <cstdio>
#include <cstdint>
#include <cmath>
#include <cstring>

typedef unsigned short bf16;
constexpr int DM = 1024, BATCH = 4, SEQ = 4096, CTXL = 256, DEPTH = 2;
constexpr int NLAT = BATCH * SEQ, NCTX = BATCH * CTXL, NROW = NLAT + NCTX;
constexpr int HD = 64, GRIDW = 64, WINDOW = 128;
constexpr int INC = 6656, DFF = 4096, YC = 2048, GC = 3072;
constexpr int C_QA = 0, C_KA = 512, C_VA = 640, C_QB = 768, C_KB = 1280, C_VB = 1408, C_XR = 1536, C_YR = 2560, C_G = 3584;
constexpr float ALPHA = 1.41421356237309515f;
constexpr float LN_EPS = 1e-5f, RMS_EPS = 1e-6f;
constexpr float QSCALE = 0.125f * 1.4426950408889634f;
constexpr float LOG2E = 1.4426950408889634f;

constexpr size_t MiB = 1u << 20;
constexpr size_t WS_CTL = 0;
constexpr size_t WS_MOD = 37 * MiB;
constexpr size_t WS_ROPE = WS_MOD + 512 * 1024;
constexpr size_t WS_LRUC = WS_ROPE + 16384;
constexpr size_t WS_CTXS = 38 * MiB;
constexpr size_t WS_AGG = 42 * MiB;
constexpr size_t WS_H = 47 * MiB;
constexpr size_t WS_Y = 81 * MiB;
constexpr size_t WS_KA = 149 * MiB, WS_VA = WS_KA + 4352 * 1024, WS_KB = WS_VA + 4352 * 1024, WS_VB = WS_KB + 4352 * 1024;
constexpr size_t WS_XR = 166 * MiB;
constexpr size_t WS_G = 149 * MiB;
constexpr size_t WS_HID = 81 * MiB;
constexpr size_t WS_ZRAW = 200 * MiB;
constexpr size_t WS_HF = 200 * MiB;
constexpr size_t WS_END = 252 * MiB;

__device__ __forceinline__ float bf2f(bf16 v) { return __uint_as_float(((unsigned)v) << 16); }
__device__ __forceinline__ bf16 f2bf(float f) { unsigned u = __float_as_uint(f); return (bf16)((u + 0x7fffu + ((u >> 16) & 1u)) >> 16); }
__device__ __forceinline__ float bfr(float f) { return bf2f(f2bf(f)); }
__device__ __forceinline__ float sigmoidf_(float x) { return 1.f / (1.f + __expf(-x)); }
__device__ __forceinline__ float gelu_tanh(float x) { const float u = 0.7978845608028654f * (x + 0.044715f * x * x * x); return 0.5f * x * (1.f + tanhf(u)); }
__device__ __forceinline__ int row_batch(int row) { return row < NLAT ? row / SEQ : (row - NLAT) / CTXL; }
__device__ __forceinline__ int row_modidx(int row) { return row < NLAT ? row / SEQ : 4; }

__global__ void nk_mod(const float* c, const float* c_ctx, const float* w_ada, const float* b_ada, float* mod) {
    const int gid = blockIdx.x * blockDim.x + threadIdx.x; if (gid >= DEPTH * 6144) return;
    const int l = gid / 6144, n = gid % 6144;
    float acc[5] = {0, 0, 0, 0, 0};
    for (int k = 0; k < DM; ++k) {
        const float w = w_ada[((size_t)l * DM + k) * 6144 + n];
        for (int v = 0; v < 5; ++v) { const float x = v < 4 ? c[v * DM + k] : c_ctx[k]; acc[v] += (x / (1.f + __expf(-x))) * w; }
    }
    for (int v = 0; v < 5; ++v) mod[((size_t)l * 5 + v) * 6144 + n] = acc[v] + b_ada[l * 6144 + n];
}
__global__ void nk_rope(float* rope) {
    const int i = threadIdx.x; if (i >= 64 * 16) return;
    const int pos = i / 16, f = i % 16;
    const double inv = pow(10000.0, -(double)f / 16.0), ang = (double)pos * (double)(float)inv;
    rope[i] = (float)cos(ang); rope[1024 + i] = (float)sin(ang);
}
__global__ void nk_modulate(const float* xin, const float* cin, const float* mod  , int sh_off, int sc_off, bf16* H) {
    const size_t gid = (size_t)blockIdx.x * blockDim.x + threadIdx.x; if (gid >= (size_t)NROW * DM) return;
    const int row = (int)(gid / DM), col = (int)(gid % DM);
    const float* m = mod + (size_t)row_modidx(row) * 6144;
    const float x = row < NLAT ? xin[gid] : cin[(size_t)(row - NLAT) * DM + col];
    H[gid] = f2bf(x * (1.f + m[sc_off + col]) + m[sh_off + col]);
}
struct Acc44 { float v[4][4]; };
__device__ __forceinline__ void ngemm_core(Acc44& acc, const bf16* A, int lda, const float* W, int ldw, int K, int m0, int n0, float* As, float* Bs) {
    const int tid = threadIdx.x, tx = tid & 15, ty = tid >> 4;
    for (int k0 = 0; k0 < K; k0 += 16) {
        { const int r = tid >> 2, kk = (tid & 3) * 4; const bf16* ap = A + (size_t)(m0 + r) * lda + k0 + kk;
          for (int j = 0; j < 4; ++j) As[(kk + j) * 68 + r] = bf2f(ap[j]); }
        { const int kk = tid >> 4, n = (tid & 15) * 4; const float* wp = W + (size_t)(k0 + kk) * ldw + n0 + n;
          for (int j = 0; j < 4; ++j) Bs[kk * 68 + n + j] = bfr(wp[j]); }
        __syncthreads();
#pragma unroll
        for (int kk = 0; kk < 16; ++kk) {
            float a[4], b[4];
#pragma unroll
            for (int j = 0; j < 4; ++j) { a[j] = As[kk * 68 + ty * 4 + j]; b[j] = Bs[kk * 68 + tx * 4 + j]; }
#pragma unroll
            for (int i = 0; i < 4; ++i)
#pragma unroll
                for (int j = 0; j < 4; ++j) acc.v[i][j] += a[i] * b[j];
        }
        __syncthreads();
    }
}
enum { E_RAW = 0, E_BF16 = 1, E_GELU = 2, E_SIGMOID = 3, E_RELU2 = 4, E_RESID = 5 };
struct NGemmArgs { const bf16* A; const float* W; void* out; const float* base_lat; const float* base_ctx; float* out_ctx; const float* mod; int lda, ldw, K, M, N, mode, ldo, gate_off; };
static NGemmArgs mkargs(const bf16* A, int lda, const float* W, int ldw, int K, int M, int N, int mode, void* out, int ldo, const float* base_lat, const float* base_ctx, float* out_ctx, const float* mod, int gate_off) {
    NGemmArgs g; memset(&g, 0, sizeof(g)); g.A = A; g.W = W; g.out = out; g.base_lat = base_lat; g.base_ctx = base_ctx; g.out_ctx = out_ctx; g.mod = mod; g.lda = lda; g.ldw = ldw; g.K = K; g.M = M; g.N = N; g.mode = mode; g.ldo = ldo; g.gate_off = gate_off; return g; }
__global__ void __launch_bounds__(256) nk_gemm(NGemmArgs g) {
    __shared__ float As[16 * 68], Bs[16 * 68];
    const int m0 = blockIdx.y * 64, n0 = blockIdx.x * 64;
    Acc44 acc; for (int i = 0; i < 4; ++i) for (int j = 0; j < 4; ++j) acc.v[i][j] = 0.f;
    ngemm_core(acc, g.A, g.lda, g.W, g.ldw, g.K, m0, n0, As, Bs);
    const int tx = threadIdx.x & 15, ty = threadIdx.x >> 4;
    for (int i = 0; i < 4; ++i) for (int j = 0; j < 4; ++j) {
        const int row = m0 + ty * 4 + i, col = n0 + tx * 4 + j; const float v = acc.v[i][j];
        if (g.mode == E_RAW) ((float*)g.out)[(size_t)row * g.ldo + col] = v;
        else if (g.mode == E_BF16) ((bf16*)g.out)[(size_t)row * g.ldo + col] = f2bf(v);
        else if (g.mode == E_GELU) ((bf16*)g.out)[(size_t)row * g.ldo + col] = f2bf(gelu_tanh(v));
        else if (g.mode == E_SIGMOID) ((bf16*)g.out)[(size_t)row * g.ldo + col] = f2bf(sigmoidf_(v));
        else if (g.mode == E_RELU2) { const float r = v > 0.f ? v : 0.f; ((bf16*)g.out)[(size_t)row * g.ldo + col] = f2bf(r * r); }
        else if (g.mode == E_RESID) {
            const float gate = g.mod[(size_t)row_modidx(row) * 6144 + g.gate_off + col];
            if (row < NLAT) ((float*)g.out)[(size_t)row * DM + col] = ALPHA * g.base_lat[(size_t)row * DM + col] + gate * v;
            else g.out_ctx[(size_t)(row - NLAT) * DM + col] = ALPHA * g.base_ctx[(size_t)(row - NLAT) * DM + col] + gate * v;
        }
    }
}
__global__ void __launch_bounds__(256) nk_merge(const bf16* Y, const bf16* G, const float* wa, const float* wb, const float* wc, bf16* Mo) {
    __shared__ float As[16 * 68], Bs[16 * 68];
    const int m0 = blockIdx.y * 64, n0 = blockIdx.x * 64;
    const int tx = threadIdx.x & 15, ty = threadIdx.x >> 4;
    float tot[4][4]; for (int i = 0; i < 4; ++i) for (int j = 0; j < 4; ++j) tot[i][j] = 0.f;
    for (int s = 0; s < 3; ++s) {
        Acc44 acc; for (int i = 0; i < 4; ++i) for (int j = 0; j < 4; ++j) acc.v[i][j] = 0.f;
        const bf16* A = Y + (s == 0 ? 0 : s == 1 ? 512 : 1024); const float* W = s == 0 ? wa : s == 1 ? wb : wc; const int K = s == 2 ? 1024 : 512;
        ngemm_core(acc, A, YC, W, DM, K, m0, n0, As, Bs);
        for (int i = 0; i < 4; ++i) for (int j = 0; j < 4; ++j) {
            const int row = m0 + ty * 4 + i, col = n0 + tx * 4 + j;
            tot[i][j] += bf2f(G[(size_t)row * GC + s * 1024 + col]) * acc.v[i][j];
        }
    }
    for (int i = 0; i < 4; ++i) for (int j = 0; j < 4; ++j) Mo[(size_t)(m0 + ty * 4 + i) * DM + n0 + tx * 4 + j] = f2bf(tot[i][j]);
}
__global__ void __launch_bounds__(256) nk_qkv_epi(const float* zraw, int half, const float* rope, const float* qgain, const float* kgain, bf16* Y, bf16* Kd, bf16* Vd) {
    const int wave = (blockIdx.x * blockDim.x + threadIdx.x) >> 6, d = threadIdx.x & 63; if (wave >= NROW * 12) return;
    const int row = wave / 12, hs = wave % 12;
    float v = zraw[(size_t)row * 768 + hs * 64 + d];
    const bool isq = hs < 8, isk = hs >= 8 && hs < 10;
    if (half == 1 && (isq || isk)) {
        float ss = v * v; for (int o = 32; o; o >>= 1) ss += __shfl_xor(ss, o);
        v = v * rsqrtf(ss * (1.f / 64.f) + RMS_EPS) * (isq ? qgain[d] : kgain[d]);
    }
    if ((isq || isk) && row < NLAT) {
        const int t = row % SEQ, pos = (d < 32) ? t / GRIDW : t % GRIDW, i = d & 15; const bool x2 = (d & 16) != 0;
        const float c = rope[pos * 16 + i], s = rope[1024 + pos * 16 + i], p = __shfl_xor(v, 16);
        v = x2 ? p * s + v * c : v * c - p * s;
    }
    if (isq) Y[(size_t)row * YC + half * 512 + hs * 64 + d] = f2bf(v * QSCALE);
    else if (isk) Kd[(size_t)row * 128 + (hs - 8) * 64 + d] = f2bf(v);
    else Vd[(size_t)row * 128 + (hs - 10) * 64 + d] = f2bf(v);
}
__global__ void __launch_bounds__(256) nk_attn(bf16* Y, const bf16* Kb, const bf16* Vb, int kind, const float* sink, int row_lo, int row_hi) {
    const int wave = (blockIdx.x * blockDim.x + threadIdx.x) >> 6, lane = threadIdx.x & 63;
    const int nrows = row_hi - row_lo; if (wave >= nrows * 8) return;
    const int row = row_lo + wave / 8, h = wave % 8, kvh = h / 4;
    bf16* qp = Y + (size_t)row * YC + kind * 512 + h * 64;
    float q[64]; _Pragma("unroll") for (int d = 0; d < 64; ++d) q[d] = bf2f(qp[d]);
    const bool lat = row < NLAT; const int b = row_batch(row);
    int jlo = 0, jhi = -1;
    if (lat) { const int t = row % SEQ; if (kind == 0) { jlo = t - WINDOW < 0 ? 0 : t - WINDOW; jhi = t + WINDOW > SEQ - 1 ? SEQ - 1 : t + WINDOW; } else { jlo = 0; jhi = SEQ - 1; } }
    const int nl = jhi - jlo + 1, nk = nl + CTXL;
    float mx = -INFINITY;
    for (int j = lane; j < nk; j += 64) {
        const int kr = j < nl ? b * SEQ + jlo + j : NLAT + b * CTXL + (j - nl);
        const bf16* kp = Kb + (size_t)kr * 128 + kvh * 64; float s = 0.f;
        _Pragma("unroll") for (int d = 0; d < 64; ++d) s += q[d] * bf2f(kp[d]);
        mx = fmaxf(mx, s);
    }
    for (int o = 32; o; o >>= 1) mx = fmaxf(mx, __shfl_xor(mx, o));
    float sk = 0.f; if (kind == 0) { sk = sink[h] * LOG2E; mx = fmaxf(mx, sk); }
    float den = 0.f; float o[64]; _Pragma("unroll") for (int d = 0; d < 64; ++d) o[d] = 0.f;
    for (int j = lane; j < nk; j += 64) {
        const int kr = j < nl ? b * SEQ + jlo + j : NLAT + b * CTXL + (j - nl);
        const bf16* kp = Kb + (size_t)kr * 128 + kvh * 64; float s = 0.f;
        _Pragma("unroll") for (int d = 0; d < 64; ++d) s += q[d] * bf2f(kp[d]);
        const float p = exp2f(s - mx); den += p;
        const bf16* vp = Vb + (size_t)kr * 128 + kvh * 64;
        _Pragma("unroll") for (int d = 0; d < 64; ++d) o[d] += p * bf2f(vp[d]);
    }
    for (int of = 32; of; of >>= 1) den += __shfl_xor(den, of);
    if (kind == 0) den += exp2f(sk - mx);
    const float inv = 1.f / den;
    _Pragma("unroll") for (int d = 0; d < 64; ++d) { float s = o[d]; for (int of = 32; of; of >>= 1) s += __shfl_xor(s, of); if (lane == (d & 63)) qp[d] = f2bf(s * inv); }
}
__global__ void __launch_bounds__(64) nk_lru(const bf16* XR, const float* convw, const float* convb, const float* wr, const float* br, const float* wi, const float* bi, const float* lam,
                                              int dir, bf16* HF, bf16* Y) {
    __shared__ float xs[64];
    const int b = blockIdx.x / 16, blk = blockIdx.x % 16, lane = threadIdx.x, ch = blk * 64 + lane;
    float wR[64], wI[64];
    _Pragma("unroll") for (int d = 0; d < 64; ++d) { wR[d] = bfr(wr[((size_t)(dir * 16 + blk) * 64 + d) * 64 + lane]); wI[d] = bfr(wi[((size_t)(dir * 16 + blk) * 64 + d) * 64 + lane]); }
    const float bR = br[dir * DM + ch], bI = bi[dir * DM + ch], lm = lam[dir * DM + ch];
    const float nsp = -8.f * log1pf(expf(-lm));
    const float cw0 = convw[0 * DM + ch], cw1 = convw[1 * DM + ch], cw2 = convw[2 * DM + ch], cw3 = convw[3 * DM + ch], cb = convb[ch];
    float h = 0.f;
    for (int seg = 0; seg < 2; ++seg) {
        const int L = seg == 0 ? CTXL : SEQ; const int rbase = seg == 0 ? NLAT + b * CTXL : b * SEQ;
        for (int st = 0; st < L; ++st) {
            const int t = dir == 0 ? st : L - 1 - st;
            float xc = cb;
            if (t - 1 >= 0) xc += cw0 * bf2f(XR[(size_t)(rbase + t - 1) * DM + ch]);
            xc += cw1 * bf2f(XR[(size_t)(rbase + t) * DM + ch]);
            if (t + 1 < L) xc += cw2 * bf2f(XR[(size_t)(rbase + t + 1) * DM + ch]);
            if (t + 2 < L) xc += cw3 * bf2f(XR[(size_t)(rbase + t + 2) * DM + ch]);
            __syncthreads(); xs[lane] = bfr(xc); __syncthreads();
            float r = bR, ig = bI;
            _Pragma("unroll") for (int d = 0; d < 64; ++d) { const float xv = xs[d]; r += xv * wR[d]; ig += xv * wI[d]; }
            r = sigmoidf_(r); ig = sigmoidf_(ig);
            const float la = nsp * r, a = expf(la), u = sqrtf(-expm1f(2.f * la)) * (ig * xc);
            h = a * h + u;
            const size_t off = (size_t)(rbase + t) * DM + ch;
            if (dir == 0) HF[off] = f2bf(h);
            else { const size_t yo = (size_t)(rbase + t) * YC + 1024 + ch; Y[yo] = f2bf((bf2f(HF[off]) + h) * bf2f(Y[yo])); }
        }
    }
}
__global__ void __launch_bounds__(256) nk_ln(float* xlat, float* xctx, const float* g, const float* bta, const float* mod, int sh_off, int sc_off, bf16* H) {
    const int wave = (blockIdx.x * blockDim.x + threadIdx.x) >> 6, lane = threadIdx.x & 63; if (wave >= NROW) return;
    const int row = wave; float* xr = row < NLAT ? xlat + (size_t)row * DM : xctx + (size_t)(row - NLAT) * DM;
    float v[16]; float s = 0.f;
    _Pragma("unroll") for (int j = 0; j < 16; ++j) { v[j] = xr[lane + 64 * j]; s += v[j]; }
    for (int o = 32; o; o >>= 1) s += __shfl_xor(s, o);
    const float mean = s * (1.f / DM); float q = 0.f;
    _Pragma("unroll") for (int j = 0; j < 16; ++j) { v[j] -= mean; q += v[j] * v[j]; }
    for (int o = 32; o; o >>= 1) q += __shfl_xor(q, o);
    const float rstd = rsqrtf(q * (1.f / DM) + LN_EPS);
    const float* m = mod ? mod + (size_t)row_modidx(row) * 6144 : nullptr;
    _Pragma("unroll") for (int j = 0; j < 16; ++j) { const int c = lane + 64 * j; const float y = v[j] * rstd * g[c] + bta[c]; xr[c] = y;
        if (H) H[(size_t)row * DM + c] = f2bf(y * (1.f + m[sc_off + c]) + m[sh_off + c]); }
}


namespace pg8 {

#define PG8_LAS __attribute__((address_space(3)))
typedef unsigned short bf16_t;
typedef short bf16x8 __attribute__((ext_vector_type(8)));
typedef float f32x4 __attribute__((ext_vector_type(4)));
typedef unsigned u32x4 __attribute__((ext_vector_type(4)));
constexpr int BM = 256, BK = 64, HALF = 128, HTB = HALF * BK * 2  , STAGE_BYTES = 8 * HTB, NXCD = 8, WGM = 8;

__host__ __device__ __forceinline__ int lds_byte(int r, int c) { const int st = (r >> 4) * 2 + (c >> 5), rr = r & 15, cc = c & 31, ob = rr * 64 + cc * 2; return st * 1024 + (ob ^ (((ob >> 9) & 1) << 5)); }
__host__ __device__ __forceinline__ void stage_rc(int b, int& R, int& C) { const int st = b / 1024, sb = b % 1024, swz = sb ^ (((sb >> 9) & 1) << 5); R = (st >> 1) * 16 + swz / 64; C = (st & 1) * 32 + (swz % 64) / 2; }
__host__ __device__ __forceinline__ int perm32(int rho) { const int n = rho >> 4, i = rho & 15; return 8 * (i >> 2) + 4 * n + (i & 3); }

struct Unit { int pm, pn; };
struct Gemm { const bf16_t* A; const bf16_t* Bt; int M, N, K; };

struct StaticOrder {
    int nM, nN, nwg, G, c;
    __host__ __device__ void init(int M, int N, int G_, int c_) { nM = M / BM; nN = N / BM; nwg = nM * nN; G = G_; c = c_; }
    __host__ __device__ bool next(int i, Unit& u) const {
        const long L = (long)i * G + c; if (L >= nwg) return false;
        int wgid = (int)L; { const int q = nwg / NXCD, r = nwg % NXCD, xcd = wgid % NXCD, off = wgid / NXCD; wgid = (xcd < r ? xcd * (q + 1) : r * (q + 1) + (xcd - r) * q) + off; }
        const int nig = WGM * nN, gid = wgid / nig, fm = gid * WGM, gsz = (nM - fm) < WGM ? (nM - fm) : WGM;
        u.pm = fm + ((wgid % nig) % gsz); u.pn = (wgid % nig) / gsz; return true;
    }
    __device__ __forceinline__ void a_ready(const Unit&) const {}
    __device__ __forceinline__ void done(const Unit&) const {}
};


typedef float f32x2_c __attribute__((ext_vector_type(2))); typedef __bf16 bf16x2_c __attribute__((ext_vector_type(2)));
__device__ __forceinline__ unsigned cvt_pk_bf16(float lo, float hi) { f32x2_c v = {lo, hi}; bf16x2_c b = __builtin_convertvector(v, bf16x2_c); return __builtin_bit_cast(unsigned, b); }

enum { TT_IDENT = 0, TT_NAT8 = 1, TT_HEAD = 2 };
__host__ __device__ __forceinline__ int tile_pos_of_logical(int tt, int L) {
    if (tt == TT_IDENT) return L;
    if (tt == TT_NAT8) { const int bj = L >> 7, wc = (L >> 5) & 3, fq = (L >> 3) & 3, n = (L >> 2) & 1, j = L & 3; return 128 * bj + 32 * wc + 16 * n + 4 * fq + j; }
    const int wc = L >> 6, d = L & 63, fqh = d >> 5, bj = (d >> 4) & 1, fql = (d >> 3) & 1, n = (d >> 2) & 1, j = d & 3;
    return 128 * bj + 32 * wc + 16 * n + 4 * (2 * fqh + fql) + j;
}
__device__ __forceinline__ float fast_sigmoid(float x) { return __builtin_amdgcn_rcpf(1.f + __builtin_amdgcn_exp2f(-1.4426950408889634f * x)); }
__device__ __forceinline__ float fast_gelu_tanh(float x) { const float u = x * (1.5957691216057308f + 0.0713548162726f * x * x); return x * __builtin_amdgcn_rcpf(1.f + __builtin_amdgcn_exp2f(-1.4426950408889634f * u)); }
template <int FN> __device__ __forceinline__ float epi_fn(float v) { if (FN == 1) return fast_gelu_tanh(v); if (FN == 2) return fast_sigmoid(v); if (FN == 3) { const float r = v > 0.f ? v : 0.f; return r * r; } return v; }
template <int FN> __device__ __forceinline__ void store_nat8(const f32x4 (&acc)[2][2][4][2], bf16_t* dst, int ld, int row0, int col0) {
#pragma unroll
    for (int ai = 0; ai < 2; ++ai)
#pragma unroll
        for (int m = 0; m < 4; ++m) { bf16_t* rowp = dst + (size_t)(row0 + ai * HALF + m * 16) * ld + col0;
#pragma unroll
            for (int bj = 0; bj < 2; ++bj) { const f32x4 v0 = acc[ai][bj][m][0], v1 = acc[ai][bj][m][1]; u32x4 w;
                w.x = cvt_pk_bf16(epi_fn<FN>(v0[0]), epi_fn<FN>(v0[1])); w.y = cvt_pk_bf16(epi_fn<FN>(v0[2]), epi_fn<FN>(v0[3]));
                w.z = cvt_pk_bf16(epi_fn<FN>(v1[0]), epi_fn<FN>(v1[1])); w.w = cvt_pk_bf16(epi_fn<FN>(v1[2]), epi_fn<FN>(v1[3]));
                *(u32x4*)(rowp + bj * HALF) = w; } }
}
template <int FN> struct EpiNat8 {
    static constexpr bool PERM = false, AFTER_DRAIN = false, RESCALE = false;
    bf16_t* dst; int ld;
    __device__ __forceinline__ void operator()(const f32x4 (&acc)[2][2][4][2], const Unit& u, int wr, int wc, int fr, int fq) const {
        store_nat8<FN>(acc, dst + u.pn * BM, ld, u.pm * BM + wr * 64 + fr, wc * 32 + 8 * fq);
    }
};
struct EpiG1 {
    static constexpr bool PERM = false, AFTER_DRAIN = false, RESCALE = false;
    bf16_t *Y, *KA, *VA, *KB, *VB, *XR, *G; const float* rope; const float* qgain; const float* kgain; int pn_off, pad_;
    __device__ __forceinline__ void operator()(const f32x4 (&acc)[2][2][4][2], const Unit& u, int wr, int wc, int fr, int fq) const {
        const int T = u.pn + pn_off, row0 = u.pm * BM + wr * 64 + fr;
        if (T >= 14) { store_nat8<2>(acc, G + (T - 14) * 256, 3072, row0, wc * 32 + 8 * fq); return; }
        if (T >= 10) { store_nat8<1>(acc, Y + 1024 + (T - 10) * 256, 2048, row0, wc * 32 + 8 * fq); return; }
        if (T >= 6) { store_nat8<0>(acc, XR + (T - 6) * 256, 1024, row0, wc * 32 + 8 * fq); return; }
        const bool isB = T >= 3; const int Tl = isB ? T - 3 : T;
        int kind; bf16_t* dst; int ld;
        if (Tl < 2) { kind = 0; dst = Y + (isB ? 512 : 0) + Tl * 256 + wc * 64; ld = 2048; }
        else if (wc < 2) { kind = 1; dst = (isB ? KB : KA) + wc * 64; ld = 128; }
        else { kind = 2; dst = (isB ? VB : VA) + (wc - 2) * 64; ld = 128; }
        const bool lat = u.pm < 64, rms = isB && kind < 2, rot = kind < 2 && lat;
        const int based = 32 * (fq >> 1) + 8 * (fq & 1);
        f32x4 gn[2][2];
#pragma unroll
        for (int bj = 0; bj < 2; ++bj)
#pragma unroll
            for (int n = 0; n < 2; ++n) { const f32x4 gq = *(const f32x4*)(qgain + based + 16 * bj + 4 * n), gk = *(const f32x4*)(kgain + based + 16 * bj + 4 * n); gn[bj][n] = kind == 0 ? gq : gk; }
        const float osc = kind == 0 ? 0.125f * 1.4426950408889634f : 1.f;
#pragma unroll
        for (int ai = 0; ai < 2; ++ai)
#pragma unroll
            for (int m = 0; m < 4; ++m) {
                const int row = row0 + ai * HALF + m * 16;
                f32x4 v[2][2];
#pragma unroll
                for (int bj = 0; bj < 2; ++bj)
#pragma unroll
                    for (int n = 0; n < 2; ++n) v[bj][n] = acc[ai][bj][m][n];
                if (rms) {
                    float ss = 0.f;
#pragma unroll
                    for (int bj = 0; bj < 2; ++bj)
#pragma unroll
                        for (int n = 0; n < 2; ++n) { const f32x4 x = v[bj][n]; ss += (x[0] * x[0] + x[1] * x[1]) + (x[2] * x[2] + x[3] * x[3]); }
                    ss += __shfl_xor(ss, 16); ss += __shfl_xor(ss, 32);
                    const float r = __builtin_amdgcn_rsqf(ss * (1.f / 64.f) + 1e-6f);
#pragma unroll
                    for (int bj = 0; bj < 2; ++bj)
#pragma unroll
                        for (int n = 0; n < 2; ++n) v[bj][n] = v[bj][n] * r * gn[bj][n];
                }
                if (rot) {
                    const int t = row & 4095, pos = (fq >> 1) ? (t & 63) : (t >> 6); const float* cp = rope + pos * 16 + 8 * (fq & 1);
#pragma unroll
                    for (int n = 0; n < 2; ++n) { const f32x4 c = *(const f32x4*)(cp + 4 * n), s = *(const f32x4*)(cp + 1024 + 4 * n); const f32x4 x1 = v[0][n], x2 = v[1][n];
                        v[0][n] = x1 * c - x2 * s; v[1][n] = x1 * s + x2 * c; }
                }
                bf16_t* rowp = dst + (size_t)row * ld + based;
#pragma unroll
                for (int bj = 0; bj < 2; ++bj) { const f32x4 v0 = v[bj][0] * osc, v1 = v[bj][1] * osc; u32x4 w;
                    w.x = cvt_pk_bf16(v0[0], v0[1]); w.y = cvt_pk_bf16(v0[2], v0[3]); w.z = cvt_pk_bf16(v1[0], v1[1]); w.w = cvt_pk_bf16(v1[2], v1[3]);
                    *(u32x4*)(rowp + 16 * bj) = w; }
            }
    }
};
struct EpiMerge {
    static constexpr bool PERM = false, AFTER_DRAIN = false, RESCALE = true;
    const bf16_t* G; bf16_t* Mo;
    __device__ __forceinline__ static void unpack8(const u32x4 w, float (&f)[8]) {
        f[0] = __uint_as_float(w.x << 16); f[1] = __uint_as_float(w.x & 0xffff0000u); f[2] = __uint_as_float(w.y << 16); f[3] = __uint_as_float(w.y & 0xffff0000u);
        f[4] = __uint_as_float(w.z << 16); f[5] = __uint_as_float(w.z & 0xffff0000u); f[6] = __uint_as_float(w.w << 16); f[7] = __uint_as_float(w.w & 0xffff0000u);
    }
    __device__ __forceinline__ void rescale(f32x4 (&acc)[2][2][4][2], const Unit& u, int t, int wr, int wc, int fr, int fq) const {
        const int s = t == 8 ? 0 : 1; int row0 = u.pm * BM + wr * 64 + fr, col0 = u.pn * BM + wc * 32 + 8 * fq;
        asm volatile("" : "+v"(row0), "+v"(col0));
#pragma unroll
        for (int ai = 0; ai < 2; ++ai)
#pragma unroll
            for (int m = 0; m < 4; ++m) { const bf16_t* gp = G + (size_t)(row0 + ai * HALF + m * 16) * 3072 + s * 1024 + col0;
#pragma unroll
                for (int bj = 0; bj < 2; ++bj) { float a[8], b[8]; unpack8(*(const u32x4*)(gp + bj * HALF), a); unpack8(*(const u32x4*)(gp + 1024 + bj * HALF), b);
                    f32x4 f0, f1;
#pragma unroll
                    for (int j = 0; j < 4; ++j) { f0[j] = fmaxf(a[j], 1e-20f) * __builtin_amdgcn_rcpf(fmaxf(b[j], 1e-20f)); f1[j] = fmaxf(a[4 + j], 1e-20f) * __builtin_amdgcn_rcpf(fmaxf(b[4 + j], 1e-20f)); }
                    if (s == 0) {
#pragma unroll
                        for (int j = 0; j < 4; ++j) { f0[j] = a[j] * __builtin_amdgcn_rcpf(fmaxf(b[j], 1e-20f)); f1[j] = a[4 + j] * __builtin_amdgcn_rcpf(fmaxf(b[4 + j], 1e-20f)); } }
                    acc[ai][bj][m][0] *= f0; acc[ai][bj][m][1] *= f1; }
                asm volatile("" ::: "memory"); }
    }
    __device__ __forceinline__ void operator()(const f32x4 (&acc)[2][2][4][2], const Unit& u, int wr, int wc, int fr, int fq) const {
        const int row0 = u.pm * BM + wr * 64 + fr, col0 = u.pn * BM + wc * 32 + 8 * fq;
#pragma unroll
        for (int ai = 0; ai < 2; ++ai)
#pragma unroll
            for (int m = 0; m < 4; ++m) { const size_t ro = (size_t)(row0 + ai * HALF + m * 16);
#pragma unroll
                for (int bj = 0; bj < 2; ++bj) { float c[8]; unpack8(*(const u32x4*)(G + ro * 3072 + 2048 + col0 + bj * HALF), c);
                    const f32x4 v0 = acc[ai][bj][m][0], v1 = acc[ai][bj][m][1]; u32x4 w;
                    w.x = cvt_pk_bf16(v0[0] * fmaxf(c[0], 1e-20f), v0[1] * fmaxf(c[1], 1e-20f)); w.y = cvt_pk_bf16(v0[2] * fmaxf(c[2], 1e-20f), v0[3] * fmaxf(c[3], 1e-20f));
                    w.z = cvt_pk_bf16(v1[0] * fmaxf(c[4], 1e-20f), v1[1] * fmaxf(c[5], 1e-20f)); w.w = cvt_pk_bf16(v1[2] * fmaxf(c[6], 1e-20f), v1[3] * fmaxf(c[7], 1e-20f));
                    *(u32x4*)(Mo + ro * 1024 + col0 + bj * HALF) = w; } }
    }
};
struct EpiResid {
    static constexpr bool PERM = false, AFTER_DRAIN = false, RESCALE = false;
    const float* base_lat; const float* base_ctx; float* out_lat; float* out_ctx; const float* mod; int gate_off, pad_;
    __device__ __forceinline__ void operator()(const f32x4 (&acc)[2][2][4][2], const Unit& u, int wr, int wc, int fr, int fq) const {
        const bool lat = u.pm < 64; const float* base = lat ? base_lat : base_ctx; float* out = lat ? out_lat : out_ctx;
        const int rowt = (lat ? u.pm : u.pm - 64) * BM + wr * 64 + fr, col0 = u.pn * BM + wc * 32 + 4 * fq;
        const float* gp = mod + (size_t)(lat ? (u.pm >> 4) : 4) * 6144 + gate_off + col0;
        f32x4 gv[2][2];
#pragma unroll
        for (int bj = 0; bj < 2; ++bj)
#pragma unroll
            for (int n = 0; n < 2; ++n) gv[bj][n] = *(const f32x4*)(gp + bj * HALF + n * 16);
#pragma unroll
        for (int ai = 0; ai < 2; ++ai)
#pragma unroll
            for (int m = 0; m < 4; ++m) { const size_t off = (size_t)(rowt + ai * HALF + m * 16) * 1024 + col0;
#pragma unroll
                for (int bj = 0; bj < 2; ++bj)
#pragma unroll
                    for (int n = 0; n < 2; ++n) { const f32x4 b = *(const f32x4*)(base + off + bj * HALF + n * 16);
                        *(f32x4*)(out + off + bj * HALF + n * 16) = b * 1.41421356237309515f + gv[bj][n] * acc[ai][bj][m][n]; } }
    }
};

template <class Epi, class Sched, bool ALIGN_EPI = false, bool SP2 = false>
__device__ __forceinline__ void gemm_phase(PG8_LAS unsigned char* lds, const Gemm g, const Sched& S, const Epi& E) {
    int tid_ = threadIdx.x; asm volatile("" : "+v"(tid_));
    const int tid = tid_, wid = __builtin_amdgcn_readfirstlane(tid >> 6), lane = tid & 63, wr = wid >> 2, wc = wid & 3, fr = lane & 15, fq = lane >> 4;
    const int K = g.K, nt = K / BK;
    unsigned voffA[2], voffB[2];
#pragma unroll
    for (int i = 0; i < 2; ++i) { int R, C; stage_rc(tid * 16 + i * 8192, R, C); const int Rb = Epi::PERM ? ((R & ~31) + perm32(R & 31)) : R;
        voffA[i] = (unsigned)(R * K + C) * 2u; voffB[i] = (unsigned)(Rb * K + C) * 2u; }
    const size_t kstep = (size_t)(BK * 2);
    const size_t hstep = (size_t)HALF * K * 2;
    const size_t tstep = 2 * hstep;
    const unsigned ldsw = (unsigned)wid * 1024u;
    const int aoff = lds_byte(wr * 64 + fr, fq * 8), boff = lds_byte(wc * 32 + fr, fq * 8);
#define PG8_SA(b, h) (((b) * 2 + (h)) * HTB)
#define PG8_SB(b, h) ((4 + (b) * 2 + (h)) * HTB)
#define PG8_STAGE(bufoff, gbase, voff) do { _Pragma("unroll") for (int _i = 0; _i < 2; ++_i) \
        __builtin_amdgcn_global_load_lds((const unsigned*)((const char*)(gbase) + (voff)[_i]), (PG8_LAS unsigned*)(lds + (bufoff) + ldsw + _i * 8192), 16, 0, 0); } while (0)
#define PG8_LDA(dst, b, h) do { _Pragma("unroll") for (int m = 0; m < 4; ++m) _Pragma("unroll") for (int k = 0; k < 2; ++k) dst[m][k] = *(const PG8_LAS bf16x8*)(lds + PG8_SA(b, h) + aoff + m * 2048 + k * 1024); } while (0)
#define PG8_LDB(dst, b, h) do { _Pragma("unroll") for (int n = 0; n < 2; ++n) _Pragma("unroll") for (int k = 0; k < 2; ++k) dst[n][k] = *(const PG8_LAS bf16x8*)(lds + PG8_SB(b, h) + boff + n * 2048 + k * 1024); } while (0)
#define PG8_MMA(ai, bj, At, Bt) do { __builtin_amdgcn_s_setprio(1); _Pragma("unroll") for (int m = 0; m < 4; ++m) _Pragma("unroll") for (int n = 0; n < 2; ++n) _Pragma("unroll") for (int k = 0; k < 2; ++k) \
        acc[ai][bj][m][n] = __builtin_amdgcn_mfma_f32_16x16x32_bf16(Bt[n][k], At[m][k], acc[ai][bj][m][n], 0, 0, 0); __builtin_amdgcn_s_setprio(0); } while (0)
#define PG8_WAIT_V(n) asm volatile("s_waitcnt vmcnt(" #n ")" ::: "memory")
#define PG8_WAIT_L(n) asm volatile("s_waitcnt lgkmcnt(" #n ")" ::: "memory")
#define PG8_BAR __builtin_amdgcn_s_barrier()
#define PG8_SCHED __builtin_amdgcn_sched_barrier(0)
    Unit cur, nxt; int ui = 0;
    if (!S.next(0, cur)) return;
    f32x4 acc[2][2][4][2];
#pragma unroll
    for (int a = 0; a < 2; ++a)
#pragma unroll
        for (int b = 0; b < 2; ++b)
#pragma unroll
            for (int m = 0; m < 4; ++m)
#pragma unroll
                for (int n = 0; n < 2; ++n) acc[a][b][m][n] = (f32x4){0.f, 0.f, 0.f, 0.f};
    bf16x8 At[4][2], B0[2][2], B1[2][2];
    const char* cA = (const char*)g.A + (size_t)cur.pm * tstep; const char* cB = (const char*)g.Bt + (size_t)cur.pn * tstep;
    S.a_ready(cur);
    if constexpr (SP2) {
        PG8_STAGE(PG8_SB(0, 0), cB, voffB); PG8_STAGE(PG8_SB(0, 1), cB + hstep, voffB); PG8_STAGE(PG8_SA(0, 0), cA, voffA); PG8_STAGE(PG8_SA(0, 1), cA + hstep, voffA);
        if (wr == 1) PG8_BAR;
        PG8_WAIT_V(2); PG8_BAR;
        PG8_STAGE(PG8_SB(1, 0), cB + kstep, voffB); PG8_STAGE(PG8_SA(1, 0), cA + kstep, voffA); PG8_STAGE(PG8_SB(1, 1), cB + hstep + kstep, voffB);
        PG8_WAIT_V(6); PG8_BAR;
    } else {
        PG8_STAGE(PG8_SB(0, 0), cB, voffB); PG8_STAGE(PG8_SA(0, 0), cA, voffA); PG8_STAGE(PG8_SB(0, 1), cB + hstep, voffB); PG8_STAGE(PG8_SA(0, 1), cA + hstep, voffA);
        if (wr == 1) PG8_BAR;
        PG8_WAIT_V(4); PG8_BAR;
        PG8_STAGE(PG8_SB(1, 0), cB + kstep, voffB); PG8_STAGE(PG8_SA(1, 0), cA + kstep, voffA); PG8_STAGE(PG8_SB(1, 1), cB + hstep + kstep, voffB);
        PG8_WAIT_V(6); PG8_BAR;
    }
    for (;;) {
        const bool has_next = S.next(ui + 1, nxt);
        const char* nA = has_next ? (const char*)g.A + (size_t)nxt.pm * tstep : cA; const char* nB = has_next ? (const char*)g.Bt + (size_t)nxt.pn * tstep : cB;
        for (int t = 0; t < nt; t += 2) {
            if constexpr (Epi::RESCALE) { if (t == 8 || t == 16) E.rescale(acc, cur, t, wr, wc, fr, fq); }
            const bool last = (t == nt - 2);
            const char* a1 = cA + (size_t)(t + 1) * kstep;
            const char* a2 = last ? nA : cA + (size_t)(t + 2) * kstep; const char* b2 = last ? nB : cB + (size_t)(t + 2) * kstep;
            const char* a3 = a2 + kstep; const char* b3 = b2 + kstep;
            if (last && has_next) S.a_ready(nxt);
            if constexpr (SP2) {
            PG8_LDB(B0, 0, 0); PG8_LDB(B1, 0, 1); PG8_SCHED; PG8_LDA(At, 0, 0); PG8_STAGE(PG8_SA(1, 1), a1 + hstep, voffA);
            PG8_WAIT_V(8); PG8_WAIT_L(0); PG8_BAR; PG8_MMA(0, 0, At, B0); PG8_MMA(0, 1, At, B1); PG8_BAR; PG8_SCHED;
            PG8_LDA(At, 0, 1); PG8_STAGE(PG8_SB(0, 0), b2, voffB); PG8_STAGE(PG8_SB(0, 1), b2 + hstep, voffB); PG8_STAGE(PG8_SA(0, 0), a2, voffA);
            PG8_WAIT_V(8); PG8_WAIT_L(0); PG8_BAR; PG8_MMA(1, 0, At, B0); PG8_MMA(1, 1, At, B1); PG8_BAR; PG8_SCHED;
            PG8_LDB(B0, 1, 0); PG8_LDB(B1, 1, 1); PG8_SCHED; PG8_LDA(At, 1, 0); PG8_STAGE(PG8_SA(0, 1), a2 + hstep, voffA);
            PG8_WAIT_V(8); PG8_WAIT_L(0); PG8_BAR; PG8_MMA(0, 0, At, B0); PG8_MMA(0, 1, At, B1); PG8_BAR; PG8_SCHED;
            PG8_LDA(At, 1, 1); PG8_STAGE(PG8_SB(1, 0), b3, voffB); PG8_STAGE(PG8_SB(1, 1), b3 + hstep, voffB); PG8_STAGE(PG8_SA(1, 0), a3, voffA);
            PG8_WAIT_V(8); PG8_WAIT_L(0); PG8_BAR; PG8_MMA(1, 0, At, B0); PG8_MMA(1, 1, At, B1); PG8_BAR; PG8_SCHED;
            } else {
            PG8_LDB(B0, 0, 0); PG8_SCHED; PG8_LDA(At, 0, 0); PG8_STAGE(PG8_SA(1, 1), a1 + hstep, voffA);
            PG8_WAIT_L(8); PG8_BAR; PG8_WAIT_L(0); PG8_MMA(0, 0, At, B0); PG8_BAR; PG8_SCHED;
            PG8_LDB(B1, 0, 1); PG8_STAGE(PG8_SB(0, 0), b2, voffB);
            PG8_BAR; PG8_WAIT_L(0); PG8_MMA(0, 1, At, B1); PG8_BAR;
            PG8_LDA(At, 0, 1); PG8_STAGE(PG8_SA(0, 0), a2, voffA);
            PG8_BAR; PG8_WAIT_L(0); PG8_MMA(1, 0, At, B0); PG8_BAR; PG8_SCHED;
            PG8_STAGE(PG8_SB(0, 1), b2 + hstep, voffB);
            PG8_WAIT_V(6); PG8_BAR; PG8_MMA(1, 1, At, B1); PG8_BAR;
            PG8_LDB(B0, 1, 0); PG8_SCHED; PG8_LDA(At, 1, 0); PG8_STAGE(PG8_SA(0, 1), a2 + hstep, voffA);
            PG8_WAIT_L(8); PG8_BAR; PG8_WAIT_L(0); PG8_MMA(0, 0, At, B0); PG8_BAR; PG8_SCHED;
            PG8_LDB(B1, 1, 1); PG8_STAGE(PG8_SB(1, 0), b3, voffB);
            PG8_BAR; PG8_WAIT_L(0); PG8_MMA(0, 1, At, B1); PG8_BAR;
            PG8_LDA(At, 1, 1); PG8_STAGE(PG8_SA(1, 0), a3, voffA);
            PG8_BAR; PG8_WAIT_L(0); PG8_MMA(1, 0, At, B0); PG8_BAR; PG8_SCHED;
            PG8_STAGE(PG8_SB(1, 1), b3 + hstep, voffB);
            PG8_WAIT_V(6); PG8_BAR; PG8_MMA(1, 1, At, B1); PG8_BAR;
            }
        }
        if constexpr (ALIGN_EPI) { if (wr == 0) PG8_BAR; }
        if constexpr (!Epi::AFTER_DRAIN) { E(acc, cur, wr, wc, fr, fq); S.done(cur); }
        if (!has_next) break;
#pragma unroll
        for (int a = 0; a < 2; ++a)
#pragma unroll
            for (int b = 0; b < 2; ++b)
#pragma unroll
                for (int m = 0; m < 4; ++m)
#pragma unroll
                    for (int n = 0; n < 2; ++n) acc[a][b][m][n] = (f32x4){0.f, 0.f, 0.f, 0.f};
        cur = nxt; cA = nA; cB = nB; ++ui;
        if constexpr (ALIGN_EPI) { if (wr == 1) PG8_BAR; }
    }
    PG8_WAIT_V(0);
    if constexpr (!ALIGN_EPI) { if (wr == 0) PG8_BAR; }
    PG8_BAR;
    if constexpr (Epi::AFTER_DRAIN) { E.fused(acc, cur, wr, wc, fr, fq, lds, wid, lane); S.done(cur); }
#undef PG8_SA
#undef PG8_SB
#undef PG8_STAGE
#undef PG8_LDA
#undef PG8_LDB
#undef PG8_MMA
#undef PG8_WAIT_V
#undef PG8_WAIT_L
#undef PG8_BAR
#undef PG8_SCHED
}
}

namespace lru {
#define LAS __attribute__((address_space(3)))
typedef short bf16x8 __attribute__((ext_vector_type(8)));
typedef float f32x4 __attribute__((ext_vector_type(4)));
typedef unsigned u32x4 __attribute__((ext_vector_type(4)));
constexpr int NCH = 68;
template <int CTRL> __device__ __forceinline__ float dpp(float oldv, float src) {
    return __int_as_float(__builtin_amdgcn_update_dpp(__float_as_int(oldv), __float_as_int(src), CTRL, 0xf, 0xf, false));
}
__device__ __forceinline__ float bfe(const bf16x8& v, int j) { return __uint_as_float(((unsigned)(unsigned short)v[j]) << 16); }
__device__ __forceinline__ float sigm(float x) { return __builtin_amdgcn_rcpf(1.f + __builtin_amdgcn_exp2f(-1.4426950408889634f * x)); }
template <int DIR> __device__ __forceinline__ void row_scan(float (&TA)[8], float (&TU)[8]) {
#define LRU_STEP(D) { _Pragma("unroll") for (int j = 0; j < 8; ++j) { const float pA = dpp<(DIR ? 0x100 : 0x110) | D>(1.f, TA[j]), pU = dpp<(DIR ? 0x100 : 0x110) | D>(0.f, TU[j]); TU[j] = TA[j] * pU + TU[j]; TA[j] = TA[j] * pA; } }
    LRU_STEP(1) LRU_STEP(2) LRU_STEP(4) LRU_STEP(8)
#undef LRU_STEP
}
struct Params { const bf16* XR; const float* convw; const float* convb; const bf16* Wg; const float* br; const float* bi; const float* c2; float* agg; bf16* Y; };

template <int PASS> __device__ __forceinline__ void item(const Params& P, int b, int c, int blk, int lane, LAS f32x4* hfl  ) {
    const int fr = lane & 15, fq = lane >> 4;
    const bool isctx = c < 4; const int L = isctx ? CTXL : SEQ, t0 = (isctx ? c : c - 4) * 64 + 4 * fr, rbase = isctx ? NLAT + b * CTXL : b * SEQ;
    bf16x8 Af[4][2];
#pragma unroll
    for (int ks = 0; ks < 2; ++ks) {
        const int ch0 = blk * 64 + 32 * ks + 8 * fq;
        float xr[7][8];
#pragma unroll
        for (int i = 0; i < 7; ++i) { const int t = t0 - 1 + i; u32x4 w = (u32x4){0u, 0u, 0u, 0u};
            if (t >= 0 && t < L) w = *(const u32x4*)(P.XR + (size_t)(rbase + t) * DM + ch0);
            xr[i][0] = __uint_as_float(w.x << 16); xr[i][1] = __uint_as_float(w.x & 0xffff0000u); xr[i][2] = __uint_as_float(w.y << 16); xr[i][3] = __uint_as_float(w.y & 0xffff0000u);
            xr[i][4] = __uint_as_float(w.z << 16); xr[i][5] = __uint_as_float(w.z & 0xffff0000u); xr[i][6] = __uint_as_float(w.w << 16); xr[i][7] = __uint_as_float(w.w & 0xffff0000u); }
        float o[4][8];
        { const f32x4 b0 = *(const f32x4*)(P.convb + ch0), b1 = *(const f32x4*)(P.convb + ch0 + 4);
#pragma unroll
          for (int m = 0; m < 4; ++m) { o[m][0] = b0[0]; o[m][1] = b0[1]; o[m][2] = b0[2]; o[m][3] = b0[3]; o[m][4] = b1[0]; o[m][5] = b1[1]; o[m][6] = b1[2]; o[m][7] = b1[3]; } }
#pragma unroll
        for (int k = 0; k < 4; ++k) { const f32x4 w0 = *(const f32x4*)(P.convw + k * DM + ch0), w1 = *(const f32x4*)(P.convw + k * DM + ch0 + 4);
#pragma unroll
            for (int m = 0; m < 4; ++m) {
#pragma unroll
                for (int j = 0; j < 4; ++j) { o[m][j] += w0[j] * xr[m + k][j]; o[m][4 + j] += w1[j] * xr[m + k][4 + j]; } } }
#pragma unroll
        for (int m = 0; m < 4; ++m) { u32x4 w; w.x = pg8::cvt_pk_bf16(o[m][0], o[m][1]); w.y = pg8::cvt_pk_bf16(o[m][2], o[m][3]); w.z = pg8::cvt_pk_bf16(o[m][4], o[m][5]); w.w = pg8::cvt_pk_bf16(o[m][6], o[m][7]);
            Af[m][ks] = __builtin_bit_cast(bf16x8, w); }
    }
#pragma unroll
    for (int p = 0; p < 2; ++p) {
        const int chp = blk * 64 + 32 * p + 8 * fq;
#pragma unroll
        for (int dir = 0; dir < 2; ++dir) {
            float hinv[8];
            if (PASS == 2) {
                const int pos = dir == 0 ? c : (c < 4 ? 3 - c : 71 - c);
                float CA[8], CU[8];
#pragma unroll
                for (int j = 0; j < 8; ++j) { CA[j] = 1.f; CU[j] = 0.f; }
                for (int i = 5 * fr; i < 5 * fr + 5 && i < pos; ++i) {
                    const int cid = dir == 0 ? i : (i < 4 ? 3 - i : 71 - i);
                    const float* ap = P.agg + ((size_t)((dir * BATCH + b) * NCH + cid)) * 2048 + chp;
                    const f32x4 p0 = *(const f32x4*)(ap), p1 = *(const f32x4*)(ap + 4), s0 = *(const f32x4*)(ap + 1024), s1 = *(const f32x4*)(ap + 1028);
#pragma unroll
                    for (int j = 0; j < 4; ++j) { CU[j] = p0[j] * CU[j] + s0[j]; CA[j] = p0[j] * CA[j]; CU[4 + j] = p1[j] * CU[4 + j] + s1[j]; CA[4 + j] = p1[j] * CA[4 + j]; }
                }
                row_scan<0>(CA, CU);
#pragma unroll
                for (int j = 0; j < 8; ++j) hinv[j] = __int_as_float(__builtin_amdgcn_ds_bpermute(((lane & 48) | 15) << 2, __float_as_int(CU[j])));
            }
            f32x4 aR[4][2], aI[4][2];
#pragma unroll
            for (int nn = 0; nn < 2; ++nn) { const f32x4 vr = *(const f32x4*)(P.br + dir * DM + chp + 4 * nn), vi = *(const f32x4*)(P.bi + dir * DM + chp + 4 * nn);
#pragma unroll
                for (int m = 0; m < 4; ++m) { aR[m][nn] = vr; aI[m][nn] = vi; } }
#pragma unroll
            for (int gate = 0; gate < 2; ++gate) {
                bf16x8 Bf[2][2];
#pragma unroll
                for (int nn = 0; nn < 2; ++nn)
#pragma unroll
                    for (int ks = 0; ks < 2; ++ks) Bf[nn][ks] = *(const bf16x8*)(P.Wg + ((size_t)(((dir * 2 + gate) * 16 + blk) * 64 + 16 * (2 * p + nn) + fr)) * 64 + 32 * ks + 8 * fq);
#pragma unroll
                for (int m = 0; m < 4; ++m)
#pragma unroll
                    for (int nn = 0; nn < 2; ++nn)
#pragma unroll
                        for (int ks = 0; ks < 2; ++ks) { if (gate == 0) aR[m][nn] = __builtin_amdgcn_mfma_f32_16x16x32_bf16(Bf[nn][ks], Af[m][ks], aR[m][nn], 0, 0, 0);
                                                         else aI[m][nn] = __builtin_amdgcn_mfma_f32_16x16x32_bf16(Bf[nn][ks], Af[m][ks], aI[m][nn], 0, 0, 0); }
            }
            float c2v[8]; { const f32x4 x0 = *(const f32x4*)(P.c2 + dir * DM + chp), x1 = *(const f32x4*)(P.c2 + dir * DM + chp + 4); c2v[0] = x0[0]; c2v[1] = x0[1]; c2v[2] = x0[2]; c2v[3] = x0[3]; c2v[4] = x1[0]; c2v[5] = x1[1]; c2v[6] = x1[2]; c2v[7] = x1[3]; }
            float A[4][8], U[4][8];
#pragma unroll
            for (int m = 0; m < 4; ++m)
#pragma unroll
                for (int j = 0; j < 8; ++j) { const float rr = sigm(aR[m][j >> 2][j & 3]), ii = sigm(aI[m][j >> 2][j & 3]); const float av = __builtin_amdgcn_exp2f(rr * c2v[j]);
                    A[m][j] = av; U[m][j] = __builtin_amdgcn_sqrtf(fmaxf(1.f - av * av, 0.f)) * (ii * bfe(Af[m][p], j)); }
            if (dir == 0) {
#pragma unroll
                for (int m = 1; m < 4; ++m)
#pragma unroll
                    for (int j = 0; j < 8; ++j) { U[m][j] = A[m][j] * U[m - 1][j] + U[m][j]; A[m][j] = A[m][j] * A[m - 1][j]; }
            } else {
#pragma unroll
                for (int m = 2; m >= 0; --m)
#pragma unroll
                    for (int j = 0; j < 8; ++j) { U[m][j] = A[m][j] * U[m + 1][j] + U[m][j]; A[m][j] = A[m][j] * A[m + 1][j]; }
            }
            float TA[8], TU[8];
#pragma unroll
            for (int j = 0; j < 8; ++j) { TA[j] = A[dir ? 0 : 3][j]; TU[j] = U[dir ? 0 : 3][j]; }
            if (dir == 0) row_scan<0>(TA, TU); else row_scan<1>(TA, TU);
            if (PASS == 1) {
                if (fr == (dir ? 0 : 15)) { float* ap = P.agg + ((size_t)((dir * BATCH + b) * NCH + c)) * 2048 + chp;
                    *(f32x4*)(ap) = (f32x4){TA[0], TA[1], TA[2], TA[3]}; *(f32x4*)(ap + 4) = (f32x4){TA[4], TA[5], TA[6], TA[7]};
                    *(f32x4*)(ap + 1024) = (f32x4){TU[0], TU[1], TU[2], TU[3]}; *(f32x4*)(ap + 1028) = (f32x4){TU[4], TU[5], TU[6], TU[7]}; }
            } else {
                float s[8];
#pragma unroll
                for (int j = 0; j < 8; ++j) { const float hin = hinv[j];
                    const float EA = dir == 0 ? dpp<0x111>(1.f, TA[j]) : dpp<0x101>(1.f, TA[j]), EU = dir == 0 ? dpp<0x111>(0.f, TU[j]) : dpp<0x101>(0.f, TU[j]);
                    s[j] = EU + EA * hin; }
                if (dir == 0) {
#pragma unroll
                    for (int m = 0; m < 4; ++m) { float h[8];
#pragma unroll
                        for (int j = 0; j < 8; ++j) h[j] = U[m][j] + A[m][j] * s[j];
                        hfl[(2 * m) * 64 + lane] = (f32x4){h[0], h[1], h[2], h[3]}; hfl[(2 * m + 1) * 64 + lane] = (f32x4){h[4], h[5], h[6], h[7]}; }
                } else {
#pragma unroll
                    for (int m = 0; m < 4; ++m) { bf16* yp = P.Y + (size_t)(rbase + (isctx ? c : c - 4) * 64 + 4 * fr + m) * YC + 1024 + chp;
                        const u32x4 g = *(const u32x4*)yp; float gv[8];
                        gv[0] = __uint_as_float(g.x << 16); gv[1] = __uint_as_float(g.x & 0xffff0000u); gv[2] = __uint_as_float(g.y << 16); gv[3] = __uint_as_float(g.y & 0xffff0000u);
                        gv[4] = __uint_as_float(g.z << 16); gv[5] = __uint_as_float(g.z & 0xffff0000u); gv[6] = __uint_as_float(g.w << 16); gv[7] = __uint_as_float(g.w & 0xffff0000u);
                        float o[8];
                        const f32x4 h0 = hfl[(2 * m) * 64 + lane], h1 = hfl[(2 * m + 1) * 64 + lane]; const float hfv[8] = {h0[0], h0[1], h0[2], h0[3], h1[0], h1[1], h1[2], h1[3]};
#pragma unroll
                        for (int j = 0; j < 8; ++j) o[j] = (hfv[j] + U[m][j] + A[m][j] * s[j]) * gv[j];
                        u32x4 w; w.x = pg8::cvt_pk_bf16(o[0], o[1]); w.y = pg8::cvt_pk_bf16(o[2], o[3]); w.z = pg8::cvt_pk_bf16(o[4], o[5]); w.w = pg8::cvt_pk_bf16(o[6], o[7]);
                        *(u32x4*)yp = w; }
                }
            }
        }
    }
}
template <int PASS> __device__ __forceinline__ void phase(const Params& P, int gw, int NGW, int lane, LAS f32x4* hfl) {
    for (int it = gw; it < BATCH * NCH * 16; it += NGW) { const int blk = it & 15, bc = it >> 4; item<PASS>(P, bc / NCH, bc % NCH, blk, lane, hfl); }
}
#undef LAS
}

#include <hip/hip_bf16.h>
#include <cmath>
namespace attn_body {
using bf16=__hip_bfloat16;
using bf16x8=__attribute__((ext_vector_type(8)))short;
using s16x4=__attribute__((ext_vector_type(4)))short;
using f32x16=__attribute__((ext_vector_type(16)))float;
using u32x4=__attribute__((ext_vector_type(4)))unsigned;
constexpr int D=64, QP=2048  , KP=128  ;
constexpr int NW=8,QBLK=32,QB=QBLK*NW,KVBLK=64;
constexpr int ATTN_UNIT_ROWS=QB;
__device__ __forceinline__ int crow(int r,int hi){return (r&3)+8*(r>>2)+4*hi;}
#define SBAR() __builtin_amdgcn_sched_barrier(0)
__device__ __forceinline__ void wmask(f32x16&p0,f32x16&p1,int d,int hi){
  const float NEG=-INFINITY; const int kb=d+4*hi;
  #pragma unroll
  for(int r=0;r<16;++r){const int x=kb+(r&3)+8*(r>>2); if(x<-128||x>128)p0[r]=NEG; if(x+32<-128||x+32>128)p1[r]=NEG;}
}

constexpr int NSLOT=3, SLOTB=8192;
constexpr int LDS_K=0, LDS_V=NSLOT*SLOTB, LDS_WS=2*NSLOT*SLOTB, LDS_OST=LDS_WS+NW*64*4, LDS_BYTES=LDS_OST+NW*4096;
constexpr float C2=0.125f*1.4426950408889634f;
__device__ __forceinline__ void glds16(const void*gsrc,unsigned lds_dst){unsigned keep;
  asm volatile("s_mov_b32 %0, m0\n\ts_mov_b32 m0, %2\n\ts_nop 0\n\tglobal_load_lds_dwordx4 %1, off\n\ts_mov_b32 m0, %0":"=&s"(keep):"v"(gsrc),"s"(lds_dst):"memory");}
__device__ __forceinline__ float max3f(float a,float b,float c){float r;asm("v_max3_f32 %0, %1, %2, %3":"=v"(r):"v"(a),"v"(b),"v"(c));return r;}
__device__ __forceinline__ float max2f(float a,float b){float r;asm("v_max_f32_e32 %0, %1, %2":"=v"(r):"v"(a),"v"(b));return r;}
__device__ __forceinline__ float fadd_s(float a,float b){float r;asm("v_add_f32_e32 %0, %1, %2":"=v"(r):"v"(a),"v"(b));return r;}
__device__ __forceinline__ float fsub_s(float a,float b){float r;asm("v_sub_f32_e32 %0, %1, %2":"=v"(r):"v"(a),"v"(b));return r;}
typedef float f32x2_t __attribute__((ext_vector_type(2))); typedef __bf16 bf16x2_t __attribute__((ext_vector_type(2)));
__device__ __forceinline__ unsigned cvtpk_s(float lo,float hi){f32x2_t v={lo,hi};bf16x2_t b=__builtin_convertvector(v,bf16x2_t);return __builtin_bit_cast(unsigned,b);}
#define WAIT_BAR(N) asm volatile("s_waitcnt vmcnt(" #N ") lgkmcnt(0)\n\ts_barrier":::"memory")

__device__ __forceinline__ void qkt(f32x16&p0,f32x16&p1,const char*Kslot,const bf16x8*qr,const f32x16&negm,int r32,int hi){
  const char*kb=Kslot+hi*1024+r32*16;
  #pragma unroll
  for(int d0=0;d0<4;++d0){
    const bf16x8 b0=*reinterpret_cast<const bf16x8*>(kb+d0*2048);
    const bf16x8 b1=*reinterpret_cast<const bf16x8*>(kb+d0*2048+512);
    if(d0==0){p0=__builtin_amdgcn_mfma_f32_32x32x16_bf16(b0,qr[0],negm,0,0,0);p1=__builtin_amdgcn_mfma_f32_32x32x16_bf16(b1,qr[0],negm,0,0,0);}
    else{p0=__builtin_amdgcn_mfma_f32_32x32x16_bf16(b0,qr[d0],p0,0,0,0);p1=__builtin_amdgcn_mfma_f32_32x32x16_bf16(b1,qr[d0],p1,0,0,0);}}
}
typedef __attribute__((address_space(3))) const char* lds_cptr;
typedef short v4i16_t __attribute__((ext_vector_type(4)));
__device__ __forceinline__ void kload8(bf16x8*kf,lds_cptr kp){
  kf[0]=*(const __attribute__((address_space(3))) bf16x8*)(kp);      kf[1]=*(const __attribute__((address_space(3))) bf16x8*)(kp+512);
  kf[2]=*(const __attribute__((address_space(3))) bf16x8*)(kp+2048); kf[3]=*(const __attribute__((address_space(3))) bf16x8*)(kp+2560);
  kf[4]=*(const __attribute__((address_space(3))) bf16x8*)(kp+4096); kf[5]=*(const __attribute__((address_space(3))) bf16x8*)(kp+4608);
  kf[6]=*(const __attribute__((address_space(3))) bf16x8*)(kp+6144); kf[7]=*(const __attribute__((address_space(3))) bf16x8*)(kp+6656);
}
__device__ __forceinline__ void kload2(bf16x8*kf,lds_cptr kp,int j){ kf[2*j]=*(const __attribute__((address_space(3))) bf16x8*)(kp+j*2048); kf[2*j+1]=*(const __attribute__((address_space(3))) bf16x8*)(kp+j*2048+512); }
__device__ __forceinline__ s16x4 vtr(lds_cptr p){ return __builtin_bit_cast(s16x4,__builtin_amdgcn_ds_read_tr16_b64_v4i16((__attribute__((address_space(3))) v4i16_t*)p)); }
__device__ __forceinline__ float rowmax(const f32x16&p0,const f32x16&p1){
  float a=max3f(p0[0],p0[1],p1[0]),b=max3f(p0[2],p0[3],p1[1]);a=max3f(a,p1[2],p1[3]);
  #pragma unroll
  for(int r=4;r<16;r+=4){a=max3f(a,p0[r],p0[r+1]);b=max3f(b,p0[r+2],p0[r+3]);a=max3f(a,p1[r],p1[r+1]);b=max3f(b,p1[r+2],p1[r+3]);}
  const float m=max2f(a,b);
  auto rr=__builtin_amdgcn_permlane32_swap(__float_as_uint(m),__float_as_uint(m),false,false);
  return max2f(__uint_as_float(rr[0]),__uint_as_float(rr[1]));
}
__device__ __forceinline__ void pv(f32x16*o,int vb,bf16x8 pa0,bf16x8 pa1,bf16x8 pa2,bf16x8 pa3){
  #pragma unroll
  for(int d0=0;d0<2;++d0){s16x4 lo[4],hi[4];
    #pragma unroll
    for(int ks=0;ks<4;++ks){
      asm volatile("ds_read_b64_tr_b16 %0,%1 offset:%c2":"=&v"(lo[ks]):"v"(vb),"i"(d0*4096+ks*1024):"memory");
      asm volatile("ds_read_b64_tr_b16 %0,%1 offset:%c2":"=&v"(hi[ks]):"v"(vb),"i"(d0*4096+ks*1024+512):"memory");}
    asm volatile("s_waitcnt lgkmcnt(0)":::"memory");SBAR();
    #define PK(k) (bf16x8){lo[k][0],lo[k][1],lo[k][2],lo[k][3],hi[k][0],hi[k][1],hi[k][2],hi[k][3]}
    o[d0]=__builtin_amdgcn_mfma_f32_32x32x16_bf16(pa0,PK(0),o[d0],0,0,0);
    o[d0]=__builtin_amdgcn_mfma_f32_32x32x16_bf16(pa1,PK(1),o[d0],0,0,0);
    o[d0]=__builtin_amdgcn_mfma_f32_32x32x16_bf16(pa2,PK(2),o[d0],0,0,0);
    o[d0]=__builtin_amdgcn_mfma_f32_32x32x16_bf16(pa3,PK(3),o[d0],0,0,0);
    #undef PK
  }
}

#ifndef ATTN_STORE16
#define ATTN_STORE16(p,v) (*(u32x4*)(p)=(v))
#endif
struct UnitDesc { int qrow0, qcol, kvcol, NT, n0, r0, r1, mq0, mk0; float sink2; };
template<int KIND,int THRL> __device__ __forceinline__ void attn_unit(const UnitDesc&ud,bf16*Y,const bf16*__restrict__ K,const bf16*__restrict__ V,char*shm){
  int tid_=threadIdx.x; asm volatile("":"+v"(tid_));
  const int tid=tid_,lane=tid&63,r32=lane&31,hi=lane>>5; const int wid=__builtin_amdgcn_readfirstlane(tid>>6);
  const bf16*Qw=Y+(long)(ud.qrow0+wid*QBLK)*QP+ud.qcol;
  const bf16*Kh=K+ud.kvcol,*Vh=V+ud.kvcol;
  #define TROW(t) ((long)((t)<ud.n0?ud.r0+64*(t):ud.r1+64*((t)-ud.n0)))
  const unsigned lds0=(unsigned)(uintptr_t)shm;
  float*wsf=(float*)(shm+LDS_WS)+wid*64;
  const bf16*ksrc=Kh+(long)lane*KP+wid*8;
  const bf16*vsrc=Vh+(long)(16*(wid&3)+(lane>>2))*KP+(wid>>2)*32+(lane&3)*8;
  const unsigned kdst=lds0+LDS_K+wid*1024, vdst=lds0+LDS_V+wid*1024;
  #define DMA_K(t,slot) glds16(ksrc+TROW(t)*KP,(unsigned)__builtin_amdgcn_readfirstlane(kdst+(slot)))
  #define DMA_V(t,slot) glds16(vsrc+TROW(t)*KP,(unsigned)__builtin_amdgcn_readfirstlane(vdst+(slot)))
  const int vb0=(int)(lds0+LDS_V)+((lane>>4)&1)*32+(lane&3)*8+(4*hi+((lane&15)>>2))*64;
  const char*Kbase=shm+LDS_K; bf16x8 kf[8];
  const lds_cptr shm3=(lds_cptr)shm; const lds_cptr kp0=shm3+LDS_K+hi*1024+r32*16; const lds_cptr vp0=shm3+LDS_V+((lane>>4)&1)*32+(lane&3)*8+(4*hi+((lane&15)>>2))*64;
  const int NT=ud.NT;
  DMA_K(0,0);DMA_V(0,0);DMA_K(1,SLOTB);
  bf16x8 qr[4];
  #pragma unroll
  for(int d0=0;d0<4;++d0)qr[d0]=*reinterpret_cast<const bf16x8*>(&Qw[(long)r32*QP+d0*16+hi*8]);
  float mhat=0.f,l_reg=0.f;f32x16 o[2];o[0]=f32x16{};o[1]=f32x16{};f32x16 negm=f32x16{};asm volatile("":"+v"(negm));
  const int qoff=ud.mq0+wid*QBLK+r32;
  #define CMASK(P0,P1,t) do{ if(KIND==0&&(t)>=4)wmask(P0,P1,ud.mk0+64*((t)-4)-qoff,hi); }while(0)
  bool resc=false;
  #define START(P0,P1) do{ const float rm=rowmax(P0,P1); resc=false; \
    { const float dl=rm; mhat=fadd_s(mhat,dl); \
      _Pragma("unroll") for(int r=0;r<16;++r){P0[r]=fsub_s(P0[r],dl);P1[r]=fsub_s(P1[r],dl);} \
      _Pragma("unroll") for(int r=0;r<16;++r)negm[r]=-mhat; asm volatile("":"+v"(negm)); } \
    _Pragma("unroll") for(int r=0;r<16;++r)P0[r]=__builtin_amdgcn_exp2f(P0[r]); }while(0)
  #define RESC() do{ if(resc){ asm volatile("s_waitcnt lgkmcnt(0)":::"memory"); \
      _Pragma("unroll") for(int d_=0;d_<2;++d_) _Pragma("unroll") for(int r=0;r<16;++r)o[d_][r]*=wsf[crow(r,hi)]; } }while(0)
  f32x16 pA0,pA1,pB0,pB1;
  int sl_prev=0,sl_cur=0,sl_next=SLOTB;
  #define ROT() do{sl_prev=sl_cur;sl_cur=sl_next;sl_next=(sl_next==(NSLOT-1)*SLOTB)?0:sl_next+SLOTB;}while(0)
  DMA_K(2,2*SLOTB);
  WAIT_BAR(3);
  qkt(pA0,pA1,Kbase,qr,negm,r32,hi);asm volatile("s_nop 15\n\ts_nop 7":"+v"(pA0),"+v"(pA1));CMASK(pA0,pA1,0);
  START(pA0,pA1);
  _Pragma("unroll") for(int r=0;r<16;++r)pA1[r]=__builtin_amdgcn_exp2f(pA1[r]);
  WAIT_BAR(0);
  DMA_K(3,0);DMA_V(1,SLOTB);
  ROT();
  kload8(kf,kp0+sl_cur);
  WAIT_BAR(2);
  s16x4 vlo[8],vhi[8]; u32x4 pw0,pw1,pw2,pw3;
  #define PKW(P,B) cvtpk_s(P[B],P[B+1])
  #define PAF(k) __builtin_bit_cast(bf16x8,pw##k)
  #define VFR(i) (bf16x8){vlo[i][0],vlo[i][1],vlo[i][2],vlo[i][3],vhi[i][0],vhi[i][1],vhi[i][2],vhi[i][3]}
  #define PIN(x) asm volatile("":"+v"(x))
  #define MX3(a,b,c) __builtin_fmaxf(__builtin_fmaxf((a),(b)),(c))
  #define GAPA(MF,A0,A1,A2,A3,W0,W1,PW) do{ MF; sacc+=A0; sacc+=A1; sacc+=A2; sacc+=A3; PIN(sacc); W0; W1; PIN(PW); SBAR(); }while(0)
  #define EX(v) __builtin_amdgcn_exp2f(v)
  #define GAPB(MF,X,B) do{ MF; X[B]=EX(X[B]); X[B+1]=EX(X[B+1]); X[B+2]=EX(X[B+2]); X[B+3]=EX(X[B+3]); PIN(X); SBAR(); }while(0)
  #define VRD(i) do{ vlo[i]=vtr(vp_+(((i)>>2)*4096+((i)&3)*1024)); vhi[i]=vtr(vp_+(((i)>>2)*4096+((i)&3)*1024+512)); }while(0)
  #define KRD(G,j) do{ if(G){ kload2(kf,kp0+sl_next,j); SBAR(); } }while(0)
  #define STEP(C0,C1,P0,P1,t,GK,GV,GL) do{ SBAR(); \
    const lds_cptr vp_=vp0+sl_prev; \
    VRD(0); SBAR(); float sacc=(P0[0]+P0[1]); \
    GAPA(C0=__builtin_amdgcn_mfma_f32_32x32x16_bf16(kf[0],qr[0],negm,0,0,0), P0[2],P0[3],P0[4],P0[5],     pw0[0]=PKW(P0,0), pw0[1]=PKW(P0,2), pw0); \
    VRD(4); SBAR(); GAPA(C1=__builtin_amdgcn_mfma_f32_32x32x16_bf16(kf[1],qr[0],negm,0,0,0), P0[6],P0[7],P0[8],P0[9],     pw0[2]=PKW(P0,4), pw0[3]=PKW(P0,6), pw0); \
    VRD(1); SBAR(); GAPA(C0=__builtin_amdgcn_mfma_f32_32x32x16_bf16(kf[2],qr[1],C0,0,0,0),   P0[10],P0[11],P0[12],P0[13], pw1[0]=PKW(P0,8), pw1[1]=PKW(P0,10), pw1); \
    VRD(5); SBAR(); GAPA(C1=__builtin_amdgcn_mfma_f32_32x32x16_bf16(kf[3],qr[1],C1,0,0,0),   P0[14],P0[15],P1[0],P1[1],   pw1[2]=PKW(P0,12),pw1[3]=PKW(P0,14), pw1); \
    VRD(2); SBAR(); GAPA(C0=__builtin_amdgcn_mfma_f32_32x32x16_bf16(kf[4],qr[2],C0,0,0,0),   P1[2],P1[3],P1[4],P1[5],     pw2[0]=PKW(P1,0), pw2[1]=PKW(P1,2), pw2); \
    VRD(6); SBAR(); GAPA(C1=__builtin_amdgcn_mfma_f32_32x32x16_bf16(kf[5],qr[2],C1,0,0,0),   P1[6],P1[7],P1[8],P1[9],     pw2[2]=PKW(P1,4), pw2[3]=PKW(P1,6), pw2); \
    VRD(3); SBAR(); GAPA(C0=__builtin_amdgcn_mfma_f32_32x32x16_bf16(kf[6],qr[3],C0,0,0,0),   P1[10],P1[11],P1[12],P1[13], pw3[0]=PKW(P1,8), pw3[1]=PKW(P1,10), pw3); \
    VRD(7); SBAR(); GAPA(C1=__builtin_amdgcn_mfma_f32_32x32x16_bf16(kf[7],qr[3],C1,0,0,0),   P1[14],P1[15],0.f,0.f,       pw3[2]=PKW(P1,12),pw3[3]=PKW(P1,14), pw3); \
    l_reg+=sacc; \
    if(GK){DMA_K((t)+3,sl_cur);} if(GV){DMA_V((t)+1,sl_next);} \
    CMASK(C0,C1,t); \
    { float a=MX3(C0[0],C0[1],C1[0]),b=MX3(C0[2],C0[3],C1[1]); a=MX3(a,C1[2],C1[3]); \
      _Pragma("unroll") for(int r=4;r<16;r+=4){a=MX3(a,C0[r],C0[r+1]);b=MX3(b,C0[r+2],C0[r+3]);a=MX3(a,C1[r],C1[r+1]);b=MX3(b,C1[r+2],C1[r+3]);} \
      float rm=__builtin_fmaxf(a,b); { auto rr=__builtin_amdgcn_permlane32_swap(__float_as_uint(rm),__float_as_uint(rm),false,false); rm=__builtin_fmaxf(__uint_as_float(rr[0]),__uint_as_float(rr[1])); } \
      resc=false; \
      if(__builtin_expect(__any(rm>(float)THRL),0)){ const float dl=__builtin_fmaxf(rm,0.f); mhat+=dl; \
        _Pragma("unroll") for(int r=0;r<16;++r){C0[r]-=dl;C1[r]-=dl;} \
        _Pragma("unroll") for(int r=0;r<16;++r)negm[r]=-mhat; asm volatile("":"+v"(negm)); \
        const float f=__builtin_amdgcn_exp2f(-dl); l_reg*=f; if(hi==0)wsf[r32]=f; resc=true; } } \
    SBAR(); \
    GAPB(o[0]=__builtin_amdgcn_mfma_f32_32x32x16_bf16(PAF(0),VFR(0),o[0],0,0,0), C0,0); \
    GAPB(o[1]=__builtin_amdgcn_mfma_f32_32x32x16_bf16(PAF(0),VFR(4),o[1],0,0,0), C0,4); \
    KRD(GL,0); GAPB(o[0]=__builtin_amdgcn_mfma_f32_32x32x16_bf16(PAF(1),VFR(1),o[0],0,0,0), C0,8); \
    KRD(GL,1); GAPB(o[1]=__builtin_amdgcn_mfma_f32_32x32x16_bf16(PAF(1),VFR(5),o[1],0,0,0), C0,12); \
    KRD(GL,2); GAPB(o[0]=__builtin_amdgcn_mfma_f32_32x32x16_bf16(PAF(2),VFR(2),o[0],0,0,0), C1,0); \
    KRD(GL,3); GAPB(o[1]=__builtin_amdgcn_mfma_f32_32x32x16_bf16(PAF(2),VFR(6),o[1],0,0,0), C1,4); \
    GAPB(o[0]=__builtin_amdgcn_mfma_f32_32x32x16_bf16(PAF(3),VFR(3),o[0],0,0,0), C1,8); \
    GAPB(o[1]=__builtin_amdgcn_mfma_f32_32x32x16_bf16(PAF(3),VFR(7),o[1],0,0,0), C1,12); \
    }while(0)
  int t=1;
  for(;t+5<NT;t+=2){
    STEP(pB0,pB1,pA0,pA1,t,true,true,true);     WAIT_BAR(2); RESC(); ROT();
    STEP(pA0,pA1,pB0,pB1,t+1,true,true,true);   WAIT_BAR(2); RESC(); ROT();
  }
  #define ENDW(tt) do{ if((tt)+3<NT){WAIT_BAR(2);} else if((tt)+2<NT){WAIT_BAR(1);} else {WAIT_BAR(0);} }while(0)
  for(;t+1<NT;t+=2){
    STEP(pB0,pB1,pA0,pA1,t,(t+3<NT),(t+1<NT),(t+1<NT));       ENDW(t);   RESC(); ROT();
    STEP(pA0,pA1,pB0,pB1,t+1,(t+4<NT),(t+2<NT),(t+2<NT));     ENDW(t+1); RESC(); ROT();
  }
  STEP(pB0,pB1,pA0,pA1,NT-1,false,false,false); RESC();
  { float sacc=pB0[0]+pB0[1]; _Pragma("unroll") for(int r=2;r<16;++r)sacc+=pB0[r]; _Pragma("unroll") for(int r=0;r<16;++r)sacc+=pB1[r]; l_reg+=sacc;
    pw0=(u32x4){PKW(pB0,0),PKW(pB0,2),PKW(pB0,4),PKW(pB0,6)};pw1=(u32x4){PKW(pB0,8),PKW(pB0,10),PKW(pB0,12),PKW(pB0,14)};pw2=(u32x4){PKW(pB1,0),PKW(pB1,2),PKW(pB1,4),PKW(pB1,6)};pw3=(u32x4){PKW(pB1,8),PKW(pB1,10),PKW(pB1,12),PKW(pB1,14)};
    SBAR(); pv(o,vb0+sl_cur,PAF(0),PAF(1),PAF(2),PAF(3)); }
  #undef PKW
  #undef PAF
  #undef VFR
  #undef PIN
  #undef MX3
  #undef GAPA
  #undef GAPB
  #undef EX
  #undef VRD
  #undef KRD
  #undef STEP
  #undef ENDW
  {auto rr=__builtin_amdgcn_permlane32_swap(__float_as_uint(l_reg),__float_as_uint(l_reg),false,false);l_reg=__uint_as_float(rr[0])+__uint_as_float(rr[1]);}
  if(KIND==0)l_reg+=__builtin_amdgcn_exp2f(ud.sink2-mhat);
  if(hi==0)wsf[32+r32]=l_reg;asm volatile("s_waitcnt lgkmcnt(0)":::"memory");
  float rli[16];
  #pragma unroll
  for(int r=0;r<16;++r)rli[r]=__builtin_amdgcn_rcpf(wsf[32+crow(r,hi)]);
  bf16*Ow=Y+(long)(ud.qrow0+wid*QBLK)*QP+ud.qcol;
  { bf16*stg=(bf16*)(shm+LDS_OST)+wid*2048;
    #pragma unroll
    for(int r=0;r<16;++r){const int orow=crow(r,hi);
      #pragma unroll
      for(int d0=0;d0<2;++d0)stg[orow*64+d0*32+r32]=__float2bfloat16(o[d0][r]*rli[r]);}
    asm volatile("s_waitcnt lgkmcnt(0)":::"memory");
    #pragma unroll
    for(int i=0;i<4;++i){const int row=i*8+(lane>>3),ch=lane&7; const u32x4 v=*(const u32x4*)(stg+row*64+ch*8); ATTN_STORE16(Ow+(long)row*QP+ch*8,v);} }
  asm volatile("s_waitcnt lgkmcnt(0)\n\ts_barrier":::"memory");
  #undef DMA_K
  #undef DMA_V
  #undef TROW
  #undef CMASK
  #undef START
  #undef RESC
  #undef ROT
}
constexpr int ATTN_LDS_BYTES=LDS_BYTES;
#undef SBAR
#undef WAIT_BAR
}

#ifndef PG8_SP2
#define PG8_SP2 true
#endif
#ifndef PG8_ALIGN
#define PG8_ALIGN true
#endif

#ifndef PG8_SP2
#define PG8_SP2 true
#endif
#ifndef PG8_ALIGN
#define PG8_ALIGN true
#endif
constexpr int NWAVES = 8;
constexpr int RING_OFF = 0, RING_BYTES = 131072;
constexpr int LDSCTL_OFF = RING_BYTES, MISC_OFF = LDSCTL_OFF + 320;
constexpr int LDS_BYTES = 147456;
constexpr size_t WS_W = 1 * MiB;
constexpr size_t WO_IN = 0, WO_MERGE = 13 * MiB, WO_OUT = 17 * MiB, WO_FF1 = 19 * MiB, WO_FF2 = 27 * MiB, WO_LRU = 35 * MiB;
constexpr int CW_TMO = 0, CW_CODE = 1, CW_BAR = 4096;
constexpr size_t CTL_ZERO_BYTES = 64 * 1024;

#define GAS __attribute__((address_space(1)))
#define LAS __attribute__((address_space(3)))
typedef unsigned v4u __attribute__((ext_vector_type(4)));
typedef float f32x4 __attribute__((ext_vector_type(4)));
typedef short bf16x8 __attribute__((ext_vector_type(8)));
typedef GAS unsigned gu32;
typedef GAS unsigned long long gu64;
#define RLX_AGENT __ATOMIC_RELAXED, __HIP_MEMORY_SCOPE_AGENT
#define LDS_WAIT() asm volatile("s_waitcnt lgkmcnt(0)" ::: "memory")
#define VM_WAIT() asm volatile("s_waitcnt vmcnt(0)" ::: "memory")
__device__ __forceinline__ unsigned long long rt() { return __builtin_amdgcn_s_memrealtime(); }
__device__ __forceinline__ unsigned f2bfu(float f) { unsigned u = __builtin_bit_cast(unsigned, f); return (u + 0x7fffu + ((u >> 16) & 1u)) >> 16; }
__device__ __forceinline__ unsigned pk2(float lo, float hi) { return f2bfu(lo) | (f2bfu(hi) << 16); }

#define XB_TMO      128
#define XB_XCNT(j)  (256  + 64 * (j))
#define XB_XSUB(j)  (1280 + 64 * (j))
#define XB_XGEN(j)  (2304 + 64 * (j))
#define XB_TOP      3328
#define XB_TOPGEN   3392
#define XCD_BAR_WORDS 3456
#define XB_SPIN_CAP (1u << 18)

__device__ __forceinline__ unsigned xb_ld(unsigned* p)              { return __hip_atomic_load(p, __ATOMIC_RELAXED, __HIP_MEMORY_SCOPE_AGENT); }
__device__ __forceinline__ unsigned xb_add(unsigned* p, unsigned v) { return __hip_atomic_fetch_add(p, v, __ATOMIC_RELAXED, __HIP_MEMORY_SCOPE_AGENT); }
__device__ __forceinline__ unsigned xb_xcc_id() { return (unsigned)__builtin_amdgcn_s_getreg((3 << 11) | 20) & 0xFu; }
#define XB_SPIN(cond, bar) do { unsigned _sp = 0; while (cond) { __builtin_amdgcn_s_sleep(1); \
    if ((++_sp & 255u) == 0u) { if (xb_ld(&(bar)[XB_TMO])) break; if (_sp > XB_SPIN_CAP) { atomicAdd(&(bar)[XB_TMO], 1u); break; } } } } while (0)

struct XcdBarrier {
    unsigned* bar; unsigned x;
    volatile LAS unsigned* st;
};

__device__ __forceinline__ XcdBarrier xcd_barrier_post(unsigned* bar, volatile LAS unsigned* st) {
    XcdBarrier b; b.bar = bar; b.x = xb_xcc_id(); b.st = st;
    if (threadIdx.x == 0) (void)xb_add(&bar[XB_XCNT(b.x)], 1u);
    return b;
}
__device__ __forceinline__ void xcd_barrier_complete(unsigned* bar, unsigned x, unsigned& nloc, unsigned& nx) {
    const unsigned G = gridDim.x * gridDim.y * gridDim.z;
    unsigned sum, cnt, mine, sp = 0u;
    for (;;) {
        sum = 0u; cnt = 0u; mine = 0u;
#pragma unroll
        for (unsigned j = 0; j < 16; ++j) { const unsigned c = xb_ld(&bar[XB_XCNT(j)]); sum += c; cnt += (c > 0u) ? 1u : 0u; mine = (j == x) ? c : mine; }
        if (sum == G) break;
        __builtin_amdgcn_s_sleep(1);
        if ((++sp & 255u) == 0u) { if (xb_ld(&bar[XB_TMO])) break; if (sp > XB_SPIN_CAP) { atomicAdd(&bar[XB_TMO], 1u); break; } }
    }
    nloc = mine > 0u ? mine : 1u; nx = cnt > 0u ? cnt : 1u;
}

__device__ __forceinline__ void xcd_barrier(const XcdBarrier& b) {
    asm volatile("s_waitcnt vmcnt(0)" ::: "memory");
    __syncthreads();
    if (threadIdx.x == 0) {
        unsigned* bar = b.bar;
        __builtin_amdgcn_s_waitcnt(0);
        unsigned nloc = b.st[0], nx = b.st[1];
        if (nloc == 0u) { xcd_barrier_complete(bar, b.x, nloc, nx); b.st[0] = nloc; b.st[1] = nx; }
        const unsigned old = xb_add(&bar[XB_XSUB(b.x)], 1u);
        const unsigned gen = old / nloc;
        if (old + 1u == (gen + 1u) * nloc) {
            __builtin_amdgcn_fence(__ATOMIC_RELEASE, "agent");
            asm volatile("s_waitcnt vmcnt(0)" ::: "memory");
            const unsigned og = xb_add(&bar[XB_TOP], 1u);
            const unsigned tg = og / nx;
            if (og + 1u == (tg + 1u) * nx) xb_add(&bar[XB_TOPGEN], 1u);
            else XB_SPIN(xb_ld(&bar[XB_TOPGEN]) == tg, bar);
            __builtin_amdgcn_fence(__ATOMIC_ACQUIRE, "agent");
            xb_add(&bar[XB_XGEN(b.x)], 1u);
            asm volatile("s_waitcnt vmcnt(0)" ::: "memory");
        } else {
            XB_SPIN(xb_ld(&bar[XB_XGEN(b.x)]) == gen, bar);
            __builtin_amdgcn_fence(__ATOMIC_ACQUIRE, "agent");
            asm volatile("s_waitcnt vmcnt(0)" ::: "memory");
        }
    }
    __syncthreads();
}


template <int KIND> __device__ __forceinline__ void attn_latent(char* lds, bf16* Y, const bf16* K, const bf16* V, int vcu, int G, const float* sink) {
    for (int U = vcu; U < 512; U += G) {
        const int grp = (U & 255) >> 5, loc = U & 31, u = loc * 2 + (U >> 8), b = grp >> 1, kvh = grp & 1, h = kvh * 4 + (u >> 4), qb = u & 15;
        attn_body::UnitDesc ud; ud.qrow0 = b * SEQ + 256 * qb; ud.qcol = (KIND == 0 ? 0 : 512) + h * 64; ud.kvcol = kvh * 64;
        if (KIND == 1) { ud.NT = 68; ud.n0 = 64; ud.r0 = b * SEQ; ud.r1 = NLAT + b * CTXL; ud.mq0 = 0; ud.mk0 = 0; ud.sink2 = 0.f; }
        else { const int tl0 = 4 * qb - 2 < 0 ? 0 : 4 * qb - 2, tl1 = 4 * qb + 5 > 63 ? 63 : 4 * qb + 5;
            ud.NT = 4 + (tl1 - tl0 + 1); ud.n0 = 4; ud.r0 = NLAT + b * CTXL; ud.r1 = b * SEQ + 64 * tl0; ud.mq0 = 256 * qb; ud.mk0 = 64 * tl0; ud.sink2 = sink[h] * LOG2E; }
        attn_body::attn_unit<KIND, 8>(ud, (attn_body::bf16*)Y, (const attn_body::bf16*)K, (const attn_body::bf16*)V, lds);
    }
}
template <int KIND> __device__ __forceinline__ void attn_context(char* lds, bf16* Y, const bf16* K, const bf16* V, int vcu, int G, const float* sink) {
    for (int j = 0; j < 32; ++j) {
        const int b = j >> 3, h = j & 7, kvh = h >> 2, tgt = ((b * 2 + kvh) * 32 + 8 + (h & 3) + 4 * KIND) % G;
        if (tgt != vcu) continue;
        attn_body::UnitDesc ud; ud.qrow0 = NLAT + b * CTXL; ud.qcol = (KIND == 0 ? 0 : 512) + h * 64; ud.kvcol = kvh * 64;
        ud.NT = 4; ud.n0 = 4; ud.r0 = NLAT + b * CTXL; ud.r1 = 0; ud.mq0 = 0; ud.mk0 = 0; ud.sink2 = KIND == 0 ? sink[h] * LOG2E : 0.f;
        attn_body::attn_unit<KIND, 8>(ud, (attn_body::bf16*)Y, (const attn_body::bf16*)K, (const attn_body::bf16*)V, lds);
    }
}

#ifndef ATTN_ON
#define ATTN_ON 1
#endif
#ifndef PHMASK
#define PHMASK 0xffffffffu
#endif
#define PHM(p) ((PHMASK >> (p)) & 1u)
struct MkArgs { const float* in[27]; float* out; unsigned char* ws; int ph_lo, ph_hi, layer, pad; };
struct Frame {
    LAS unsigned char* lds; volatile LAS unsigned* MISC; gu32* ctl;
    int tid, lane, wave, vcu, G;
};
enum { PH_PRO = 0, PH_W = 1, PH_G1A = 2, PH_MIX1 = 3, PH_MIX2 = 4, PH_G1B = 5, PH_MERGE = 6, PH_OUT = 7, PH_LN1 = 8, PH_FF1 = 9, PH_FF2 = 10, PH_LN2 = 11, PH_COUNT = 12 };

__device__ __forceinline__ int tt_of_tile(int kind, int tile) { return kind == 0 ? pg8::TT_IDENT : kind == 1 ? pg8::TT_NAT8 : (tile < 6 ? pg8::TT_HEAD : pg8::TT_NAT8); }
__device__ __forceinline__ void transpose_item(const float* W, int ldw, int N, bf16* WT, int dpitch, int koff, int kind, LAS float* scr, int item, int lane) {
    const int nblk = N / 32, kb = item / nblk, nb = item % nblk, k0 = 64 * kb, n0 = 32 * nb;
#pragma unroll 8
    for (int i = 0; i < 32; ++i) { const int kk = 2 * i + (lane >> 5); scr[kk * 33 + (lane & 31)] = W[(size_t)(k0 + kk) * ldw + n0 + (lane & 31)]; }
    LDS_WAIT(); asm volatile("" ::: "memory");
    const int c = lane & 7;
#pragma unroll
    for (int j = 0; j < 4; ++j) { const int n = (lane >> 3) + 8 * j; const LAS float* s = scr + (8 * c) * 33 + n;
        v4u o; o.x = pk2(s[0 * 33], s[1 * 33]); o.y = pk2(s[2 * 33], s[3 * 33]); o.z = pk2(s[4 * 33], s[5 * 33]); o.w = pk2(s[6 * 33], s[7 * 33]);
        const int cl = n0 + n, tile = cl >> 8, drow = tile * 256 + pg8::tile_pos_of_logical(tt_of_tile(kind, tile), cl & 255);
        *(GAS v4u*)(WT + (size_t)drow * dpitch + koff + k0 + 8 * c) = o; }
    LDS_WAIT(); asm volatile("" ::: "memory");
}
__device__ __forceinline__ void phase_weights(Frame& F, const MkArgs& a, int l) {
    LAS float* scr = (LAS float*)(F.lds + RING_OFF + F.wave * 16384);
    const int gw = F.vcu * NWAVES + F.wave, NGW = F.G * NWAVES;
    bf16* wb = (bf16*)(a.ws + WS_W);
    bf16 *Wi = wb + WO_IN / 2, *Wm = wb + WO_MERGE / 2, *Wo = wb + WO_OUT / 2, *W1 = wb + WO_FF1 / 2, *W2 = wb + WO_FF2 / 2;
    const float* w_in = a.in[6] + (size_t)l * DM * INC; const float* wa = a.in[17] + (size_t)l * 512 * DM; const float* wbb = a.in[18] + (size_t)l * 512 * DM; const float* wc = a.in[19] + (size_t)l * DM * DM;
    const float* wo = a.in[20] + (size_t)l * DM * DM; const float* w1 = a.in[23] + (size_t)l * DM * DFF; const float* w2 = a.in[24] + (size_t)l * DFF * DM;
    constexpr int I_IN = 16 * (INC / 32), I_A = 8 * 32, I_C = 16 * 32, I_O = 16 * 32, I_1 = 16 * (DFF / 32), I_2 = 64 * 32;
    constexpr int NITEMS = I_IN + 2 * I_A + I_C + I_O + I_1 + I_2;
    for (int it = gw; it < NITEMS; it += NGW) {
        int r = it;
        if (r < I_IN) { transpose_item(w_in, INC, INC, Wi, DM, 0, 2, scr, r, F.lane); continue; } r -= I_IN;
        if (r < I_A) { transpose_item(wa, DM, DM, Wm, YC, 0, 1, scr, r, F.lane); continue; } r -= I_A;
        if (r < I_A) { transpose_item(wbb, DM, DM, Wm, YC, 512, 1, scr, r, F.lane); continue; } r -= I_A;
        if (r < I_C) { transpose_item(wc, DM, DM, Wm, YC, 1024, 1, scr, r, F.lane); continue; } r -= I_C;
        if (r < I_O) { transpose_item(wo, DM, DM, Wo, DM, 0, 0, scr, r, F.lane); continue; } r -= I_O;
        if (r < I_1) { transpose_item(w1, DFF, DFF, W1, DM, 0, 1, scr, r, F.lane); continue; } r -= I_1;
        transpose_item(w2, DM, DM, W2, DFF, 0, 0, scr, r, F.lane);
    }
    { bf16* Wg = wb + WO_LRU / 2; const float* wr = a.in[12] + (size_t)l * 2 * 16 * 4096; const float* wi = a.in[14] + (size_t)l * 2 * 16 * 4096;
      for (int idx = gw * 64 + F.lane; idx < 2 * 2 * 16 * 64 * 8; idx += NGW * 64) {
          const int dc = idx & 7, rho = (idx >> 3) & 63, blk = (idx >> 9) & 15, gate = (idx >> 13) & 1, dir = idx >> 14;
          const int n = rho >> 4, i = rho & 15, e = 32 * (n >> 1) + 8 * (i >> 2) + 4 * (n & 1) + (i & 3);
          const float* src = (gate ? wi : wr) + ((size_t)(dir * 16 + blk) * 64 + dc * 8) * 64 + e;
          v4u o; o.x = pk2(src[0], src[64]); o.y = pk2(src[128], src[192]); o.z = pk2(src[256], src[320]); o.w = pk2(src[384], src[448]);
          *(GAS v4u*)(Wg + (size_t)(idx >> 3) * 64 + dc * 8) = o; }
      float* c2 = (float*)(a.ws + WS_LRUC); const float* lam = a.in[16] + (size_t)l * 2 * DM;
      for (int idx = gw * 64 + F.lane; idx < 2 * DM; idx += NGW * 64) c2[idx] = -8.f * 1.4426950408889634f * log1pf(__expf(-lam[idx])); }
}


__device__ __forceinline__ float wave_sum(float v) {
#pragma unroll
    for (int o = 1; o < 64; o <<= 1) v += __shfl_xor(v, o);
    return v;
}
__device__ __forceinline__ void phase_pro(Frame& F, const MkArgs& a, float* mod, float* rope) {
    LAS float* red = (LAS float*)(F.lds + RING_OFF);
    const float* c = a.in[1]; const float* c_ctx = a.in[3]; const float* w_ada = a.in[4]; const float* b_ada = a.in[5];
    for (int it = F.vcu; it < DEPTH * 96; it += F.G) {
        const int l = it / 96, n = (it % 96) * 64 + F.lane;
        float acc[5] = {0.f, 0.f, 0.f, 0.f, 0.f};
        const float* wp = w_ada + ((size_t)l * DM + F.wave * 128) * 6144 + n;
#pragma unroll 4
        for (int k = 0; k < 128; ++k) { const float w = wp[(size_t)k * 6144]; const int kk = F.wave * 128 + k;
#pragma unroll
            for (int v = 0; v < 5; ++v) { const float x = v < 4 ? c[v * DM + kk] : c_ctx[kk]; acc[v] += (x / (1.f + __expf(-x))) * w; } }
        __syncthreads();
#pragma unroll
        for (int v = 0; v < 5; ++v) red[(F.wave * 5 + v) * 64 + F.lane] = acc[v];
        __syncthreads();
        if (F.wave < 5) { float s = b_ada[l * 6144 + n];
#pragma unroll
            for (int w = 0; w < 8; ++w) s += red[(w * 5 + F.wave) * 64 + F.lane];
            mod[((size_t)l * 5 + F.wave) * 6144 + n] = s; }
    }
    if (blockIdx.x == 0) for (int i = F.tid; i < 1024; i += NWAVES * 64) { const int pos = i / 16, f = i % 16;
        float inv = 1.f;
        inv = f == 1 ? 5.623413324e-01f : inv; inv = f == 2 ? 3.162277639e-01f : inv; inv = f == 3 ? 1.778279394e-01f : inv; inv = f == 4 ? 1.000000015e-01f : inv; inv = f == 5 ? 5.623413250e-02f : inv;
        inv = f == 6 ? 3.162277490e-02f : inv; inv = f == 7 ? 1.778279431e-02f : inv; inv = f == 8 ? 9.999999776e-03f : inv; inv = f == 9 ? 5.623413250e-03f : inv; inv = f == 10 ? 3.162277630e-03f : inv;
        inv = f == 11 ? 1.778279431e-03f : inv; inv = f == 12 ? 1.000000047e-03f : inv; inv = f == 13 ? 5.623413017e-04f : inv; inv = f == 14 ? 3.162277571e-04f : inv; inv = f == 15 ? 1.778279402e-04f : inv;
        const float ang = (float)pos * inv; rope[i] = cosf(ang); rope[1024 + i] = sinf(ang); }
}
__device__ __forceinline__ void phase_modulate(Frame& F, const float* xlat, const float* xctx, const float* modl, int sh_off, int sc_off, bf16* H) {
    const int gw = F.vcu * NWAVES + F.wave, NGW = F.G * NWAVES;
    for (int row = gw; row < NROW; row += NGW) {
        const float* xr = row < NLAT ? xlat + (size_t)row * DM : xctx + (size_t)(row - NLAT) * DM; const float* m = modl + (size_t)(row < NLAT ? row / SEQ : 4) * 6144;
        GAS unsigned long long* o8 = (GAS unsigned long long*)(H + (size_t)row * DM) + F.lane;
#pragma unroll
        for (int j = 0; j < 4; ++j) { const int c = 4 * F.lane + 256 * j; const f32x4 v = *(const f32x4*)(xr + c), sc = *(const f32x4*)(m + sc_off + c), sh = *(const f32x4*)(m + sh_off + c);
            const f32x4 y = v * (sc + 1.f) + sh; o8[64 * j] = (unsigned long long)pk2(y.x, y.y) | ((unsigned long long)pk2(y.z, y.w) << 32); }
    }
}
__device__ __forceinline__ void phase_ln(Frame& F, float* xlat, float* xctx, const float* g, const float* bta, const float* modl, int sh_off, int sc_off, bf16* H) {
    const int gw = F.vcu * NWAVES + F.wave, NGW = F.G * NWAVES;
    for (int row = gw; row < NROW; row += NGW) {
        float* xr = row < NLAT ? xlat + (size_t)row * DM : xctx + (size_t)(row - NLAT) * DM;
        f32x4 v[4]; float s = 0.f;
#pragma unroll
        for (int j = 0; j < 4; ++j) { v[j] = *(const f32x4*)(xr + 4 * F.lane + 256 * j); s += (v[j].x + v[j].y) + (v[j].z + v[j].w); }
        const float mean = wave_sum(s) * (1.f / DM); float q = 0.f;
#pragma unroll
        for (int j = 0; j < 4; ++j) { v[j] = v[j] - mean; q += (v[j].x * v[j].x + v[j].y * v[j].y) + (v[j].z * v[j].z + v[j].w * v[j].w); }
        const float rstd = 1.f / sqrtf(wave_sum(q) * (1.f / DM) + LN_EPS);
        const float* m = modl ? modl + (size_t)(row < NLAT ? row / SEQ : 4) * 6144 : nullptr;
        GAS unsigned long long* o8 = (GAS unsigned long long*)(H + (size_t)row * DM) + F.lane;
#pragma unroll
        for (int j = 0; j < 4; ++j) { const int c = 4 * F.lane + 256 * j; const f32x4 y = v[j] * rstd * *(const f32x4*)(g + c) + *(const f32x4*)(bta + c);
            *(f32x4*)(xr + c) = y;
            if (modl) { const f32x4 z = y * (*(const f32x4*)(m + sc_off + c) + 1.f) + *(const f32x4*)(m + sh_off + c); o8[64 * j] = (unsigned long long)pk2(z.x, z.y) | ((unsigned long long)pk2(z.z, z.w) << 32); } }
    }
}

__global__ void __launch_bounds__(NWAVES * 64, 2) mk_fwd(MkArgs args) {
    extern __shared__ __attribute__((aligned(16))) unsigned char lds[];
    Frame F;
    F.lds = (LAS unsigned char*)lds; F.MISC = (volatile LAS unsigned*)(F.lds + MISC_OFF);
    F.tid = threadIdx.x; F.lane = F.tid & 63; F.wave = __builtin_amdgcn_readfirstlane(F.tid >> 6);
    F.G = gridDim.x; { const int bx = blockIdx.x; F.vcu = (F.G % 8 == 0) ? (bx % 8) * (F.G / 8) + bx / 8 : bx; }
    F.ctl = (gu32*)(args.ws + WS_CTL);
    for (int u = F.tid; u < (LDS_BYTES - LDSCTL_OFF) / 4; u += NWAVES * 64) ((LAS unsigned*)(F.lds + LDSCTL_OFF))[u] = 0u;
    __syncthreads();
    XcdBarrier bar = xcd_barrier_post((unsigned*)(F.ctl + CW_BAR), F.MISC + 8);
    const int lo = args.ph_lo, hi = args.ph_hi;
    for (int gp = lo; gp < hi; ++gp) {
        const int l = gp / PH_COUNT, ph = gp % PH_COUNT;
        unsigned long long wsi_ = (unsigned long long)args.ws; asm volatile("" : "+s"(wsi_)); unsigned char* ws = (unsigned char*)(GAS unsigned char*)wsi_;
        float* mod = (float*)(ws + WS_MOD); float* rope = (float*)(ws + WS_ROPE); float* ctxs = (float*)(ws + WS_CTXS);
        bf16* H = (bf16*)(ws + WS_H); bf16* Y = (bf16*)(ws + WS_Y); bf16* KA = (bf16*)(ws + WS_KA); bf16* VA = (bf16*)(ws + WS_VA); bf16* KB = (bf16*)(ws + WS_KB); bf16* VB = (bf16*)(ws + WS_VB);
        bf16* XR = (bf16*)(ws + WS_XR); bf16* G = (bf16*)(ws + WS_G); bf16* HID = (bf16*)(ws + WS_HID);
        bf16* wb = (bf16*)(ws + WS_W);
        { int t_ = threadIdx.x; asm volatile("" : "+v"(t_)); F.tid = t_; F.lane = t_ & 63; }
        const float* modl = mod + (size_t)l * 5 * 6144;
        if (PHM(PH_PRO) && ph == PH_PRO) { if (l == 0) phase_pro(F, args, mod, rope); }
        else if (PHM(PH_W) && ph == PH_W) { phase_weights(F, args, l); if (l == 0) phase_modulate(F, args.in[0], args.in[2], modl, 0, 1024, H); }
        else if ((PHM(PH_MIX1) && ph == PH_MIX1) || (PHM(PH_MIX2) && ph == PH_MIX2)) {
            lru::Params LP{XR, args.in[10] + (size_t)l * 4 * DM, args.in[11] + (size_t)l * DM, wb + WO_LRU / 2, args.in[13] + (size_t)l * 2 * DM, args.in[15] + (size_t)l * 2 * DM, (const float*)(ws + WS_LRUC), (float*)(ws + WS_AGG), Y};
            LAS lru::f32x4* hfl = (LAS lru::f32x4*)(F.lds + RING_OFF + F.wave * 8192);
            if (ph == PH_MIX1) lru::phase<1>(LP, F.vcu * NWAVES + F.wave, F.G * NWAVES, F.lane, hfl); else lru::phase<2>(LP, F.vcu * NWAVES + F.wave, F.G * NWAVES, F.lane, hfl);
            __syncthreads();
            const float* sink = args.in[7] + l * 8;
            if (ATTN_ON) {
            if (ph == PH_MIX1) { attn_latent<0>((char*)lds, Y, KA, VA, F.vcu, F.G, sink); if (l == 0) { attn_context<0>((char*)lds, Y, KA, VA, F.vcu, F.G, sink); attn_context<1>((char*)lds, Y, KB, VB, F.vcu, F.G, sink); } }
            else attn_latent<1>((char*)lds, Y, KB, VB, F.vcu, F.G, sink);
            }
        }
        else if (PHM(PH_LN1) && ph == PH_LN1) phase_ln(F, args.out, ctxs, args.in[21] + l * DM, args.in[22] + l * DM, modl, 3072, 4096, H);
        else if (PHM(PH_LN2) && ph == PH_LN2) { phase_ln(F, args.out, ctxs, args.in[25] + l * DM, args.in[26] + l * DM, l + 1 < DEPTH ? modl + 5 * 6144 : nullptr, 0, 1024, H); if (l + 1 < DEPTH) phase_weights(F, args, l + 1); }
        else if (PHM(PH_G1A) && ph == PH_G1A) {
            pg8::Gemm g{H, wb + WO_IN / 2, NROW, 3584, DM}; pg8::StaticOrder S; S.init(NROW, 3584, F.G, (int)blockIdx.x);
            pg8::EpiG1 E{Y, KA, VA, KB, VB, XR, G, rope, args.in[8] + l * 64, args.in[9] + l * 64, 0, 0};
            pg8::gemm_phase<pg8::EpiG1, pg8::StaticOrder, PG8_ALIGN, PG8_SP2>(F.lds + RING_OFF, g, S, E);
        } else if (PHM(PH_G1B) && ph == PH_G1B) {
            pg8::Gemm g{H, wb + WO_IN / 2 + (size_t)3584 * DM, NROW, 3072, DM}; pg8::StaticOrder S; S.init(NROW, 3072, F.G, (int)blockIdx.x);
            pg8::EpiG1 E{Y, KA, VA, KB, VB, XR, G, rope, args.in[8] + l * 64, args.in[9] + l * 64, 14, 0};
            pg8::gemm_phase<pg8::EpiG1, pg8::StaticOrder, PG8_ALIGN, PG8_SP2>(F.lds + RING_OFF, g, S, E);
        } else if (PHM(PH_MERGE) && ph == PH_MERGE) {
            pg8::Gemm g{Y, wb + WO_MERGE / 2, NROW, DM, YC}; pg8::StaticOrder S; S.init(NROW, DM, F.G, (int)blockIdx.x);
            pg8::EpiMerge E{G, H};
            pg8::gemm_phase<pg8::EpiMerge, pg8::StaticOrder, PG8_ALIGN, PG8_SP2>(F.lds + RING_OFF, g, S, E);
        } else if (PHM(PH_OUT) && ph == PH_OUT) {
            pg8::Gemm g{H, wb + WO_OUT / 2, NROW, DM, DM}; pg8::StaticOrder S; S.init(NROW, DM, F.G, (int)blockIdx.x);
            pg8::EpiResid E{l == 0 ? args.in[0] : args.out, l == 0 ? args.in[2] : ctxs, args.out, ctxs, modl, 2048, 0};
            pg8::gemm_phase<pg8::EpiResid, pg8::StaticOrder, PG8_ALIGN, PG8_SP2>(F.lds + RING_OFF, g, S, E);
        } else if (PHM(PH_FF1) && ph == PH_FF1) {
            pg8::Gemm g{H, wb + WO_FF1 / 2, NROW, DFF, DM}; pg8::StaticOrder S; S.init(NROW, DFF, F.G, (int)blockIdx.x);
            pg8::EpiNat8<3> E{HID, DFF};
            pg8::gemm_phase<pg8::EpiNat8<3>, pg8::StaticOrder, PG8_ALIGN, PG8_SP2>(F.lds + RING_OFF, g, S, E);
        } else if (PHM(PH_FF2) && ph == PH_FF2) {
            pg8::Gemm g{HID, wb + WO_FF2 / 2, NROW, DM, DFF}; pg8::StaticOrder S; S.init(NROW, DM, F.G, (int)blockIdx.x);
            pg8::EpiResid E{args.out, ctxs, args.out, ctxs, modl, 5120, 0};
            pg8::gemm_phase<pg8::EpiResid, pg8::StaticOrder, PG8_ALIGN, PG8_SP2>(F.lds + RING_OFF, g, S, E);
        }
        if (gp + 1 < hi) xcd_barrier(bar);
    }
}

static void launch_mk(const MkArgs& base, int l, int ph, int grid, hipStream_t stream) {
    MkArgs a = base; a.ph_lo = l * PH_COUNT + ph; a.ph_hi = a.ph_lo + 1; a.layer = l;
    hipLaunchKernelGGL(mk_fwd, dim3(grid), dim3(NWAVES * 64), LDS_BYTES, stream, a);
}
extern "C" void kernel_launch(void* const* d_in, const int* in_sizes, int n_in, void* d_out, int out_size, void* d_ws, size_t ws_size, hipStream_t stream) {
    if (n_in != 27 || ws_size < WS_END) { fprintf(stderr, "kernel_launch: unexpected n_in %d / ws_size %zu\n", n_in, ws_size); return; }
    static int grid = 0;
    if (grid == 0) {
        int dev = 0, cus = 0;
        if (hipGetDevice(&dev) != hipSuccess || hipDeviceGetAttribute(&cus, hipDeviceAttributeMultiprocessorCount, dev) != hipSuccess) { grid = -1; return; }
        if (hipFuncSetAttribute((const void*)mk_fwd, hipFuncAttributeMaxDynamicSharedMemorySize, LDS_BYTES) != hipSuccess) { fprintf(stderr, "hipFuncSetAttribute failed\n"); grid = -1; return; }
        grid = cus;
    }
    if (grid < 0) return;
    const float* x = (const float*)d_in[0]; const float* c = (const float*)d_in[1]; const float* ctx = (const float*)d_in[2]; const float* c_ctx = (const float*)d_in[3];
    const float* w_ada = (const float*)d_in[4]; const float* b_ada = (const float*)d_in[5]; const float* w_in = (const float*)d_in[6]; const float* a_sink = (const float*)d_in[7];
    const float* qgain = (const float*)d_in[8]; const float* kgain = (const float*)d_in[9]; const float* convw = (const float*)d_in[10]; const float* convb = (const float*)d_in[11];
    const float* c_wr = (const float*)d_in[12]; const float* c_br = (const float*)d_in[13]; const float* c_wi = (const float*)d_in[14]; const float* c_bi = (const float*)d_in[15];
    const float* c_lam = (const float*)d_in[16]; const float* w_br_a = (const float*)d_in[17]; const float* w_br_b = (const float*)d_in[18]; const float* w_br_c = (const float*)d_in[19];
    const float* w_out = (const float*)d_in[20]; const float* ln1_g = (const float*)d_in[21]; const float* ln1_b = (const float*)d_in[22]; const float* w_ff1 = (const float*)d_in[23];
    const float* w_ff2 = (const float*)d_in[24]; const float* ln2_g = (const float*)d_in[25]; const float* ln2_b = (const float*)d_in[26];
    char* ws = (char*)d_ws; float* out = (float*)d_out;
    float* mod = (float*)(ws + WS_MOD); float* rope = (float*)(ws + WS_ROPE); float* ctxs = (float*)(ws + WS_CTXS);
    bf16* H = (bf16*)(ws + WS_H); bf16* Y = (bf16*)(ws + WS_Y); bf16* KA = (bf16*)(ws + WS_KA); bf16* VA = (bf16*)(ws + WS_VA); bf16* KB = (bf16*)(ws + WS_KB); bf16* VB = (bf16*)(ws + WS_VB);
    bf16* XR = (bf16*)(ws + WS_XR); bf16* G = (bf16*)(ws + WS_G); bf16* HID = (bf16*)(ws + WS_HID); float* ZRAW = (float*)(ws + WS_ZRAW); bf16* HF = (bf16*)(ws + WS_HF);
    (void)w_in; (void)w_br_a; (void)w_br_b; (void)w_br_c; (void)w_out; (void)w_ff1; (void)w_ff2; (void)G; (void)HID; (void)ZRAW; (void)XR;
    MkArgs base; memset(&base, 0, sizeof(base));
    for (int i = 0; i < 27; ++i) base.in[i] = (const float*)d_in[i];
    base.out = out; base.ws = (unsigned char*)d_ws;

    hipMemsetAsync(ws + WS_CTL, 0, CTL_ZERO_BYTES, stream);
    launch_mk(base, 0, PH_PRO, grid, stream);
    launch_mk(base, 0, PH_W, grid, stream);
    for (int l = 0; l < DEPTH; ++l) {
        launch_mk(base, l, PH_G1A, grid, stream);
        launch_mk(base, l, PH_MIX1, grid, stream);
        launch_mk(base, l, PH_MIX2, grid, stream);
        launch_mk(base, l, PH_G1B, grid, stream);
        launch_mk(base, l, PH_MERGE, grid, stream);
        launch_mk(base, l, PH_OUT, grid, stream);
        launch_mk(base, l, PH_LN1, grid, stream);
        launch_mk(base, l, PH_FF1, grid, stream);
        launch_mk(base, l, PH_FF2, grid, stream);
        launch_mk(base, l, PH_LN2, grid, stream);
    }
}
```

```cpp
#include <hip/hip_runtime.h>
#include <cstdio>
#include <cstdint>
#include <cmath>
#include <cstring>

typedef unsigned short bf16;
constexpr int DM = 1024, BATCH = 4, SEQ = 4096, CTXL = 256, DEPTH = 2;
constexpr int NLAT = BATCH * SEQ, NCTX = BATCH * CTXL, NROW = NLAT + NCTX;
constexpr int HD = 64, GRIDW = 64, WINDOW = 128;
constexpr int INC = 6656, DFF = 4096, YC = 2048, GC = 3072;
constexpr int C_QA = 0, C_KA = 512, C_VA = 640, C_QB = 768, C_KB = 1280, C_VB = 1408, C_XR = 1536, C_YR = 2560, C_G = 3584;
constexpr float ALPHA = 1.41421356237309515f;
constexpr float LN_EPS = 1e-5f, RMS_EPS = 1e-6f;
constexpr float QSCALE = 0.125f * 1.4426950408889634f;
constexpr float LOG2E = 1.4426950408889634f;

constexpr size_t MiB = 1u << 20;
constexpr size_t WS_CTL = 0;
constexpr size_t WS_MOD = 37 * MiB;
constexpr size_t WS_ROPE = WS_MOD + 512 * 1024;
constexpr size_t WS_LRUC = WS_ROPE + 16384;
constexpr size_t WS_CTXS = 38 * MiB;
constexpr size_t WS_AGG = 42 * MiB;
constexpr size_t WS_H = 47 * MiB;
constexpr size_t WS_Y = 81 * MiB;
constexpr size_t WS_KA = 149 * MiB, WS_VA = WS_KA + 4352 * 1024, WS_KB = WS_VA + 4352 * 1024, WS_VB = WS_KB + 4352 * 1024;
constexpr size_t WS_XR = 166 * MiB;
constexpr size_t WS_G = 149 * MiB;
constexpr size_t WS_HID = 81 * MiB;
constexpr size_t WS_ZRAW = 200 * MiB;
constexpr size_t WS_HF = 200 * MiB;
constexpr size_t WS_END = 252 * MiB;

__device__ __forceinline__ float bf2f(bf16 v) { return __uint_as_float(((unsigned)v) << 16); }
__device__ __forceinline__ bf16 f2bf(float f) { unsigned u = __float_as_uint(f); return (bf16)((u + 0x7fffu + ((u >> 16) & 1u)) >> 16); }
__device__ __forceinline__ float bfr(float f) { return bf2f(f2bf(f)); }
__device__ __forceinline__ float sigmoidf_(float x) { return 1.f / (1.f + __expf(-x)); }
__device__ __forceinline__ float gelu_tanh(float x) { const float u = 0.7978845608028654f * (x + 0.044715f * x * x * x); return 0.5f * x * (1.f + tanhf(u)); }
__device__ __forceinline__ int row_batch(int row) { return row < NLAT ? row / SEQ : (row - NLAT) / CTXL; }
__device__ __forceinline__ int row_modidx(int row) { return row < NLAT ? row / SEQ : 4; }

__global__ void nk_mod(const float* c, const float* c_ctx, const float* w_ada, const float* b_ada, float* mod) {
    const int gid = blockIdx.x * blockDim.x + threadIdx.x; if (gid >= DEPTH * 6144) return;
    const int l = gid / 6144, n = gid % 6144;
    float acc[5] = {0, 0, 0, 0, 0};
    for (int k = 0; k < DM; ++k) {
        const float w = w_ada[((size_t)l * DM + k) * 6144 + n];
        for (int v = 0; v < 5; ++v) { const float x = v < 4 ? c[v * DM + k] : c_ctx[k]; acc[v] += (x / (1.f + __expf(-x))) * w; }
    }
    for (int v = 0; v < 5; ++v) mod[((size_t)l * 5 + v) * 6144 + n] = acc[v] + b_ada[l * 6144 + n];
}
__global__ void nk_rope(float* rope) {
    const int i = threadIdx.x; if (i >= 64 * 16) return;
    const int pos = i / 16, f = i % 16;
    const double inv = pow(10000.0, -(double)f / 16.0), ang = (double)pos * (double)(float)inv;
    rope[i] = (float)cos(ang); rope[1024 + i] = (float)sin(ang);
}
__global__ void nk_modulate(const float* xin, const float* cin, const float* mod  , int sh_off, int sc_off, bf16* H) {
    const size_t gid = (size_t)blockIdx.x * blockDim.x + threadIdx.x; if (gid >= (size_t)NROW * DM) return;
    const int row = (int)(gid / DM), col = (int)(gid % DM);
    const float* m = mod + (size_t)row_modidx(row) * 6144;
    const float x = row < NLAT ? xin[gid] : cin[(size_t)(row - NLAT) * DM + col];
    H[gid] = f2bf(x * (1.f + m[sc_off + col]) + m[sh_off + col]);
}
struct Acc44 { float v[4][4]; };
__device__ __forceinline__ void ngemm_core(Acc44& acc, const bf16* A, int lda, const float* W, int ldw, int K, int m0, int n0, float* As, float* Bs) {
    const int tid = threadIdx.x, tx = tid & 15, ty = tid >> 4;
    for (int k0 = 0; k0 < K; k0 += 16) {
        { const int r = tid >> 2, kk = (tid & 3) * 4; const bf16* ap = A + (size_t)(m0 + r) * lda + k0 + kk;
          for (int j = 0; j < 4; ++j) As[(kk + j) * 68 + r] = bf2f(ap[j]); }
        { const int kk = tid >> 4, n = (tid & 15) * 4; const float* wp = W + (size_t)(k0 + kk) * ldw + n0 + n;
          for (int j = 0; j < 4; ++j) Bs[kk * 68 + n + j] = bfr(wp[j]); }
        __syncthreads();
#pragma unroll
        for (int kk = 0; kk < 16; ++kk) {
            float a[4], b[4];
#pragma unroll
            for (int j = 0; j < 4; ++j) { a[j] = As[kk * 68 + ty * 4 + j]; b[j] = Bs[kk * 68 + tx * 4 + j]; }
#pragma unroll
            for (int i = 0; i < 4; ++i)
#pragma unroll
                for (int j = 0; j < 4; ++j) acc.v[i][j] += a[i] * b[j];
        }
        __syncthreads();
    }
}
enum { E_RAW = 0, E_BF16 = 1, E_GELU = 2, E_SIGMOID = 3, E_RELU2 = 4, E_RESID = 5 };
struct NGemmArgs { const bf16* A; const float* W; void* out; const float* base_lat; const float* base_ctx; float* out_ctx; const float* mod; int lda, ldw, K, M, N, mode, ldo, gate_off; };
static NGemmArgs mkargs(const bf16* A, int lda, const float* W, int ldw, int K, int M, int N, int mode, void* out, int ldo, const float* base_lat, const float* base_ctx, float* out_ctx, const float* mod, int gate_off) {
    NGemmArgs g; memset(&g, 0, sizeof(g)); g.A = A; g.W = W; g.out = out; g.base_lat = base_lat; g.base_ctx = base_ctx; g.out_ctx = out_ctx; g.mod = mod; g.lda = lda; g.ldw = ldw; g.K = K; g.M = M; g.N = N; g.mode = mode; g.ldo = ldo; g.gate_off = gate_off; return g; }
__global__ void __launch_bounds__(256) nk_gemm(NGemmArgs g) {
    __shared__ float As[16 * 68], Bs[16 * 68];
    const int m0 = blockIdx.y * 64, n0 = blockIdx.x * 64;
    Acc44 acc; for (int i = 0; i < 4; ++i) for (int j = 0; j < 4; ++j) acc.v[i][j] = 0.f;
    ngemm_core(acc, g.A, g.lda, g.W, g.ldw, g.K, m0, n0, As, Bs);
    const int tx = threadIdx.x & 15, ty = threadIdx.x >> 4;
    for (int i = 0; i < 4; ++i) for (int j = 0; j < 4; ++j) {
        const int row = m0 + ty * 4 + i, col = n0 + tx * 4 + j; const float v = acc.v[i][j];
        if (g.mode == E_RAW) ((float*)g.out)[(size_t)row * g.ldo + col] = v;
        else if (g.mode == E_BF16) ((bf16*)g.out)[(size_t)row * g.ldo + col] = f2bf(v);
        else if (g.mode == E_GELU) ((bf16*)g.out)[(size_t)row * g.ldo + col] = f2bf(gelu_tanh(v));
        else if (g.mode == E_SIGMOID) ((bf16*)g.out)[(size_t)row * g.ldo + col] = f2bf(sigmoidf_(v));
        else if (g.mode == E_RELU2) { const float r = v > 0.f ? v : 0.f; ((bf16*)g.out)[(size_t)row * g.ldo + col] = f2bf(r * r); }
        else if (g.mode == E_RESID) {
            const float gate = g.mod[(size_t)row_modidx(row) * 6144 + g.gate_off + col];
            if (row < NLAT) ((float*)g.out)[(size_t)row * DM + col] = ALPHA * g.base_lat[(size_t)row * DM + col] + gate * v;
            else g.out_ctx[(size_t)(row - NLAT) * DM + col] = ALPHA * g.base_ctx[(size_t)(row - NLAT) * DM + col] + gate * v;
        }
    }
}
__global__ void __launch_bounds__(256) nk_merge(const bf16* Y, const bf16* G, const float* wa, const float* wb, const float* wc, bf16* Mo) {
    __shared__ float As[16 * 68], Bs[16 * 68];
    const int m0 = blockIdx.y * 64, n0 = blockIdx.x * 64;
    const int tx = threadIdx.x & 15, ty = threadIdx.x >> 4;
    float tot[4][4]; for (int i = 0; i < 4; ++i) for (int j = 0; j < 4; ++j) tot[i][j] = 0.f;
    for (int s = 0; s < 3; ++s) {
        Acc44 acc; for (int i = 0; i < 4; ++i) for (int j = 0; j < 4; ++j) acc.v[i][j] = 0.f;
        const bf16* A = Y + (s == 0 ? 0 : s == 1 ? 512 : 1024); const float* W = s == 0 ? wa : s == 1 ? wb : wc; const int K = s == 2 ? 1024 : 512;
        ngemm_core(acc, A, YC, W, DM, K, m0, n0, As, Bs);
        for (int i = 0; i < 4; ++i) for (int j = 0; j < 4; ++j) {
            const int row = m0 + ty * 4 + i, col = n0 + tx * 4 + j;
            tot[i][j] += bf2f(G[(size_t)row * GC + s * 1024 + col]) * acc.v[i][j];
        }
    }
    for (int i = 0; i < 4; ++i) for (int j = 0; j < 4; ++j) Mo[(size_t)(m0 + ty * 4 + i) * DM + n0 + tx * 4 + j] = f2bf(tot[i][j]);
}
__global__ void __launch_bounds__(256) nk_qkv_epi(const float* zraw, int half, const float* rope, const float* qgain, const float* kgain, bf16* Y, bf16* Kd, bf16* Vd) {
    const int wave = (blockIdx.x * blockDim.x + threadIdx.x) >> 6, d = threadIdx.x & 63; if (wave >= NROW * 12) return;
    const int row = wave / 12, hs = wave % 12;
    float v = zraw[(size_t)row * 768 + hs * 64 + d];
    const bool isq = hs < 8, isk = hs >= 8 && hs < 10;
    if (half == 1 && (isq || isk)) {
        float ss = v * v; for (int o = 32; o; o >>= 1) ss += __shfl_xor(ss, o);
        v = v * rsqrtf(ss * (1.f / 64.f) + RMS_EPS) * (isq ? qgain[d] : kgain[d]);
    }
    if ((isq || isk) && row < NLAT) {
        const int t = row % SEQ, pos = (d < 32) ? t / GRIDW : t % GRIDW, i = d & 15; const bool x2 = (d & 16) != 0;
        const float c = rope[pos * 16 + i], s = rope[1024 + pos * 16 + i], p = __shfl_xor(v, 16);
        v = x2 ? p * s + v * c : v * c - p * s;
    }
    if (isq) Y[(size_t)row * YC + half * 512 + hs * 64 + d] = f2bf(v * QSCALE);
    else if (isk) Kd[(size_t)row * 128 + (hs - 8) * 64 + d] = f2bf(v);
    else Vd[(size_t)row * 128 + (hs - 10) * 64 + d] = f2bf(v);
}
__global__ void __launch_bounds__(256) nk_attn(bf16* Y, const bf16* Kb, const bf16* Vb, int kind, const float* sink, int row_lo, int row_hi) {
    const int wave = (blockIdx.x * blockDim.x + threadIdx.x) >> 6, lane = threadIdx.x & 63;
    const int nrows = row_hi - row_lo; if (wave >= nrows * 8) return;
    const int row = row_lo + wave / 8, h = wave % 8, kvh = h / 4;
    bf16* qp = Y + (size_t)row * YC + kind * 512 + h * 64;
    float q[64]; _Pragma("unroll") for (int d = 0; d < 64; ++d) q[d] = bf2f(qp[d]);
    const bool lat = row < NLAT; const int b = row_batch(row);
    int jlo = 0, jhi = -1;
    if (lat) { const int t = row % SEQ; if (kind == 0) { jlo = t - WINDOW < 0 ? 0 : t - WINDOW; jhi = t + WINDOW > SEQ - 1 ? SEQ - 1 : t + WINDOW; } else { jlo = 0; jhi = SEQ - 1; } }
    const int nl = jhi - jlo + 1, nk = nl + CTXL;
    float mx = -INFINITY;
    for (int j = lane; j < nk; j += 64) {
        const int kr = j < nl ? b * SEQ + jlo + j : NLAT + b * CTXL + (j - nl);
        const bf16* kp = Kb + (size_t)kr * 128 + kvh * 64; float s = 0.f;
        _Pragma("unroll") for (int d = 0; d < 64; ++d) s += q[d] * bf2f(kp[d]);
        mx = fmaxf(mx, s);
    }
    for (int o = 32; o; o >>= 1) mx = fmaxf(mx, __shfl_xor(mx, o));
    float sk = 0.f; if (kind == 0) { sk = sink[h] * LOG2E; mx = fmaxf(mx, sk); }
    float den = 0.f; float o[64]; _Pragma("unroll") for (int d = 0; d < 64; ++d) o[d] = 0.f;
    for (int j = lane; j < nk; j += 64) {
        const int kr = j < nl ? b * SEQ + jlo + j : NLAT + b * CTXL + (j - nl);
        const bf16* kp = Kb + (size_t)kr * 128 + kvh * 64; float s = 0.f;
        _Pragma("unroll") for (int d = 0; d < 64; ++d) s += q[d] * bf2f(kp[d]);
        const float p = exp2f(s - mx); den += p;
        const bf16* vp = Vb + (size_t)kr * 128 + kvh * 64;
        _Pragma("unroll") for (int d = 0; d < 64; ++d) o[d] += p * bf2f(vp[d]);
    }
    for (int of = 32; of; of >>= 1) den += __shfl_xor(den, of);
    if (kind == 0) den += exp2f(sk - mx);
    const float inv = 1.f / den;
    _Pragma("unroll") for (int d = 0; d < 64; ++d) { float s = o[d]; for (int of = 32; of; of >>= 1) s += __shfl_xor(s, of); if (lane == (d & 63)) qp[d] = f2bf(s * inv); }
}
__global__ void __launch_bounds__(64) nk_lru(const bf16* XR, const float* convw, const float* convb, const float* wr, const float* br, const float* wi, const float* bi, const float* lam,
                                              int dir, bf16* HF, bf16* Y) {
    __shared__ float xs[64];
    const int b = blockIdx.x / 16, blk = blockIdx.x % 16, lane = threadIdx.x, ch = blk * 64 + lane;
    float wR[64], wI[64];
    _Pragma("unroll") for (int d = 0; d < 64; ++d) { wR[d] = bfr(wr[((size_t)(dir * 16 + blk) * 64 + d) * 64 + lane]); wI[d] = bfr(wi[((size_t)(dir * 16 + blk) * 64 + d) * 64 + lane]); }
    const float bR = br[dir * DM + ch], bI = bi[dir * DM + ch], lm = lam[dir * DM + ch];
    const float nsp = -8.f * log1pf(expf(-lm));
    const float cw0 = convw[0 * DM + ch], cw1 = convw[1 * DM + ch], cw2 = convw[2 * DM + ch], cw3 = convw[3 * DM + ch], cb = convb[ch];
    float h = 0.f;
    for (int seg = 0; seg < 2; ++seg) {
        const int L = seg == 0 ? CTXL : SEQ; const int rbase = seg == 0 ? NLAT + b * CTXL : b * SEQ;
        for (int st = 0; st < L; ++st) {
            const int t = dir == 0 ? st : L - 1 - st;
            float xc = cb;
            if (t - 1 >= 0) xc += cw0 * bf2f(XR[(size_t)(rbase + t - 1) * DM + ch]);
            xc += cw1 * bf2f(XR[(size_t)(rbase + t) * DM + ch]);
            if (t + 1 < L) xc += cw2 * bf2f(XR[(size_t)(rbase + t + 1) * DM + ch]);
            if (t + 2 < L) xc += cw3 * bf2f(XR[(size_t)(rbase + t + 2) * DM + ch]);
            __syncthreads(); xs[lane] = bfr(xc); __syncthreads();
            float r = bR, ig = bI;
            _Pragma("unroll") for (int d = 0; d < 64; ++d) { const float xv = xs[d]; r += xv * wR[d]; ig += xv * wI[d]; }
            r = sigmoidf_(r); ig = sigmoidf_(ig);
            const float la = nsp * r, a = expf(la), u = sqrtf(-expm1f(2.f * la)) * (ig * xc);
            h = a * h + u;
            const size_t off = (size_t)(rbase + t) * DM + ch;
            if (dir == 0) HF[off] = f2bf(h);
            else { const size_t yo = (size_t)(rbase + t) * YC + 1024 + ch; Y[yo] = f2bf((bf2f(HF[off]) + h) * bf2f(Y[yo])); }
        }
    }
}
__global__ void __launch_bounds__(256) nk_ln(float* xlat, float* xctx, const float* g, const float* bta, const float* mod, int sh_off, int sc_off, bf16* H) {
    const int wave = (blockIdx.x * blockDim.x + threadIdx.x) >> 6, lane = threadIdx.x & 63; if (wave >= NROW) return;
    const int row = wave; float* xr = row < NLAT ? xlat + (size_t)row * DM : xctx + (size_t)(row - NLAT) * DM;
    float v[16]; float s = 0.f;
    _Pragma("unroll") for (int j = 0; j < 16; ++j) { v[j] = xr[lane + 64 * j]; s += v[j]; }
    for (int o = 32; o; o >>= 1) s += __shfl_xor(s, o);
    const float mean = s * (1.f / DM); float q = 0.f;
    _Pragma("unroll") for (int j = 0; j < 16; ++j) { v[j] -= mean; q += v[j] * v[j]; }
    for (int o = 32; o; o >>= 1) q += __shfl_xor(q, o);
    const float rstd = rsqrtf(q * (1.f / DM) + LN_EPS);
    const float* m = mod ? mod + (size_t)row_modidx(row) * 6144 : nullptr;
    _Pragma("unroll") for (int j = 0; j < 16; ++j) { const int c = lane + 64 * j; const float y = v[j] * rstd * g[c] + bta[c]; xr[c] = y;
        if (H) H[(size_t)row * DM + c] = f2bf(y * (1.f + m[sc_off + c]) + m[sh_off + c]); }
}


namespace pg8 {

#define PG8_LAS __attribute__((address_space(3)))
typedef unsigned short bf16_t;
typedef short bf16x8 __attribute__((ext_vector_type(8)));
typedef float f32x4 __attribute__((ext_vector_type(4)));
typedef unsigned u32x4 __attribute__((ext_vector_type(4)));
constexpr int BM = 256, BK = 64, HALF = 128, HTB = HALF * BK * 2  , STAGE_BYTES = 8 * HTB, NXCD = 8, WGM = 8;

__host__ __device__ __forceinline__ int lds_byte(int r, int c) { const int st = (r >> 4) * 2 + (c >> 5), rr = r & 15, cc = c & 31, ob = rr * 64 + cc * 2; return st * 1024 + (ob ^ (((ob >> 9) & 1) << 5)); }
__host__ __device__ __forceinline__ void stage_rc(int b, int& R, int& C) { const int st = b / 1024, sb = b % 1024, swz = sb ^ (((sb >> 9) & 1) << 5); R = (st >> 1) * 16 + swz / 64; C = (st & 1) * 32 + (swz % 64) / 2; }
__host__ __device__ __forceinline__ int perm32(int rho) { const int n = rho >> 4, i = rho & 15; return 8 * (i >> 2) + 4 * n + (i & 3); }

struct Unit { int pm, pn; };
struct Gemm { const bf16_t* A; const bf16_t* Bt; int M, N, K; };

struct StaticOrder {
    int nM, nN, nwg, G, c;
    __host__ __device__ void init(int M, int N, int G_, int c_) { nM = M / BM; nN = N / BM; nwg = nM * nN; G = G_; c = c_; }
    __host__ __device__ bool next(int i, Unit& u) const {
        const long L = (long)i * G + c; if (L >= nwg) return false;
        int wgid = (int)L; { const int q = nwg / NXCD, r = nwg % NXCD, xcd = wgid % NXCD, off = wgid / NXCD; wgid = (xcd < r ? xcd * (q + 1) : r * (q + 1) + (xcd - r) * q) + off; }
        const int nig = WGM * nN, gid = wgid / nig, fm = gid * WGM, gsz = (nM - fm) < WGM ? (nM - fm) : WGM;
        u.pm = fm + ((wgid % nig) % gsz); u.pn = (wgid % nig) / gsz; return true;
    }
    __device__ __forceinline__ void a_ready(const Unit&) const {}
    __device__ __forceinline__ void done(const Unit&) const {}
};


typedef float f32x2_c __attribute__((ext_vector_type(2))); typedef __bf16 bf16x2_c __attribute__((ext_vector_type(2)));
__device__ __forceinline__ unsigned cvt_pk_bf16(float lo, float hi) { f32x2_c v = {lo, hi}; bf16x2_c b = __builtin_convertvector(v, bf16x2_c); return __builtin_bit_cast(unsigned, b); }

enum { TT_IDENT = 0, TT_NAT8 = 1, TT_HEAD = 2 };
__host__ __device__ __forceinline__ int tile_pos_of_logical(int tt, int L) {
    if (tt == TT_IDENT) return L;
    if (tt == TT_NAT8) { const int bj = L >> 7, wc = (L >> 5) & 3, fq = (L >> 3) & 3, n = (L >> 2) & 1, j = L & 3; return 128 * bj + 32 * wc + 16 * n + 4 * fq + j; }
    const int wc = L >> 6, d = L & 63, fqh = d >> 5, bj = (d >> 4) & 1, fql = (d >> 3) & 1, n = (d >> 2) & 1, j = d & 3;
    return 128 * bj + 32 * wc + 16 * n + 4 * (2 * fqh + fql) + j;
}
__device__ __forceinline__ float fast_sigmoid(float x) { return __builtin_amdgcn_rcpf(1.f + __builtin_amdgcn_exp2f(-1.4426950408889634f * x)); }
__device__ __forceinline__ float fast_gelu_tanh(float x) { const float u = x * (1.5957691216057308f + 0.0713548162726f * x * x); return x * __builtin_amdgcn_rcpf(1.f + __builtin_amdgcn_exp2f(-1.4426950408889634f * u)); }
template <int FN> __device__ __forceinline__ float epi_fn(float v) { if (FN == 1) return fast_gelu_tanh(v); if (FN == 2) return fast_sigmoid(v); if (FN == 3) { const float r = v > 0.f ? v : 0.f; return r * r; } return v; }
template <int FN> __device__ __forceinline__ void store_nat8(const f32x4 (&acc)[2][2][4][2], bf16_t* dst, int ld, int row0, int col0) {
#pragma unroll
    for (int ai = 0; ai < 2; ++ai)
#pragma unroll
        for (int m = 0; m < 4; ++m) { bf16_t* rowp = dst + (size_t)(row0 + ai * HALF + m * 16) * ld + col0;
#pragma unroll
            for (int bj = 0; bj < 2; ++bj) { const f32x4 v0 = acc[ai][bj][m][0], v1 = acc[ai][bj][m][1]; u32x4 w;
                w.x = cvt_pk_bf16(epi_fn<FN>(v0[0]), epi_fn<FN>(v0[1])); w.y = cvt_pk_bf16(epi_fn<FN>(v0[2]), epi_fn<FN>(v0[3]));
                w.z = cvt_pk_bf16(epi_fn<FN>(v1[0]), epi_fn<FN>(v1[1])); w.w = cvt_pk_bf16(epi_fn<FN>(v1[2]), epi_fn<FN>(v1[3]));
                *(u32x4*)(rowp + bj * HALF) = w; } }
}
template <int FN> struct EpiNat8 {
    static constexpr bool PERM = false, AFTER_DRAIN = false, RESCALE = false;
    bf16_t* dst; int ld;
    __device__ __forceinline__ void operator()(const f32x4 (&acc)[2][2][4][2], const Unit& u, int wr, int wc, int fr, int fq) const {
        store_nat8<FN>(acc, dst + u.pn * BM, ld, u.pm * BM + wr * 64 + fr, wc * 32 + 8 * fq);
    }
};
struct EpiG1 {
    static constexpr bool PERM = false, AFTER_DRAIN = false, RESCALE = false;
    bf16_t *Y, *KA, *VA, *KB, *VB, *XR, *G; const float* rope; const float* qgain; const float* kgain; int pn_off, pad_;
    __device__ __forceinline__ void operator()(const f32x4 (&acc)[2][2][4][2], const Unit& u, int wr, int wc, int fr, int fq) const {
        const int T = u.pn + pn_off, row0 = u.pm * BM + wr * 64 + fr;
        if (T >= 14) { store_nat8<2>(acc, G + (T - 14) * 256, 3072, row0, wc * 32 + 8 * fq); return; }
        if (T >= 10) { store_nat8<1>(acc, Y + 1024 + (T - 10) * 256, 2048, row0, wc * 32 + 8 * fq); return; }
        if (T >= 6) { store_nat8<0>(acc, XR + (T - 6) * 256, 1024, row0, wc * 32 + 8 * fq); return; }
        const bool isB = T >= 3; const int Tl = isB ? T - 3 : T;
        int kind; bf16_t* dst; int ld;
        if (Tl < 2) { kind = 0; dst = Y + (isB ? 512 : 0) + Tl * 256 + wc * 64; ld = 2048; }
        else if (wc < 2) { kind = 1; dst = (isB ? KB : KA) + wc * 64; ld = 128; }
        else { kind = 2; dst = (isB ? VB : VA) + (wc - 2) * 64; ld = 128; }
        const bool lat = u.pm < 64, rms = isB && kind < 2, rot = kind < 2 && lat;
        const int based = 32 * (fq >> 1) + 8 * (fq & 1);
        f32x4 gn[2][2];
#pragma unroll
        for (int bj = 0; bj < 2; ++bj)
#pragma unroll
            for (int n = 0; n < 2; ++n) { const f32x4 gq = *(const f32x4*)(qgain + based + 16 * bj + 4 * n), gk = *(const f32x4*)(kgain + based + 16 * bj + 4 * n); gn[bj][n] = kind == 0 ? gq : gk; }
        const float osc = kind == 0 ? 0.125f * 1.4426950408889634f : 1.f;
#pragma unroll
        for (int ai = 0; ai < 2; ++ai)
#pragma unroll
            for (int m = 0; m < 4; ++m) {
                const int row = row0 + ai * HALF + m * 16;
                f32x4 v[2][2];
#pragma unroll
                for (int bj = 0; bj < 2; ++bj)
#pragma unroll
                    for (int n = 0; n < 2; ++n) v[bj][n] = acc[ai][bj][m][n];
                if (rms) {
                    float ss = 0.f;
#pragma unroll
                    for (int bj = 0; bj < 2; ++bj)
#pragma unroll
                        for (int n = 0; n < 2; ++n) { const f32x4 x = v[bj][n]; ss += (x[0] * x[0] + x[1] * x[1]) + (x[2] * x[2] + x[3] * x[3]); }
                    ss += __shfl_xor(ss, 16); ss += __shfl_xor(ss, 32);
                    const float r = __builtin_amdgcn_rsqf(ss * (1.f / 64.f) + 1e-6f);
#pragma unroll
                    for (int bj = 0; bj < 2; ++bj)
#pragma unroll
                        for (int n = 0; n < 2; ++n) v[bj][n] = v[bj][n] * r * gn[bj][n];
                }
                if (rot) {
                    const int t = row & 4095, pos = (fq >> 1) ? (t & 63) : (t >> 6); const float* cp = rope + pos * 16 + 8 * (fq & 1);
#pragma unroll
                    for (int n = 0; n < 2; ++n) { const f32x4 c = *(const f32x4*)(cp + 4 * n), s = *(const f32x4*)(cp + 1024 + 4 * n); const f32x4 x1 = v[0][n], x2 = v[1][n];
                        v[0][n] = x1 * c - x2 * s; v[1][n] = x1 * s + x2 * c; }
                }
                bf16_t* rowp = dst + (size_t)row * ld + based;
#pragma unroll
                for (int bj = 0; bj < 2; ++bj) { const f32x4 v0 = v[bj][0] * osc, v1 = v[bj][1] * osc; u32x4 w;
                    w.x = cvt_pk_bf16(v0[0], v0[1]); w.y = cvt_pk_bf16(v0[2], v0[3]); w.z = cvt_pk_bf16(v1[0], v1[1]); w.w = cvt_pk_bf16(v1[2], v1[3]);
                    *(u32x4*)(rowp + 16 * bj) = w; }
            }
    }
};
struct EpiMerge {
    static constexpr bool PERM = false, AFTER_DRAIN = false, RESCALE = true;
    const bf16_t* G; bf16_t* Mo;
    __device__ __forceinline__ static void unpack8(const u32x4 w, float (&f)[8]) {
        f[0] = __uint_as_float(w.x << 16); f[1] = __uint_as_float(w.x & 0xffff0000u); f[2] = __uint_as_float(w.y << 16); f[3] = __uint_as_float(w.y & 0xffff0000u);
        f[4] = __uint_as_float(w.z << 16); f[5] = __uint_as_float(w.z & 0xffff0000u); f[6] = __uint_as_float(w.w << 16); f[7] = __uint_as_float(w.w & 0xffff0000u);
    }
    __device__ __forceinline__ void rescale(f32x4 (&acc)[2][2][4][2], const Unit& u, int t, int wr, int wc, int fr, int fq) const {
        const int s = t == 8 ? 0 : 1; int row0 = u.pm * BM + wr * 64 + fr, col0 = u.pn * BM + wc * 32 + 8 * fq;
        asm volatile("" : "+v"(row0), "+v"(col0));
#pragma unroll
        for (int ai = 0; ai < 2; ++ai)
#pragma unroll
            for (int m = 0; m < 4; ++m) { const bf16_t* gp = G + (size_t)(row0 + ai * HALF + m * 16) * 3072 + s * 1024 + col0;
#pragma unroll
                for (int bj = 0; bj < 2; ++bj) { float a[8], b[8]; unpack8(*(const u32x4*)(gp + bj * HALF), a); unpack8(*(const u32x4*)(gp + 1024 + bj * HALF), b);
                    f32x4 f0, f1;
#pragma unroll
                    for (int j = 0; j < 4; ++j) { f0[j] = fmaxf(a[j], 1e-20f) * __builtin_amdgcn_rcpf(fmaxf(b[j], 1e-20f)); f1[j] = fmaxf(a[4 + j], 1e-20f) * __builtin_amdgcn_rcpf(fmaxf(b[4 + j], 1e-20f)); }
                    if (s == 0) {
#pragma unroll
                        for (int j = 0; j < 4; ++j) { f0[j] = a[j] * __builtin_amdgcn_rcpf(fmaxf(b[j], 1e-20f)); f1[j] = a[4 + j] * __builtin_amdgcn_rcpf(fmaxf(b[4 + j], 1e-20f)); } }
                    acc[ai][bj][m][0] *= f0; acc[ai][bj][m][1] *= f1; }
                asm volatile("" ::: "memory"); }
    }
    __device__ __forceinline__ void operator()(const f32x4 (&acc)[2][2][4][2], const Unit& u, int wr, int wc, int fr, int fq) const {
        const int row0 = u.pm * BM + wr * 64 + fr, col0 = u.pn * BM + wc * 32 + 8 * fq;
#pragma unroll
        for (int ai = 0; ai < 2; ++ai)
#pragma unroll
            for (int m = 0; m < 4; ++m) { const size_t ro = (size_t)(row0 + ai * HALF + m * 16);
#pragma unroll
                for (int bj = 0; bj < 2; ++bj) { float c[8]; unpack8(*(const u32x4*)(G + ro * 3072 + 2048 + col0 + bj * HALF), c);
                    const f32x4 v0 = acc[ai][bj][m][0], v1 = acc[ai][bj][m][1]; u32x4 w;
                    w.x = cvt_pk_bf16(v0[0] * fmaxf(c[0], 1e-20f), v0[1] * fmaxf(c[1], 1e-20f)); w.y = cvt_pk_bf16(v0[2] * fmaxf(c[2], 1e-20f), v0[3] * fmaxf(c[3], 1e-20f));
                    w.z = cvt_pk_bf16(v1[0] * fmaxf(c[4], 1e-20f), v1[1] * fmaxf(c[5], 1e-20f)); w.w = cvt_pk_bf16(v1[2] * fmaxf(c[6], 1e-20f), v1[3] * fmaxf(c[7], 1e-20f));
                    *(u32x4*)(Mo + ro * 1024 + col0 + bj * HALF) = w; } }
    }
};
struct EpiResid {
    static constexpr bool PERM = false, AFTER_DRAIN = false, RESCALE = false;
    const float* base_lat; const float* base_ctx; float* out_lat; float* out_ctx; const float* mod; int gate_off, pad_;
    __device__ __forceinline__ void operator()(const f32x4 (&acc)[2][2][4][2], const Unit& u, int wr, int wc, int fr, int fq) const {
        const bool lat = u.pm < 64; const float* base = lat ? base_lat : base_ctx; float* out = lat ? out_lat : out_ctx;
        const int rowt = (lat ? u.pm : u.pm - 64) * BM + wr * 64 + fr, col0 = u.pn * BM + wc * 32 + 4 * fq;
        const float* gp = mod + (size_t)(lat ? (u.pm >> 4) : 4) * 6144 + gate_off + col0;
        f32x4 gv[2][2];
#pragma unroll
        for (int bj = 0; bj < 2; ++bj)
#pragma unroll
            for (int n = 0; n < 2; ++n) gv[bj][n] = *(const f32x4*)(gp + bj * HALF + n * 16);
#pragma unroll
        for (int ai = 0; ai < 2; ++ai)
#pragma unroll
            for (int m = 0; m < 4; ++m) { const size_t off = (size_t)(rowt + ai * HALF + m * 16) * 1024 + col0;
#pragma unroll
                for (int bj = 0; bj < 2; ++bj)
#pragma unroll
                    for (int n = 0; n < 2; ++n) { const f32x4 b = *(const f32x4*)(base + off + bj * HALF + n * 16);
                        *(f32x4*)(out + off + bj * HALF + n * 16) = b * 1.41421356237309515f + gv[bj][n] * acc[ai][bj][m][n]; } }
    }
};

template <class Epi, class Sched, bool ALIGN_EPI = false, bool SP2 = false>
__device__ __forceinline__ void gemm_phase(PG8_LAS unsigned char* lds, const Gemm g, const Sched& S, const Epi& E) {
    int tid_ = threadIdx.x; asm volatile("" : "+v"(tid_));
    const int tid = tid_, wid = __builtin_amdgcn_readfirstlane(tid >> 6), lane = tid & 63, wr = wid >> 2, wc = wid & 3, fr = lane & 15, fq = lane >> 4;
    const int K = g.K, nt = K / BK;
    unsigned voffA[2], voffB[2];
#pragma unroll
    for (int i = 0; i < 2; ++i) { int R, C; stage_rc(tid * 16 + i * 8192, R, C); const int Rb = Epi::PERM ? ((R & ~31) + perm32(R & 31)) : R;
        voffA[i] = (unsigned)(R * K + C) * 2u; voffB[i] = (unsigned)(Rb * K + C) * 2u; }
    const size_t kstep = (size_t)(BK * 2);
    const size_t hstep = (size_t)HALF * K * 2;
    const size_t tstep = 2 * hstep;
    const unsigned ldsw = (unsigned)wid * 1024u;
    const int aoff = lds_byte(wr * 64 + fr, fq * 8), boff = lds_byte(wc * 32 + fr, fq * 8);
#define PG8_SA(b, h) (((b) * 2 + (h)) * HTB)
#define PG8_SB(b, h) ((4 + (b) * 2 + (h)) * HTB)
#define PG8_STAGE(bufoff, gbase, voff) do { _Pragma("unroll") for (int _i = 0; _i < 2; ++_i) \
        __builtin_amdgcn_global_load_lds((const unsigned*)((const char*)(gbase) + (voff)[_i]), (PG8_LAS unsigned*)(lds + (bufoff) + ldsw + _i * 8192), 16, 0, 0); } while (0)
#define PG8_LDA(dst, b, h) do { _Pragma("unroll") for (int m = 0; m < 4; ++m) _Pragma("unroll") for (int k = 0; k < 2; ++k) dst[m][k] = *(const PG8_LAS bf16x8*)(lds + PG8_SA(b, h) + aoff + m * 2048 + k * 1024); } while (0)
#define PG8_LDB(dst, b, h) do { _Pragma("unroll") for (int n = 0; n < 2; ++n) _Pragma("unroll") for (int k = 0; k < 2; ++k) dst[n][k] = *(const PG8_LAS bf16x8*)(lds + PG8_SB(b, h) + boff + n * 2048 + k * 1024); } while (0)
#define PG8_MMA(ai, bj, At, Bt) do { __builtin_amdgcn_s_setprio(1); _Pragma("unroll") for (int m = 0; m < 4; ++m) _Pragma("unroll") for (int n = 0; n < 2; ++n) _Pragma("unroll") for (int k = 0; k < 2; ++k) \
        acc[ai][bj][m][n] = __builtin_amdgcn_mfma_f32_16x16x32_bf16(Bt[n][k], At[m][k], acc[ai][bj][m][n], 0, 0, 0); __builtin_amdgcn_s_setprio(0); } while (0)
#define PG8_WAIT_V(n) asm volatile("s_waitcnt vmcnt(" #n ")" ::: "memory")
#define PG8_WAIT_L(n) asm volatile("s_waitcnt lgkmcnt(" #n ")" ::: "memory")
#define PG8_BAR __builtin_amdgcn_s_barrier()
#define PG8_SCHED __builtin_amdgcn_sched_barrier(0)
    Unit cur, nxt; int ui = 0;
    if (!S.next(0, cur)) return;
    f32x4 acc[2][2][4][2];
#pragma unroll
    for (int a = 0; a < 2; ++a)
#pragma unroll
        for (int b = 0; b < 2; ++b)
#pragma unroll
            for (int m = 0; m < 4; ++m)
#pragma unroll
                for (int n = 0; n < 2; ++n) acc[a][b][m][n] = (f32x4){0.f, 0.f, 0.f, 0.f};
    bf16x8 At[4][2], B0[2][2], B1[2][2];
    const char* cA = (const char*)g.A + (size_t)cur.pm * tstep; const char* cB = (const char*)g.Bt + (size_t)cur.pn * tstep;
    S.a_ready(cur);
    if constexpr (SP2) {
        PG8_STAGE(PG8_SB(0, 0), cB, voffB); PG8_STAGE(PG8_SB(0, 1), cB + hstep, voffB); PG8_STAGE(PG8_SA(0, 0), cA, voffA); PG8_STAGE(PG8_SA(0, 1), cA + hstep, voffA);
        if (wr == 1) PG8_BAR;
        PG8_WAIT_V(2); PG8_BAR;
        PG8_STAGE(PG8_SB(1, 0), cB + kstep, voffB); PG8_STAGE(PG8_SA(1, 0), cA + kstep, voffA); PG8_STAGE(PG8_SB(1, 1), cB + hstep + kstep, voffB);
        PG8_WAIT_V(6); PG8_BAR;
    } else {
        PG8_STAGE(PG8_SB(0, 0), cB, voffB); PG8_STAGE(PG8_SA(0, 0), cA, voffA); PG8_STAGE(PG8_SB(0, 1), cB + hstep, voffB); PG8_STAGE(PG8_SA(0, 1), cA + hstep, voffA);
        if (wr == 1) PG8_BAR;
        PG8_WAIT_V(4); PG8_BAR;
        PG8_STAGE(PG8_SB(1, 0), cB + kstep, voffB); PG8_STAGE(PG8_SA(1, 0), cA + kstep, voffA); PG8_STAGE(PG8_SB(1, 1), cB + hstep + kstep, voffB);
        PG8_WAIT_V(6); PG8_BAR;
    }
    for (;;) {
        const bool has_next = S.next(ui + 1, nxt);
        const char* nA = has_next ? (const char*)g.A + (size_t)nxt.pm * tstep : cA; const char* nB = has_next ? (const char*)g.Bt + (size_t)nxt.pn * tstep : cB;
        for (int t = 0; t < nt; t += 2) {
            if constexpr (Epi::RESCALE) { if (t == 8 || t == 16) E.rescale(acc, cur, t, wr, wc, fr, fq); }
            const bool last = (t == nt - 2);
            const char* a1 = cA + (size_t)(t + 1) * kstep;
            const char* a2 = last ? nA : cA + (size_t)(t + 2) * kstep; const char* b2 = last ? nB : cB + (size_t)(t + 2) * kstep;
            const char* a3 = a2 + kstep; const char* b3 = b2 + kstep;
            if (last && has_next) S.a_ready(nxt);
            if constexpr (SP2) {
            PG8_LDB(B0, 0, 0); PG8_LDB(B1, 0, 1); PG8_SCHED; PG8_LDA(At, 0, 0); PG8_STAGE(PG8_SA(1, 1), a1 + hstep, voffA);
            PG8_WAIT_V(8); PG8_WAIT_L(0); PG8_BAR; PG8_MMA(0, 0, At, B0); PG8_MMA(0, 1, At, B1); PG8_BAR; PG8_SCHED;
            PG8_LDA(At, 0, 1); PG8_STAGE(PG8_SB(0, 0), b2, voffB); PG8_STAGE(PG8_SB(0, 1), b2 + hstep, voffB); PG8_STAGE(PG8_SA(0, 0), a2, voffA);
            PG8_WAIT_V(8); PG8_WAIT_L(0); PG8_BAR; PG8_MMA(1, 0, At, B0); PG8_MMA(1, 1, At, B1); PG8_BAR; PG8_SCHED;
            PG8_LDB(B0, 1, 0); PG8_LDB(B1, 1, 1); PG8_SCHED; PG8_LDA(At, 1, 0); PG8_STAGE(PG8_SA(0, 1), a2 + hstep, voffA);
            PG8_WAIT_V(8); PG8_WAIT_L(0); PG8_BAR; PG8_MMA(0, 0, At, B0); PG8_MMA(0, 1, At, B1); PG8_BAR; PG8_SCHED;
            PG8_LDA(At, 1, 1); PG8_STAGE(PG8_SB(1, 0), b3, voffB); PG8_STAGE(PG8_SB(1, 1), b3 + hstep, voffB); PG8_STAGE(PG8_SA(1, 0), a3, voffA);
            PG8_WAIT_V(8); PG8_WAIT_L(0); PG8_BAR; PG8_MMA(1, 0, At, B0); PG8_MMA(1, 1, At, B1); PG8_BAR; PG8_SCHED;
            } else {
            PG8_LDB(B0, 0, 0); PG8_SCHED; PG8_LDA(At, 0, 0); PG8_STAGE(PG8_SA(1, 1), a1 + hstep, voffA);
            PG8_WAIT_L(8); PG8_BAR; PG8_WAIT_L(0); PG8_MMA(0, 0, At, B0); PG8_BAR; PG8_SCHED;
            PG8_LDB(B1, 0, 1); PG8_STAGE(PG8_SB(0, 0), b2, voffB);
            PG8_BAR; PG8_WAIT_L(0); PG8_MMA(0, 1, At, B1); PG8_BAR;
            PG8_LDA(At, 0, 1); PG8_STAGE(PG8_SA(0, 0), a2, voffA);
            PG8_BAR; PG8_WAIT_L(0); PG8_MMA(1, 0, At, B0); PG8_BAR; PG8_SCHED;
            PG8_STAGE(PG8_SB(0, 1), b2 + hstep, voffB);
            PG8_WAIT_V(6); PG8_BAR; PG8_MMA(1, 1, At, B1); PG8_BAR;
            PG8_LDB(B0, 1, 0); PG8_SCHED; PG8_LDA(At, 1, 0); PG8_STAGE(PG8_SA(0, 1), a2 + hstep, voffA);
            PG8_WAIT_L(8); PG8_BAR; PG8_WAIT_L(0); PG8_MMA(0, 0, At, B0); PG8_BAR; PG8_SCHED;
            PG8_LDB(B1, 1, 1); PG8_STAGE(PG8_SB(1, 0), b3, voffB);
            PG8_BAR; PG8_WAIT_L(0); PG8_MMA(0, 1, At, B1); PG8_BAR;
            PG8_LDA(At, 1, 1); PG8_STAGE(PG8_SA(1, 0), a3, voffA);
            PG8_BAR; PG8_WAIT_L(0); PG8_MMA(1, 0, At, B0); PG8_BAR; PG8_SCHED;
            PG8_STAGE(PG8_SB(1, 1), b3 + hstep, voffB);
            PG8_WAIT_V(6); PG8_BAR; PG8_MMA(1, 1, At, B1); PG8_BAR;
            }
        }
        if constexpr (ALIGN_EPI) { if (wr == 0) PG8_BAR; }
        if constexpr (!Epi::AFTER_DRAIN) { E(acc, cur, wr, wc, fr, fq); S.done(cur); }
        if (!has_next) break;
#pragma unroll
        for (int a = 0; a < 2; ++a)
#pragma unroll
            for (int b = 0; b < 2; ++b)
#pragma unroll
                for (int m = 0; m < 4; ++m)
#pragma unroll
                    for (int n = 0; n < 2; ++n) acc[a][b][m][n] = (f32x4){0.f, 0.f, 0.f, 0.f};
        cur = nxt; cA = nA; cB = nB; ++ui;
        if constexpr (ALIGN_EPI) { if (wr == 1) PG8_BAR; }
    }
    PG8_WAIT_V(0);
    if constexpr (!ALIGN_EPI) { if (wr == 0) PG8_BAR; }
    PG8_BAR;
    if constexpr (Epi::AFTER_DRAIN) { E.fused(acc, cur, wr, wc, fr, fq, lds, wid, lane); S.done(cur); }
#undef PG8_SA
#undef PG8_SB
#undef PG8_STAGE
#undef PG8_LDA
#undef PG8_LDB
#undef PG8_MMA
#undef PG8_WAIT_V
#undef PG8_WAIT_L
#undef PG8_BAR
#undef PG8_SCHED
}
}

namespace lru {
#define LAS __attribute__((address_space(3)))
typedef short bf16x8 __attribute__((ext_vector_type(8)));
typedef float f32x4 __attribute__((ext_vector_type(4)));
typedef unsigned u32x4 __attribute__((ext_vector_type(4)));
constexpr int NCH = 68;
template <int CTRL> __device__ __forceinline__ float dpp(float oldv, float src) {
    return __int_as_float(__builtin_amdgcn_update_dpp(__float_as_int(oldv), __float_as_int(src), CTRL, 0xf, 0xf, false));
}
__device__ __forceinline__ float bfe(const bf16x8& v, int j) { return __uint_as_float(((unsigned)(unsigned short)v[j]) << 16); }
__device__ __forceinline__ float sigm(float x) { return __builtin_amdgcn_rcpf(1.f + __builtin_amdgcn_exp2f(-1.4426950408889634f * x)); }
template <int DIR> __device__ __forceinline__ void row_scan(float (&TA)[8], float (&TU)[8]) {
#define LRU_STEP(D) { _Pragma("unroll") for (int j = 0; j < 8; ++j) { const float pA = dpp<(DIR ? 0x100 : 0x110) | D>(1.f, TA[j]), pU = dpp<(DIR ? 0x100 : 0x110) | D>(0.f, TU[j]); TU[j] = TA[j] * pU + TU[j]; TA[j] = TA[j] * pA; } }
    LRU_STEP(1) LRU_STEP(2) LRU_STEP(4) LRU_STEP(8)
#undef LRU_STEP
}
struct Params { const bf16* XR; const float* convw; const float* convb; const bf16* Wg; const float* br; const float* bi; const float* c2; float* agg; bf16* Y; };

template <int PASS> __device__ __forceinline__ void item(const Params& P, int b, int c, int blk, int lane, LAS f32x4* hfl  ) {
    const int fr = lane & 15, fq = lane >> 4;
    const bool isctx = c < 4; const int L = isctx ? CTXL : SEQ, t0 = (isctx ? c : c - 4) * 64 + 4 * fr, rbase = isctx ? NLAT + b * CTXL : b * SEQ;
    bf16x8 Af[4][2];
#pragma unroll
    for (int ks = 0; ks < 2; ++ks) {
        const int ch0 = blk * 64 + 32 * ks + 8 * fq;
        float xr[7][8];
#pragma unroll
        for (int i = 0; i < 7; ++i) { const int t = t0 - 1 + i; u32x4 w = (u32x4){0u, 0u, 0u, 0u};
            if (t >= 0 && t < L) w = *(const u32x4*)(P.XR + (size_t)(rbase + t) * DM + ch0);
            xr[i][0] = __uint_as_float(w.x << 16); xr[i][1] = __uint_as_float(w.x & 0xffff0000u); xr[i][2] = __uint_as_float(w.y << 16); xr[i][3] = __uint_as_float(w.y & 0xffff0000u);
            xr[i][4] = __uint_as_float(w.z << 16); xr[i][5] = __uint_as_float(w.z & 0xffff0000u); xr[i][6] = __uint_as_float(w.w << 16); xr[i][7] = __uint_as_float(w.w & 0xffff0000u); }
        float o[4][8];
        { const f32x4 b0 = *(const f32x4*)(P.convb + ch0), b1 = *(const f32x4*)(P.convb + ch0 + 4);
#pragma unroll
          for (int m = 0; m < 4; ++m) { o[m][0] = b0[0]; o[m][1] = b0[1]; o[m][2] = b0[2]; o[m][3] = b0[3]; o[m][4] = b1[0]; o[m][5] = b1[1]; o[m][6] = b1[2]; o[m][7] = b1[3]; } }
#pragma unroll
        for (int k = 0; k < 4; ++k) { const f32x4 w0 = *(const f32x4*)(P.convw + k * DM + ch0), w1 = *(const f32x4*)(P.convw + k * DM + ch0 + 4);
#pragma unroll
            for (int m = 0; m < 4; ++m) {
#pragma unroll
                for (int j = 0; j < 4; ++j) { o[m][j] += w0[j] * xr[m + k][j]; o[m][4 + j] += w1[j] * xr[m + k][4 + j]; } } }
#pragma unroll
        for (int m = 0; m < 4; ++m) { u32x4 w; w.x = pg8::cvt_pk_bf16(o[m][0], o[m][1]); w.y = pg8::cvt_pk_bf16(o[m][2], o[m][3]); w.z = pg8::cvt_pk_bf16(o[m][4], o[m][5]); w.w = pg8::cvt_pk_bf16(o[m][6], o[m][7]);
            Af[m][ks] = __builtin_bit_cast(bf16x8, w); }
    }
#pragma unroll
    for (int p = 0; p < 2; ++p) {
        const int chp = blk * 64 + 32 * p + 8 * fq;
#pragma unroll
        for (int dir = 0; dir < 2; ++dir) {
            float hinv[8];
            if (PASS == 2) {
                const int pos = dir == 0 ? c : (c < 4 ? 3 - c : 71 - c);
                float CA[8], CU[8];
#pragma unroll
                for (int j = 0; j < 8; ++j) { CA[j] = 1.f; CU[j] = 0.f; }
                for (int i = 5 * fr; i < 5 * fr + 5 && i < pos; ++i) {
                    const int cid = dir == 0 ? i : (i < 4 ? 3 - i : 71 - i);
                    const float* ap = P.agg + ((size_t)((dir * BATCH + b) * NCH + cid)) * 2048 + chp;
                    const f32x4 p0 = *(const f32x4*)(ap), p1 = *(const f32x4*)(ap + 4), s0 = *(const f32x4*)(ap + 1024), s1 = *(const f32x4*)(ap + 1028);
#pragma unroll
                    for (int j = 0; j < 4; ++j) { CU[j] = p0[j] * CU[j] + s0[j]; CA[j] = p0[j] * CA[j]; CU[4 + j] = p1[j] * CU[4 + j] + s1[j]; CA[4 + j] = p1[j] * CA[4 + j]; }
                }
                row_scan<0>(CA, CU);
#pragma unroll
                for (int j = 0; j < 8; ++j) hinv[j] = __int_as_float(__builtin_amdgcn_ds_bpermute(((lane & 48) | 15) << 2, __float_as_int(CU[j])));
            }
            f32x4 aR[4][2], aI[4][2];
#pragma unroll
            for (int nn = 0; nn < 2; ++nn) { const f32x4 vr = *(const f32x4*)(P.br + dir * DM + chp + 4 * nn), vi = *(const f32x4*)(P.bi + dir * DM + chp + 4 * nn);
#pragma unroll
                for (int m = 0; m < 4; ++m) { aR[m][nn] = vr; aI[m][nn] = vi; } }
#pragma unroll
            for (int gate = 0; gate < 2; ++gate) {
                bf16x8 Bf[2][2];
#pragma unroll
                for (int nn = 0; nn < 2; ++nn)
#pragma unroll
                    for (int ks = 0; ks < 2; ++ks) Bf[nn][ks] = *(const bf16x8*)(P.Wg + ((size_t)(((dir * 2 + gate) * 16 + blk) * 64 + 16 * (2 * p + nn) + fr)) * 64 + 32 * ks + 8 * fq);
#pragma unroll
                for (int m = 0; m < 4; ++m)
#pragma unroll
                    for (int nn = 0; nn < 2; ++nn)
#pragma unroll
                        for (int ks = 0; ks < 2; ++ks) { if (gate == 0) aR[m][nn] = __builtin_amdgcn_mfma_f32_16x16x32_bf16(Bf[nn][ks], Af[m][ks], aR[m][nn], 0, 0, 0);
                                                         else aI[m][nn] = __builtin_amdgcn_mfma_f32_16x16x32_bf16(Bf[nn][ks], Af[m][ks], aI[m][nn], 0, 0, 0); }
            }
            float c2v[8]; { const f32x4 x0 = *(const f32x4*)(P.c2 + dir * DM + chp), x1 = *(const f32x4*)(P.c2 + dir * DM + chp + 4); c2v[0] = x0[0]; c2v[1] = x0[1]; c2v[2] = x0[2]; c2v[3] = x0[3]; c2v[4] = x1[0]; c2v[5] = x1[1]; c2v[6] = x1[2]; c2v[7] = x1[3]; }
            float A[4][8], U[4][8];
#pragma unroll
            for (int m = 0; m < 4; ++m)
#pragma unroll
                for (int j = 0; j < 8; ++j) { const float rr = sigm(aR[m][j >> 2][j & 3]), ii = sigm(aI[m][j >> 2][j & 3]); const float av = __builtin_amdgcn_exp2f(rr * c2v[j]);
                    A[m][j] = av; U[m][j] = __builtin_amdgcn_sqrtf(fmaxf(1.f - av * av, 0.f)) * (ii * bfe(Af[m][p], j)); }
            if (dir == 0) {
#pragma unroll
                for (int m = 1; m < 4; ++m)
#pragma unroll
                    for (int j = 0; j < 8; ++j) { U[m][j] = A[m][j] * U[m - 1][j] + U[m][j]; A[m][j] = A[m][j] * A[m - 1][j]; }
            } else {
#pragma unroll
                for (int m = 2; m >= 0; --m)
#pragma unroll
                    for (int j = 0; j < 8; ++j) { U[m][j] = A[m][j] * U[m + 1][j] + U[m][j]; A[m][j] = A[m][j] * A[m + 1][j]; }
            }
            float TA[8], TU[8];
#pragma unroll
            for (int j = 0; j < 8; ++j) { TA[j] = A[dir ? 0 : 3][j]; TU[j] = U[dir ? 0 : 3][j]; }
            if (dir == 0) row_scan<0>(TA, TU); else row_scan<1>(TA, TU);
            if (PASS == 1) {
                if (fr == (dir ? 0 : 15)) { float* ap = P.agg + ((size_t)((dir * BATCH + b) * NCH + c)) * 2048 + chp;
                    *(f32x4*)(ap) = (f32x4){TA[0], TA[1], TA[2], TA[3]}; *(f32x4*)(ap + 4) = (f32x4){TA[4], TA[5], TA[6], TA[7]};
                    *(f32x4*)(ap + 1024) = (f32x4){TU[0], TU[1], TU[2], TU[3]}; *(f32x4*)(ap + 1028) = (f32x4){TU[4], TU[5], TU[6], TU[7]}; }
            } else {
                float s[8];
#pragma unroll
                for (int j = 0; j < 8; ++j) { const float hin = hinv[j];
                    const float EA = dir == 0 ? dpp<0x111>(1.f, TA[j]) : dpp<0x101>(1.f, TA[j]), EU = dir == 0 ? dpp<0x111>(0.f, TU[j]) : dpp<0x101>(0.f, TU[j]);
                    s[j] = EU + EA * hin; }
                if (dir == 0) {
#pragma unroll
                    for (int m = 0; m < 4; ++m) { float h[8];
#pragma unroll
                        for (int j = 0; j < 8; ++j) h[j] = U[m][j] + A[m][j] * s[j];
                        hfl[(2 * m) * 64 + lane] = (f32x4){h[0], h[1], h[2], h[3]}; hfl[(2 * m + 1) * 64 + lane] = (f32x4){h[4], h[5], h[6], h[7]}; }
                } else {
#pragma unroll
                    for (int m = 0; m < 4; ++m) { bf16* yp = P.Y + (size_t)(rbase + (isctx ? c : c - 4) * 64 + 4 * fr + m) * YC + 1024 + chp;
                        const u32x4 g = *(const u32x4*)yp; float gv[8];
                        gv[0] = __uint_as_float(g.x << 16); gv[1] = __uint_as_float(g.x & 0xffff0000u); gv[2] = __uint_as_float(g.y << 16); gv[3] = __uint_as_float(g.y & 0xffff0000u);
                        gv[4] = __uint_as_float(g.z << 16); gv[5] = __uint_as_float(g.z & 0xffff0000u); gv[6] = __uint_as_float(g.w << 16); gv[7] = __uint_as_float(g.w & 0xffff0000u);
                        float o[8];
                        const f32x4 h0 = hfl[(2 * m) * 64 + lane], h1 = hfl[(2 * m + 1) * 64 + lane]; const float hfv[8] = {h0[0], h0[1], h0[2], h0[3], h1[0], h1[1], h1[2], h1[3]};
#pragma unroll
                        for (int j = 0; j < 8; ++j) o[j] = (hfv[j] + U[m][j] + A[m][j] * s[j]) * gv[j];
                        u32x4 w; w.x = pg8::cvt_pk_bf16(o[0], o[1]); w.y = pg8::cvt_pk_bf16(o[2], o[3]); w.z = pg8::cvt_pk_bf16(o[4], o[5]); w.w = pg8::cvt_pk_bf16(o[6], o[7]);
                        *(u32x4*)yp = w; }
                }
            }
        }
    }
}
template <int PASS> __device__ __forceinline__ void phase(const Params& P, int gw, int NGW, int lane, LAS f32x4* hfl) {
    for (int it = gw; it < BATCH * NCH * 16; it += NGW) { const int blk = it & 15, bc = it >> 4; item<PASS>(P, bc / NCH, bc % NCH, blk, lane, hfl); }
}
#undef LAS
}

#include <hip/hip_bf16.h>
#include <cmath>
namespace attn_body {
using bf16=__hip_bfloat16;
using bf16x8=__attribute__((ext_vector_type(8)))short;
using s16x4=__attribute__((ext_vector_type(4)))short;
using f32x16=__attribute__((ext_vector_type(16)))float;
using u32x4=__attribute__((ext_vector_type(4)))unsigned;
constexpr int D=64, QP=2048  , KP=128  ;
constexpr int NW=8,QBLK=32,QB=QBLK*NW,KVBLK=64;
constexpr int ATTN_UNIT_ROWS=QB;
__device__ __forceinline__ int crow(int r,int hi){return (r&3)+8*(r>>2)+4*hi;}
#define SBAR() __builtin_amdgcn_sched_barrier(0)
__device__ __forceinline__ void wmask(f32x16&p0,f32x16&p1,int d,int hi){
  const float NEG=-INFINITY; const int kb=d+4*hi;
  #pragma unroll
  for(int r=0;r<16;++r){const int x=kb+(r&3)+8*(r>>2); if(x<-128||x>128)p0[r]=NEG; if(x+32<-128||x+32>128)p1[r]=NEG;}
}

constexpr int NSLOT=3, SLOTB=8192;
constexpr int LDS_K=0, LDS_V=NSLOT*SLOTB, LDS_WS=2*NSLOT*SLOTB, LDS_OST=LDS_WS+NW*64*4, LDS_BYTES=LDS_OST+NW*4096;
constexpr float C2=0.125f*1.4426950408889634f;
__device__ __forceinline__ void glds16(const void*gsrc,unsigned lds_dst){unsigned keep;
  asm volatile("s_mov_b32 %0, m0\n\ts_mov_b32 m0, %2\n\ts_nop 0\n\tglobal_load_lds_dwordx4 %1, off\n\ts_mov_b32 m0, %0":"=&s"(keep):"v"(gsrc),"s"(lds_dst):"memory");}
__device__ __forceinline__ float max3f(float a,float b,float c){float r;asm("v_max3_f32 %0, %1, %2, %3":"=v"(r):"v"(a),"v"(b),"v"(c));return r;}
__device__ __forceinline__ float max2f(float a,float b){float r;asm("v_max_f32_e32 %0, %1, %2":"=v"(r):"v"(a),"v"(b));return r;}
__device__ __forceinline__ float fadd_s(float a,float b){float r;asm("v_add_f32_e32 %0, %1, %2":"=v"(r):"v"(a),"v"(b));return r;}
__device__ __forceinline__ float fsub_s(float a,float b){float r;asm("v_sub_f32_e32 %0, %1, %2":"=v"(r):"v"(a),"v"(b));return r;}
typedef float f32x2_t __attribute__((ext_vector_type(2))); typedef __bf16 bf16x2_t __attribute__((ext_vector_type(2)));
__device__ __forceinline__ unsigned cvtpk_s(float lo,float hi){f32x2_t v={lo,hi};bf16x2_t b=__builtin_convertvector(v,bf16x2_t);return __builtin_bit_cast(unsigned,b);}
#define WAIT_BAR(N) asm volatile("s_waitcnt vmcnt(" #N ") lgkmcnt(0)\n\ts_barrier":::"memory")

__device__ __forceinline__ void qkt(f32x16&p0,f32x16&p1,const char*Kslot,const bf16x8*qr,const f32x16&negm,int r32,int hi){
  const char*kb=Kslot+hi*1024+r32*16;
  #pragma unroll
  for(int d0=0;d0<4;++d0){
    const bf16x8 b0=*reinterpret_cast<const bf16x8*>(kb+d0*2048);
    const bf16x8 b1=*reinterpret_cast<const bf16x8*>(kb+d0*2048+512);
    if(d0==0){p0=__builtin_amdgcn_mfma_f32_32x32x16_bf16(b0,qr[0],negm,0,0,0);p1=__builtin_amdgcn_mfma_f32_32x32x16_bf16(b1,qr[0],negm,0,0,0);}
    else{p0=__builtin_amdgcn_mfma_f32_32x32x16_bf16(b0,qr[d0],p0,0,0,0);p1=__builtin_amdgcn_mfma_f32_32x32x16_bf16(b1,qr[d0],p1,0,0,0);}}
}
typedef __attribute__((address_space(3))) const char* lds_cptr;
typedef short v4i16_t __attribute__((ext_vector_type(4)));
__device__ __forceinline__ void kload8(bf16x8*kf,lds_cptr kp){
  kf[0]=*(const __attribute__((address_space(3))) bf16x8*)(kp);      kf[1]=*(const __attribute__((address_space(3))) bf16x8*)(kp+512);
  kf[2]=*(const __attribute__((address_space(3))) bf16x8*)(kp+2048); kf[3]=*(const __attribute__((address_space(3))) bf16x8*)(kp+2560);
  kf[4]=*(const __attribute__((address_space(3))) bf16x8*)(kp+4096); kf[5]=*(const __attribute__((address_space(3))) bf16x8*)(kp+4608);
  kf[6]=*(const __attribute__((address_space(3))) bf16x8*)(kp+6144); kf[7]=*(const __attribute__((address_space(3))) bf16x8*)(kp+6656);
}
__device__ __forceinline__ void kload2(bf16x8*kf,lds_cptr kp,int j){ kf[2*j]=*(const __attribute__((address_space(3))) bf16x8*)(kp+j*2048); kf[2*j+1]=*(const __attribute__((address_space(3))) bf16x8*)(kp+j*2048+512); }
__device__ __forceinline__ s16x4 vtr(lds_cptr p){ return __builtin_bit_cast(s16x4,__builtin_amdgcn_ds_read_tr16_b64_v4i16((__attribute__((address_space(3))) v4i16_t*)p)); }
__device__ __forceinline__ float rowmax(const f32x16&p0,const f32x16&p1){
  float a=max3f(p0[0],p0[1],p1[0]),b=max3f(p0[2],p0[3],p1[1]);a=max3f(a,p1[2],p1[3]);
  #pragma unroll
  for(int r=4;r<16;r+=4){a=max3f(a,p0[r],p0[r+1]);b=max3f(b,p0[r+2],p0[r+3]);a=max3f(a,p1[r],p1[r+1]);b=max3f(b,p1[r+2],p1[r+3]);}
  const float m=max2f(a,b);
  auto rr=__builtin_amdgcn_permlane32_swap(__float_as_uint(m),__float_as_uint(m),false,false);
  return max2f(__uint_as_float(rr[0]),__uint_as_float(rr[1]));
}
__device__ __forceinline__ void pv(f32x16*o,int vb,bf16x8 pa0,bf16x8 pa1,bf16x8 pa2,bf16x8 pa3){
  #pragma unroll
  for(int d0=0;d0<2;++d0){s16x4 lo[4],hi[4];
    #pragma unroll
    for(int ks=0;ks<4;++ks){
      asm volatile("ds_read_b64_tr_b16 %0,%1 offset:%c2":"=&v"(lo[ks]):"v"(vb),"i"(d0*4096+ks*1024):"memory");
      asm volatile("ds_read_b64_tr_b16 %0,%1 offset:%c2":"=&v"(hi[ks]):"v"(vb),"i"(d0*4096+ks*1024+512):"memory");}
    asm volatile("s_waitcnt lgkmcnt(0)":::"memory");SBAR();
    #define PK(k) (bf16x8){lo[k][0],lo[k][1],lo[k][2],lo[k][3],hi[k][0],hi[k][1],hi[k][2],hi[k][3]}
    o[d0]=__builtin_amdgcn_mfma_f32_32x32x16_bf16(pa0,PK(0),o[d0],0,0,0);
    o[d0]=__builtin_amdgcn_mfma_f32_32x32x16_bf16(pa1,PK(1),o[d0],0,0,0);
    o[d0]=__builtin_amdgcn_mfma_f32_32x32x16_bf16(pa2,PK(2),o[d0],0,0,0);
    o[d0]=__builtin_amdgcn_mfma_f32_32x32x16_bf16(pa3,PK(3),o[d0],0,0,0);
    #undef PK
  }
}

#ifndef ATTN_STORE16
#define ATTN_STORE16(p,v) (*(u32x4*)(p)=(v))
#endif
struct UnitDesc { int qrow0, qcol, kvcol, NT, n0, r0, r1, mq0, mk0; float sink2; };
template<int KIND,int THRL> __device__ __forceinline__ void attn_unit(const UnitDesc&ud,bf16*Y,const bf16*__restrict__ K,const bf16*__restrict__ V,char*shm){
  int tid_=threadIdx.x; asm volatile("":"+v"(tid_));
  const int tid=tid_,lane=tid&63,r32=lane&31,hi=lane>>5; const int wid=__builtin_amdgcn_readfirstlane(tid>>6);
  const bf16*Qw=Y+(long)(ud.qrow0+wid*QBLK)*QP+ud.qcol;
  const bf16*Kh=K+ud.kvcol,*Vh=V+ud.kvcol;
  #define TROW(t) ((long)((t)<ud.n0?ud.r0+64*(t):ud.r1+64*((t)-ud.n0)))
  const unsigned lds0=(unsigned)(uintptr_t)shm;
  float*wsf=(float*)(shm+LDS_WS)+wid*64;
  const bf16*ksrc=Kh+(long)lane*KP+wid*8;
  const bf16*vsrc=Vh+(long)(16*(wid&3)+(lane>>2))*KP+(wid>>2)*32+(lane&3)*8;
  const unsigned kdst=lds0+LDS_K+wid*1024, vdst=lds0+LDS_V+wid*1024;
  #define DMA_K(t,slot) glds16(ksrc+TROW(t)*KP,(unsigned)__builtin_amdgcn_readfirstlane(kdst+(slot)))
  #define DMA_V(t,slot) glds16(vsrc+TROW(t)*KP,(unsigned)__builtin_amdgcn_readfirstlane(vdst+(slot)))
  const int vb0=(int)(lds0+LDS_V)+((lane>>4)&1)*32+(lane&3)*8+(4*hi+((lane&15)>>2))*64;
  const char*Kbase=shm+LDS_K; bf16x8 kf[8];
  const lds_cptr shm3=(lds_cptr)shm; const lds_cptr kp0=shm3+LDS_K+hi*1024+r32*16; const lds_cptr vp0=shm3+LDS_V+((lane>>4)&1)*32+(lane&3)*8+(4*hi+((lane&15)>>2))*64;
  const int NT=ud.NT;
  DMA_K(0,0);DMA_V(0,0);DMA_K(1,SLOTB);
  bf16x8 qr[4];
  #pragma unroll
  for(int d0=0;d0<4;++d0)qr[d0]=*reinterpret_cast<const bf16x8*>(&Qw[(long)r32*QP+d0*16+hi*8]);
  float mhat=0.f,l_reg=0.f;f32x16 o[2];o[0]=f32x16{};o[1]=f32x16{};f32x16 negm=f32x16{};asm volatile("":"+v"(negm));
  const int qoff=ud.mq0+wid*QBLK+r32;
  #define CMASK(P0,P1,t) do{ if(KIND==0&&(t)>=4)wmask(P0,P1,ud.mk0+64*((t)-4)-qoff,hi); }while(0)
  bool resc=false;
  #define START(P0,P1) do{ const float rm=rowmax(P0,P1); resc=false; \
    { const float dl=rm; mhat=fadd_s(mhat,dl); \
      _Pragma("unroll") for(int r=0;r<16;++r){P0[r]=fsub_s(P0[r],dl);P1[r]=fsub_s(P1[r],dl);} \
      _Pragma("unroll") for(int r=0;r<16;++r)negm[r]=-mhat; asm volatile("":"+v"(negm)); } \
    _Pragma("unroll") for(int r=0;r<16;++r)P0[r]=__builtin_amdgcn_exp2f(P0[r]); }while(0)
  #define RESC() do{ if(resc){ asm volatile("s_waitcnt lgkmcnt(0)":::"memory"); \
      _Pragma("unroll") for(int d_=0;d_<2;++d_) _Pragma("unroll") for(int r=0;r<16;++r)o[d_][r]*=wsf[crow(r,hi)]; } }while(0)
  f32x16 pA0,pA1,pB0,pB1;
  int sl_prev=0,sl_cur=0,sl_next=SLOTB;
  #define ROT() do{sl_prev=sl_cur;sl_cur=sl_next;sl_next=(sl_next==(NSLOT-1)*SLOTB)?0:sl_next+SLOTB;}while(0)
  DMA_K(2,2*SLOTB);
  WAIT_BAR(3);
  qkt(pA0,pA1,Kbase,qr,negm,r32,hi);asm volatile("s_nop 15\n\ts_nop 7":"+v"(pA0),"+v"(pA1));CMASK(pA0,pA1,0);
  START(pA0,pA1);
  _Pragma("unroll") for(int r=0;r<16;++r)pA1[r]=__builtin_amdgcn_exp2f(pA1[r]);
  WAIT_BAR(0);
  DMA_K(3,0);DMA_V(1,SLOTB);
  ROT();
  kload8(kf,kp0+sl_cur);
  WAIT_BAR(2);
  s16x4 vlo[8],vhi[8]; u32x4 pw0,pw1,pw2,pw3;
  #define PKW(P,B) cvtpk_s(P[B],P[B+1])
  #define PAF(k) __builtin_bit_cast(bf16x8,pw##k)
  #define VFR(i) (bf16x8){vlo[i][0],vlo[i][1],vlo[i][2],vlo[i][3],vhi[i][0],vhi[i][1],vhi[i][2],vhi[i][3]}
  #define PIN(x) asm volatile("":"+v"(x))
  #define MX3(a,b,c) __builtin_fmaxf(__builtin_fmaxf((a),(b)),(c))
  #define GAPA(MF,A0,A1,A2,A3,W0,W1,PW) do{ MF; sacc+=A0; sacc+=A1; sacc+=A2; sacc+=A3; PIN(sacc); W0; W1; PIN(PW); SBAR(); }while(0)
  #define EX(v) __builtin_amdgcn_exp2f(v)
  #define GAPB(MF,X,B) do{ MF; X[B]=EX(X[B]); X[B+1]=EX(X[B+1]); X[B+2]=EX(X[B+2]); X[B+3]=EX(X[B+3]); PIN(X); SBAR(); }while(0)
  #define VRD(i) do{ vlo[i]=vtr(vp_+(((i)>>2)*4096+((i)&3)*1024)); vhi[i]=vtr(vp_+(((i)>>2)*4096+((i)&3)*1024+512)); }while(0)
  #define KRD(G,j) do{ if(G){ kload2(kf,kp0+sl_next,j); SBAR(); } }while(0)
  #define STEP(C0,C1,P0,P1,t,GK,GV,GL) do{ SBAR(); \
    const lds_cptr vp_=vp0+sl_prev; \
    VRD(0); SBAR(); float sacc=(P0[0]+P0[1]); \
    GAPA(C0=__builtin_amdgcn_mfma_f32_32x32x16_bf16(kf[0],qr[0],negm,0,0,0), P0[2],P0[3],P0[4],P0[5],     pw0[0]=PKW(P0,0), pw0[1]=PKW(P0,2), pw0); \
    VRD(4); SBAR(); GAPA(C1=__builtin_amdgcn_mfma_f32_32x32x16_bf16(kf[1],qr[0],negm,0,0,0), P0[6],P0[7],P0[8],P0[9],     pw0[2]=PKW(P0,4), pw0[3]=PKW(P0,6), pw0); \
    VRD(1); SBAR(); GAPA(C0=__builtin_amdgcn_mfma_f32_32x32x16_bf16(kf[2],qr[1],C0,0,0,0),   P0[10],P0[11],P0[12],P0[13], pw1[0]=PKW(P0,8), pw1[1]=PKW(P0,10), pw1); \
    VRD(5); SBAR(); GAPA(C1=__builtin_amdgcn_mfma_f32_32x32x16_bf16(kf[3],qr[1],C1,0,0,0),   P0[14],P0[15],P1[0],P1[1],   pw1[2]=PKW(P0,12),pw1[3]=PKW(P0,14), pw1); \
    VRD(2); SBAR(); GAPA(C0=__builtin_amdgcn_mfma_f32_32x32x16_bf16(kf[4],qr[2],C0,0,0,0),   P1[2],P1[3],P1[4],P1[5],     pw2[0]=PKW(P1,0), pw2[1]=PKW(P1,2), pw2); \
    VRD(6); SBAR(); GAPA(C1=__builtin_amdgcn_mfma_f32_32x32x16_bf16(kf[5],qr[2],C1,0,0,0),   P1[6],P1[7],P1[8],P1[9],     pw2[2]=PKW(P1,4), pw2[3]=PKW(P1,6), pw2); \
    VRD(3); SBAR(); GAPA(C0=__builtin_amdgcn_mfma_f32_32x32x16_bf16(kf[6],qr[3],C0,0,0,0),   P1[10],P1[11],P1[12],P1[13], pw3[0]=PKW(P1,8), pw3[1]=PKW(P1,10), pw3); \
    VRD(7); SBAR(); GAPA(C1=__builtin_amdgcn_mfma_f32_32x32x16_bf16(kf[7],qr[3],C1,0,0,0),   P1[14],P1[15],0.f,0.f,       pw3[2]=PKW(P1,12),pw3[3]=PKW(P1,14), pw3); \
    l_reg+=sacc; \
    if(GK){DMA_K((t)+3,sl_cur);} if(GV){DMA_V((t)+1,sl_next);} \
    CMASK(C0,C1,t); \
    { float a=MX3(C0[0],C0[1],C1[0]),b=MX3(C0[2],C0[3],C1[1]); a=MX3(a,C1[2],C1[3]); \
      _Pragma("unroll") for(int r=4;r<16;r+=4){a=MX3(a,C0[r],C0[r+1]);b=MX3(b,C0[r+2],C0[r+3]);a=MX3(a,C1[r],C1[r+1]);b=MX3(b,C1[r+2],C1[r+3]);} \
      float rm=__builtin_fmaxf(a,b); { auto rr=__builtin_amdgcn_permlane32_swap(__float_as_uint(rm),__float_as_uint(rm),false,false); rm=__builtin_fmaxf(__uint_as_float(rr[0]),__uint_as_float(rr[1])); } \
      resc=false; \
      if(__builtin_expect(__any(rm>(float)THRL),0)){ const float dl=__builtin_fmaxf(rm,0.f); mhat+=dl; \
        _Pragma("unroll") for(int r=0;r<16;++r){C0[r]-=dl;C1[r]-=dl;} \
        _Pragma("unroll") for(int r=0;r<16;++r)negm[r]=-mhat; asm volatile("":"+v"(negm)); \
        const float f=__builtin_amdgcn_exp2f(-dl); l_reg*=f; if(hi==0)wsf[r32]=f; resc=true; } } \
    SBAR(); \
    GAPB(o[0]=__builtin_amdgcn_mfma_f32_32x32x16_bf16(PAF(0),VFR(0),o[0],0,0,0), C0,0); \
    GAPB(o[1]=__builtin_amdgcn_mfma_f32_32x32x16_bf16(PAF(0),VFR(4),o[1],0,0,0), C0,4); \
    KRD(GL,0); GAPB(o[0]=__builtin_amdgcn_mfma_f32_32x32x16_bf16(PAF(1),VFR(1),o[0],0,0,0), C0,8); \
    KRD(GL,1); GAPB(o[1]=__builtin_amdgcn_mfma_f32_32x32x16_bf16(PAF(1),VFR(5),o[1],0,0,0), C0,12); \
    KRD(GL,2); GAPB(o[0]=__builtin_amdgcn_mfma_f32_32x32x16_bf16(PAF(2),VFR(2),o[0],0,0,0), C1,0); \
    KRD(GL,3); GAPB(o[1]=__builtin_amdgcn_mfma_f32_32x32x16_bf16(PAF(2),VFR(6),o[1],0,0,0), C1,4); \
    GAPB(o[0]=__builtin_amdgcn_mfma_f32_32x32x16_bf16(PAF(3),VFR(3),o[0],0,0,0), C1,8); \
    GAPB(o[1]=__builtin_amdgcn_mfma_f32_32x32x16_bf16(PAF(3),VFR(7),o[1],0,0,0), C1,12); \
    }while(0)
  int t=1;
  for(;t+5<NT;t+=2){
    STEP(pB0,pB1,pA0,pA1,t,true,true,true);     WAIT_BAR(2); RESC(); ROT();
    STEP(pA0,pA1,pB0,pB1,t+1,true,true,true);   WAIT_BAR(2); RESC(); ROT();
  }
  #define ENDW(tt) do{ if((tt)+3<NT){WAIT_BAR(2);} else if((tt)+2<NT){WAIT_BAR(1);} else {WAIT_BAR(0);} }while(0)
  for(;t+1<NT;t+=2){
    STEP(pB0,pB1,pA0,pA1,t,(t+3<NT),(t+1<NT),(t+1<NT));       ENDW(t);   RESC(); ROT();
    STEP(pA0,pA1,pB0,pB1,t+1,(t+4<NT),(t+2<NT),(t+2<NT));     ENDW(t+1); RESC(); ROT();
  }
  STEP(pB0,pB1,pA0,pA1,NT-1,false,false,false); RESC();
  { float sacc=pB0[0]+pB0[1]; _Pragma("unroll") for(int r=2;r<16;++r)sacc+=pB0[r]; _Pragma("unroll") for(int r=0;r<16;++r)sacc+=pB1[r]; l_reg+=sacc;
    pw0=(u32x4){PKW(pB0,0),PKW(pB0,2),PKW(pB0,4),PKW(pB0,6)};pw1=(u32x4){PKW(pB0,8),PKW(pB0,10),PKW(pB0,12),PKW(pB0,14)};pw2=(u32x4){PKW(pB1,0),PKW(pB1,2),PKW(pB1,4),PKW(pB1,6)};pw3=(u32x4){PKW(pB1,8),PKW(pB1,10),PKW(pB1,12),PKW(pB1,14)};
    SBAR(); pv(o,vb0+sl_cur,PAF(0),PAF(1),PAF(2),PAF(3)); }
  #undef PKW
  #undef PAF
  #undef VFR
  #undef PIN
  #undef MX3
  #undef GAPA
  #undef GAPB
  #undef EX
  #undef VRD
  #undef KRD
  #undef STEP
  #undef ENDW
  {auto rr=__builtin_amdgcn_permlane32_swap(__float_as_uint(l_reg),__float_as_uint(l_reg),false,false);l_reg=__uint_as_float(rr[0])+__uint_as_float(rr[1]);}
  if(KIND==0)l_reg+=__builtin_amdgcn_exp2f(ud.sink2-mhat);
  if(hi==0)wsf[32+r32]=l_reg;asm volatile("s_waitcnt lgkmcnt(0)":::"memory");
  float rli[16];
  #pragma unroll
  for(int r=0;r<16;++r)rli[r]=__builtin_amdgcn_rcpf(wsf[32+crow(r,hi)]);
  bf16*Ow=Y+(long)(ud.qrow0+wid*QBLK)*QP+ud.qcol;
  { bf16*stg=(bf16*)(shm+LDS_OST)+wid*2048;
    #pragma unroll
    for(int r=0;r<16;++r){const int orow=crow(r,hi);
      #pragma unroll
      for(int d0=0;d0<2;++d0)stg[orow*64+d0*32+r32]=__float2bfloat16(o[d0][r]*rli[r]);}
    asm volatile("s_waitcnt lgkmcnt(0)":::"memory");
    #pragma unroll
    for(int i=0;i<4;++i){const int row=i*8+(lane>>3),ch=lane&7; const u32x4 v=*(const u32x4*)(stg+row*64+ch*8); ATTN_STORE16(Ow+(long)row*QP+ch*8,v);} }
  asm volatile("s_waitcnt lgkmcnt(0)\n\ts_barrier":::"memory");
  #undef DMA_K
  #undef DMA_V
  #undef TROW
  #undef CMASK
  #undef START
  #undef RESC
  #undef ROT
}
constexpr int ATTN_LDS_BYTES=LDS_BYTES;
#undef SBAR
#undef WAIT_BAR
}

#ifndef PG8_SP2
#define PG8_SP2 true
#endif
#ifndef PG8_ALIGN
#define PG8_ALIGN true
#endif

#ifndef PG8_SP2
#define PG8_SP2 true
#endif
#ifndef PG8_ALIGN
#define PG8_ALIGN true
#endif
constexpr int NWAVES = 8;
constexpr int RING_OFF = 0, RING_BYTES = 131072;
constexpr int LDSCTL_OFF = RING_BYTES, MISC_OFF = LDSCTL_OFF + 320;
constexpr int LDS_BYTES = 147456;
constexpr size_t WS_W = 1 * MiB;
constexpr size_t WO_IN = 0, WO_MERGE = 13 * MiB, WO_OUT = 17 * MiB, WO_FF1 = 19 * MiB, WO_FF2 = 27 * MiB, WO_LRU = 35 * MiB;
constexpr int CW_TMO = 0, CW_CODE = 1, CW_BAR = 4096;
constexpr size_t CTL_ZERO_BYTES = 64 * 1024;

#define GAS __attribute__((address_space(1)))
#define LAS __attribute__((address_space(3)))
typedef unsigned v4u __attribute__((ext_vector_type(4)));
typedef float f32x4 __attribute__((ext_vector_type(4)));
typedef short bf16x8 __attribute__((ext_vector_type(8)));
typedef GAS unsigned gu32;
typedef GAS unsigned long long gu64;
#define RLX_AGENT __ATOMIC_RELAXED, __HIP_MEMORY_SCOPE_AGENT
#define LDS_WAIT() asm volatile("s_waitcnt lgkmcnt(0)" ::: "memory")
#define VM_WAIT() asm volatile("s_waitcnt vmcnt(0)" ::: "memory")
__device__ __forceinline__ unsigned long long rt() { return __builtin_amdgcn_s_memrealtime(); }
__device__ __forceinline__ unsigned f2bfu(float f) { unsigned u = __builtin_bit_cast(unsigned, f); return (u + 0x7fffu + ((u >> 16) & 1u)) >> 16; }
__device__ __forceinline__ unsigned pk2(float lo, float hi) { return f2bfu(lo) | (f2bfu(hi) << 16); }

#define XB_TMO      128
#define XB_XCNT(j)  (256  + 64 * (j))
#define XB_XSUB(j)  (1280 + 64 * (j))
#define XB_XGEN(j)  (2304 + 64 * (j))
#define XB_TOP      3328
#define XB_TOPGEN   3392
#define XCD_BAR_WORDS 3456
#define XB_SPIN_CAP (1u << 18)

__device__ __forceinline__ unsigned xb_ld(unsigned* p)              { return __hip_atomic_load(p, __ATOMIC_RELAXED, __HIP_MEMORY_SCOPE_AGENT); }
__device__ __forceinline__ unsigned xb_add(unsigned* p, unsigned v) { return __hip_atomic_fetch_add(p, v, __ATOMIC_RELAXED, __HIP_MEMORY_SCOPE_AGENT); }
__device__ __forceinline__ unsigned xb_xcc_id() { return (unsigned)__builtin_amdgcn_s_getreg((3 << 11) | 20) & 0xFu; }
#define XB_SPIN(cond, bar) do { unsigned _sp = 0; while (cond) { __builtin_amdgcn_s_sleep(1); \
    if ((++_sp & 255u) == 0u) { if (xb_ld(&(bar)[XB_TMO])) break; if (_sp > XB_SPIN_CAP) { atomicAdd(&(bar)[XB_TMO], 1u); break; } } } } while (0)

struct XcdBarrier {
    unsigned* bar; unsigned x;
    volatile LAS unsigned* st;
};

__device__ __forceinline__ XcdBarrier xcd_barrier_post(unsigned* bar, volatile LAS unsigned* st) {
    XcdBarrier b; b.bar = bar; b.x = xb_xcc_id(); b.st = st;
    if (threadIdx.x == 0) (void)xb_add(&bar[XB_XCNT(b.x)], 1u);
    return b;
}
__device__ __forceinline__ void xcd_barrier_complete(unsigned* bar, unsigned x, unsigned& nloc, unsigned& nx) {
    const unsigned G = gridDim.x * gridDim.y * gridDim.z;
    unsigned sum, cnt, mine, sp = 0u;
    for (;;) {
        sum = 0u; cnt = 0u; mine = 0u;
#pragma unroll
        for (unsigned j = 0; j < 16; ++j) { const unsigned c = xb_ld(&bar[XB_XCNT(j)]); sum += c; cnt += (c > 0u) ? 1u : 0u; mine = (j == x) ? c : mine; }
        if (sum == G) break;
        __builtin_amdgcn_s_sleep(1);
        if ((++sp & 255u) == 0u) { if (xb_ld(&bar[XB_TMO])) break; if (sp > XB_SPIN_CAP) { atomicAdd(&bar[XB_TMO], 1u); break; } }
    }
    nloc = mine > 0u ? mine : 1u; nx = cnt > 0u ? cnt : 1u;
}

__device__ __forceinline__ void xcd_barrier(const XcdBarrier& b) {
    asm volatile("s_waitcnt vmcnt(0)" ::: "memory");
    __syncthreads();
    if (threadIdx.x == 0) {
        unsigned* bar = b.bar;
        __builtin_amdgcn_s_waitcnt(0);
        unsigned nloc = b.st[0], nx = b.st[1];
        if (nloc == 0u) { xcd_barrier_complete(bar, b.x, nloc, nx); b.st[0] = nloc; b.st[1] = nx; }
        const unsigned old = xb_add(&bar[XB_XSUB(b.x)], 1u);
        const unsigned gen = old / nloc;
        if (old + 1u == (gen + 1u) * nloc) {
            __builtin_amdgcn_fence(__ATOMIC_RELEASE, "agent");
            asm volatile("s_waitcnt vmcnt(0)" ::: "memory");
            const unsigned og = xb_add(&bar[XB_TOP], 1u);
            const unsigned tg = og / nx;
            if (og + 1u == (tg + 1u) * nx) xb_add(&bar[XB_TOPGEN], 1u);
            else XB_SPIN(xb_ld(&bar[XB_TOPGEN]) == tg, bar);
            __builtin_amdgcn_fence(__ATOMIC_ACQUIRE, "agent");
            xb_add(&bar[XB_XGEN(b.x)], 1u);
            asm volatile("s_waitcnt vmcnt(0)" ::: "memory");
        } else {
            XB_SPIN(xb_ld(&bar[XB_XGEN(b.x)]) == gen, bar);
            __builtin_amdgcn_fence(__ATOMIC_ACQUIRE, "agent");
            asm volatile("s_waitcnt vmcnt(0)" ::: "memory");
        }
    }
    __syncthreads();
}


template <int KIND> __device__ __forceinline__ void attn_latent(char* lds, bf16* Y, const bf16* K, const bf16* V, int vcu, int G, const float* sink) {
    for (int U = vcu; U < 512; U += G) {
        const int grp = (U & 255) >> 5, loc = U & 31, u = loc * 2 + (U >> 8), b = grp >> 1, kvh = grp & 1, h = kvh * 4 + (u >> 4), qb = u & 15;
        attn_body::UnitDesc ud; ud.qrow0 = b * SEQ + 256 * qb; ud.qcol = (KIND == 0 ? 0 : 512) + h * 64; ud.kvcol = kvh * 64;
        if (KIND == 1) { ud.NT = 68; ud.n0 = 64; ud.r0 = b * SEQ; ud.r1 = NLAT + b * CTXL; ud.mq0 = 0; ud.mk0 = 0; ud.sink2 = 0.f; }
        else { const int tl0 = 4 * qb - 2 < 0 ? 0 : 4 * qb - 2, tl1 = 4 * qb + 5 > 63 ? 63 : 4 * qb + 5;
            ud.NT = 4 + (tl1 - tl0 + 1); ud.n0 = 4; ud.r0 = NLAT + b * CTXL; ud.r1 = b * SEQ + 64 * tl0; ud.mq0 = 256 * qb; ud.mk0 = 64 * tl0; ud.sink2 = sink[h] * LOG2E; }
        attn_body::attn_unit<KIND, 8>(ud, (attn_body::bf16*)Y, (const attn_body::bf16*)K, (const attn_body::bf16*)V, lds);
    }
}
template <int KIND> __device__ __forceinline__ void attn_context(char* lds, bf16* Y, const bf16* K, const bf16* V, int vcu, int G, const float* sink) {
    for (int j = 0; j < 32; ++j) {
        const int b = j >> 3, h = j & 7, kvh = h >> 2, tgt = ((b * 2 + kvh) * 32 + 8 + (h & 3) + 4 * KIND) % G;
        if (tgt != vcu) continue;
        attn_body::UnitDesc ud; ud.qrow0 = NLAT + b * CTXL; ud.qcol = (KIND == 0 ? 0 : 512) + h * 64; ud.kvcol = kvh * 64;
        ud.NT = 4; ud.n0 = 4; ud.r0 = NLAT + b * CTXL; ud.r1 = 0; ud.mq0 = 0; ud.mk0 = 0; ud.sink2 = KIND == 0 ? sink[h] * LOG2E : 0.f;
        attn_body::attn_unit<KIND, 8>(ud, (attn_body::bf16*)Y, (const attn_body::bf16*)K, (const attn_body::bf16*)V, lds);
    }
}

#ifndef ATTN_ON
#define ATTN_ON 1
#endif
#ifndef PHMASK
#define PHMASK 0xffffffffu
#endif
#define PHM(p) ((PHMASK >> (p)) & 1u)
struct MkArgs { const float* in[27]; float* out; unsigned char* ws; int ph_lo, ph_hi, layer, pad; };
struct Frame {
    LAS unsigned char* lds; volatile LAS unsigned* MISC; gu32* ctl;
    int tid, lane, wave, vcu, G;
};
enum { PH_PRO = 0, PH_W = 1, PH_G1A = 2, PH_MIX1 = 3, PH_MIX2 = 4, PH_G1B = 5, PH_MERGE = 6, PH_OUT = 7, PH_LN1 = 8, PH_FF1 = 9, PH_FF2 = 10, PH_LN2 = 11, PH_COUNT = 12 };

__device__ __forceinline__ int tt_of_tile(int kind, int tile) { return kind == 0 ? pg8::TT_IDENT : kind == 1 ? pg8::TT_NAT8 : (tile < 6 ? pg8::TT_HEAD : pg8::TT_NAT8); }
__device__ __forceinline__ void transpose_item(const float* W, int ldw, int N, bf16* WT, int dpitch, int koff, int kind, LAS float* scr, int item, int lane) {
    const int nblk = N / 32, kb = item / nblk, nb = item % nblk, k0 = 64 * kb, n0 = 32 * nb;
#pragma unroll 8
    for (int i = 0; i < 32; ++i) { const int kk = 2 * i + (lane >> 5); scr[kk * 33 + (lane & 31)] = W[(size_t)(k0 + kk) * ldw + n0 + (lane & 31)]; }
    LDS_WAIT(); asm volatile("" ::: "memory");
    const int c = lane & 7;
#pragma unroll
    for (int j = 0; j < 4; ++j) { const int n = (lane >> 3) + 8 * j; const LAS float* s = scr + (8 * c) * 33 + n;
        v4u o; o.x = pk2(s[0 * 33], s[1 * 33]); o.y = pk2(s[2 * 33], s[3 * 33]); o.z = pk2(s[4 * 33], s[5 * 33]); o.w = pk2(s[6 * 33], s[7 * 33]);
        const int cl = n0 + n, tile = cl >> 8, drow = tile * 256 + pg8::tile_pos_of_logical(tt_of_tile(kind, tile), cl & 255);
        *(GAS v4u*)(WT + (size_t)drow * dpitch + koff + k0 + 8 * c) = o; }
    LDS_WAIT(); asm volatile("" ::: "memory");
}
__device__ __forceinline__ void phase_weights(Frame& F, const MkArgs& a, int l) {
    LAS float* scr = (LAS float*)(F.lds + RING_OFF + F.wave * 16384);
    const int gw = F.vcu * NWAVES + F.wave, NGW = F.G * NWAVES;
    bf16* wb = (bf16*)(a.ws + WS_W);
    bf16 *Wi = wb + WO_IN / 2, *Wm = wb + WO_MERGE / 2, *Wo = wb + WO_OUT / 2, *W1 = wb + WO_FF1 / 2, *W2 = wb + WO_FF2 / 2;
    const float* w_in = a.in[6] + (size_t)l * DM * INC; const float* wa = a.in[17] + (size_t)l * 512 * DM; const float* wbb = a.in[18] + (size_t)l * 512 * DM; const float* wc = a.in[19] + (size_t)l * DM * DM;
    const float* wo = a.in[20] + (size_t)l * DM * DM; const float* w1 = a.in[23] + (size_t)l * DM * DFF; const float* w2 = a.in[24] + (size_t)l * DFF * DM;
    constexpr int I_IN = 16 * (INC / 32), I_A = 8 * 32, I_C = 16 * 32, I_O = 16 * 32, I_1 = 16 * (DFF / 32), I_2 = 64 * 32;
    constexpr int NITEMS = I_IN + 2 * I_A + I_C + I_O + I_1 + I_2;
    for (int it = gw; it < NITEMS; it += NGW) {
        int r = it;
        if (r < I_IN) { transpose_item(w_in, INC, INC, Wi, DM, 0, 2, scr, r, F.lane); continue; } r -= I_IN;
        if (r < I_A) { transpose_item(wa, DM, DM, Wm, YC, 0, 1, scr, r, F.lane); continue; } r -= I_A;
        if (r < I_A) { transpose_item(wbb, DM, DM, Wm, YC, 512, 1, scr, r, F.lane); continue; } r -= I_A;
        if (r < I_C) { transpose_item(wc, DM, DM, Wm, YC, 1024, 1, scr, r, F.lane); continue; } r -= I_C;
        if (r < I_O) { transpose_item(wo, DM, DM, Wo, DM, 0, 0, scr, r, F.lane); continue; } r -= I_O;
        if (r < I_1) { transpose_item(w1, DFF, DFF, W1, DM, 0, 1, scr, r, F.lane); continue; } r -= I_1;
        transpose_item(w2, DM, DM, W2, DFF, 0, 0, scr, r, F.lane);
    }
    { bf16* Wg = wb + WO_LRU / 2; const float* wr = a.in[12] + (size_t)l * 2 * 16 * 4096; const float* wi = a.in[14] + (size_t)l * 2 * 16 * 4096;
      for (int idx = gw * 64 + F.lane; idx < 2 * 2 * 16 * 64 * 8; idx += NGW * 64) {
          const int dc = idx & 7, rho = (idx >> 3) & 63, blk = (idx >> 9) & 15, gate = (idx >> 13) & 1, dir = idx >> 14;
          const int n = rho >> 4, i = rho & 15, e = 32 * (n >> 1) + 8 * (i >> 2) + 4 * (n & 1) + (i & 3);
          const float* src = (gate ? wi : wr) + ((size_t)(dir * 16 + blk) * 64 + dc * 8) * 64 + e;
          v4u o; o.x = pk2(src[0], src[64]); o.y = pk2(src[128], src[192]); o.z = pk2(src[256], src[320]); o.w = pk2(src[384], src[448]);
          *(GAS v4u*)(Wg + (size_t)(idx >> 3) * 64 + dc * 8) = o; }
      float* c2 = (float*)(a.ws + WS_LRUC); const float* lam = a.in[16] + (size_t)l * 2 * DM;
      for (int idx = gw * 64 + F.lane; idx < 2 * DM; idx += NGW * 64) c2[idx] = -8.f * 1.4426950408889634f * log1pf(__expf(-lam[idx])); }
}


__device__ __forceinline__ float wave_sum(float v) {
#pragma unroll
    for (int o = 1; o < 64; o <<= 1) v += __shfl_xor(v, o);
    return v;
}
__device__ __forceinline__ void phase_pro(Frame& F, const MkArgs& a, float* mod, float* rope) {
    LAS float* red = (LAS float*)(F.lds + RING_OFF);
    const float* c = a.in[1]; const float* c_ctx = a.in[3]; const float* w_ada = a.in[4]; const float* b_ada = a.in[5];
    for (int it = F.vcu; it < DEPTH * 96; it += F.G) {
        const int l = it / 96, n = (it % 96) * 64 + F.lane;
        float acc[5] = {0.f, 0.f, 0.f, 0.f, 0.f};
        const float* wp = w_ada + ((size_t)l * DM + F.wave * 128) * 6144 + n;
#pragma unroll 4
        for (int k = 0; k < 128; ++k) { const float w = wp[(size_t)k * 6144]; const int kk = F.wave * 128 + k;
#pragma unroll
            for (int v = 0; v < 5; ++v) { const float x = v < 4 ? c[v * DM + kk] : c_ctx[kk]; acc[v] += (x / (1.f + __expf(-x))) * w; } }
        __syncthreads();
#pragma unroll
        for (int v = 0; v < 5; ++v) red[(F.wave * 5 + v) * 64 + F.lane] = acc[v];
        __syncthreads();
        if (F.wave < 5) { float s = b_ada[l * 6144 + n];
#pragma unroll
            for (int w = 0; w < 8; ++w) s += red[(w * 5 + F.wave) * 64 + F.lane];
            mod[((size_t)l * 5 + F.wave) * 6144 + n] = s; }
    }
    if (blockIdx.x == 0) for (int i = F.tid; i < 1024; i += NWAVES * 64) { const int pos = i / 16, f = i % 16;
        float inv = 1.f;
        inv = f == 1 ? 5.623413324e-01f : inv; inv = f == 2 ? 3.162277639e-01f : inv; inv = f == 3 ? 1.778279394e-01f : inv; inv = f == 4 ? 1.000000015e-01f : inv; inv = f == 5 ? 5.623413250e-02f : inv;
        inv = f == 6 ? 3.162277490e-02f : inv; inv = f == 7 ? 1.778279431e-02f : inv; inv = f == 8 ? 9.999999776e-03f : inv; inv = f == 9 ? 5.623413250e-03f : inv; inv = f == 10 ? 3.162277630e-03f : inv;
        inv = f == 11 ? 1.778279431e-03f : inv; inv = f == 12 ? 1.000000047e-03f : inv; inv = f == 13 ? 5.623413017e-04f : inv; inv = f == 14 ? 3.162277571e-04f : inv; inv = f == 15 ? 1.778279402e-04f : inv;
        const float ang = (float)pos * inv; rope[i] = cosf(ang); rope[1024 + i] = sinf(ang); }
}
__device__ __forceinline__ void phase_modulate(Frame& F, const float* xlat, const float* xctx, const float* modl, int sh_off, int sc_off, bf16* H) {
    const int gw = F.vcu * NWAVES + F.wave, NGW = F.G * NWAVES;
    for (int row = gw; row < NROW; row += NGW) {
        const float* xr = row < NLAT ? xlat + (size_t)row * DM : xctx + (size_t)(row - NLAT) * DM; const float* m = modl + (size_t)(row < NLAT ? row / SEQ : 4) * 6144;
        GAS unsigned long long* o8 = (GAS unsigned long long*)(H + (size_t)row * DM) + F.lane;
#pragma unroll
        for (int j = 0; j < 4; ++j) { const int c = 4 * F.lane + 256 * j; const f32x4 v = *(const f32x4*)(xr + c), sc = *(const f32x4*)(m + sc_off + c), sh = *(const f32x4*)(m + sh_off + c);
            const f32x4 y = v * (sc + 1.f) + sh; o8[64 * j] = (unsigned long long)pk2(y.x, y.y) | ((unsigned long long)pk2(y.z, y.w) << 32); }
    }
}
__device__ __forceinline__ void phase_ln(Frame& F, float* xlat, float* xctx, const float* g, const float* bta, const float* modl, int sh_off, int sc_off, bf16* H) {
    const int gw = F.vcu * NWAVES + F.wave, NGW = F.G * NWAVES;
    for (int row = gw; row < NROW; row += NGW) {
        float* xr = row < NLAT ? xlat + (size_t)row * DM : xctx + (size_t)(row - NLAT) * DM;
        f32x4 v[4]; float s = 0.f;
#pragma unroll
        for (int j = 0; j < 4; ++j) { v[j] = *(const f32x4*)(xr + 4 * F.lane + 256 * j); s += (v[j].x + v[j].y) + (v[j].z + v[j].w); }
        const float mean = wave_sum(s) * (1.f / DM); float q = 0.f;
#pragma unroll
        for (int j = 0; j < 4; ++j) { v[j] = v[j] - mean; q += (v[j].x * v[j].x + v[j].y * v[j].y) + (v[j].z * v[j].z + v[j].w * v[j].w); }
        const float rstd = 1.f / sqrtf(wave_sum(q) * (1.f / DM) + LN_EPS);
        const float* m = modl ? modl + (size_t)(row < NLAT ? row / SEQ : 4) * 6144 : nullptr;
        GAS unsigned long long* o8 = (GAS unsigned long long*)(H + (size_t)row * DM) + F.lane;
#pragma unroll
        for (int j = 0; j < 4; ++j) { const int c = 4 * F.lane + 256 * j; const f32x4 y = v[j] * rstd * *(const f32x4*)(g + c) + *(const f32x4*)(bta + c);
            *(f32x4*)(xr + c) = y;
            if (modl) { const f32x4 z = y * (*(const f32x4*)(m + sc_off + c) + 1.f) + *(const f32x4*)(m + sh_off + c); o8[64 * j] = (unsigned long long)pk2(z.x, z.y) | ((unsigned long long)pk2(z.z, z.w) << 32); } }
    }
}

__global__ void __launch_bounds__(NWAVES * 64, 2) mk_fwd(MkArgs args) {
    extern __shared__ __attribute__((aligned(16))) unsigned char lds[];
    Frame F;
    F.lds = (LAS unsigned char*)lds; F.MISC = (volatile LAS unsigned*)(F.lds + MISC_OFF);
    F.tid = threadIdx.x; F.lane = F.tid & 63; F.wave = __builtin_amdgcn_readfirstlane(F.tid >> 6);
    F.G = gridDim.x; { const int bx = blockIdx.x; F.vcu = (F.G % 8 == 0) ? (bx % 8) * (F.G / 8) + bx / 8 : bx; }
    F.ctl = (gu32*)(args.ws + WS_CTL);
    for (int u = F.tid; u < (LDS_BYTES - LDSCTL_OFF) / 4; u += NWAVES * 64) ((LAS unsigned*)(F.lds + LDSCTL_OFF))[u] = 0u;
    __syncthreads();
    XcdBarrier bar = xcd_barrier_post((unsigned*)(F.ctl + CW_BAR), F.MISC + 8);
    const int lo = args.ph_lo, hi = args.ph_hi;
    for (int gp = lo; gp < hi; ++gp) {
        const int l = gp / PH_COUNT, ph = gp % PH_COUNT;
        if (l > 0 && (ph == PH_PRO || ph == PH_W)) continue;
        unsigned long long wsi_ = (unsigned long long)args.ws; asm volatile("" : "+s"(wsi_)); unsigned char* ws = (unsigned char*)(GAS unsigned char*)wsi_;
        float* mod = (float*)(ws + WS_MOD); float* rope = (float*)(ws + WS_ROPE); float* ctxs = (float*)(ws + WS_CTXS);
        bf16* H = (bf16*)(ws + WS_H); bf16* Y = (bf16*)(ws + WS_Y); bf16* KA = (bf16*)(ws + WS_KA); bf16* VA = (bf16*)(ws + WS_VA); bf16* KB = (bf16*)(ws + WS_KB); bf16* VB = (bf16*)(ws + WS_VB);
        bf16* XR = (bf16*)(ws + WS_XR); bf16* G = (bf16*)(ws + WS_G); bf16* HID = (bf16*)(ws + WS_HID);
        bf16* wb = (bf16*)(ws + WS_W);
        { int t_ = threadIdx.x; asm volatile("" : "+v"(t_)); F.tid = t_; F.lane = t_ & 63; }
        const float* modl = mod + (size_t)l * 5 * 6144;
        if (PHM(PH_PRO) && ph == PH_PRO) { if (l == 0) phase_pro(F, args, mod, rope); }
        else if (PHM(PH_W) && ph == PH_W) { phase_weights(F, args, l); if (l == 0) phase_modulate(F, args.in[0], args.in[2], modl, 0, 1024, H); }
        else if ((PHM(PH_MIX1) && ph == PH_MIX1) || (PHM(PH_MIX2) && ph == PH_MIX2)) {
            lru::Params LP{XR, args.in[10] + (size_t)l * 4 * DM, args.in[11] + (size_t)l * DM, wb + WO_LRU / 2, args.in[13] + (size_t)l * 2 * DM, args.in[15] + (size_t)l * 2 * DM, (const float*)(ws + WS_LRUC), (float*)(ws + WS_AGG), Y};
            LAS lru::f32x4* hfl = (LAS lru::f32x4*)(F.lds + RING_OFF + F.wave * 8192);
            if (ph == PH_MIX1) lru::phase<1>(LP, F.vcu * NWAVES + F.wave, F.G * NWAVES, F.lane, hfl); else lru::phase<2>(LP, F.vcu * NWAVES + F.wave, F.G * NWAVES, F.lane, hfl);
            __syncthreads();
            const float* sink = args.in[7] + l * 8;
            if (ATTN_ON) {
            if (ph == PH_MIX1) { attn_latent<0>((char*)lds, Y, KA, VA, F.vcu, F.G, sink); if (l == 0) { attn_context<0>((char*)lds, Y, KA, VA, F.vcu, F.G, sink); attn_context<1>((char*)lds, Y, KB, VB, F.vcu, F.G, sink); } }
            else attn_latent<1>((char*)lds, Y, KB, VB, F.vcu, F.G, sink);
            }
        }
        else if (PHM(PH_LN1) && ph == PH_LN1) phase_ln(F, args.out, ctxs, args.in[21] + l * DM, args.in[22] + l * DM, modl, 3072, 4096, H);
        else if (PHM(PH_LN2) && ph == PH_LN2) { phase_ln(F, args.out, ctxs, args.in[25] + l * DM, args.in[26] + l * DM, l + 1 < DEPTH ? modl + 5 * 6144 : nullptr, 0, 1024, H); if (l + 1 < DEPTH) phase_weights(F, args, l + 1); }
        else if (PHM(PH_G1A) && ph == PH_G1A) {
            pg8::Gemm g{H, wb + WO_IN / 2, NROW, 3584, DM}; pg8::StaticOrder S; S.init(NROW, 3584, F.G, (int)blockIdx.x);
            pg8::EpiG1 E{Y, KA, VA, KB, VB, XR, G, rope, args.in[8] + l * 64, args.in[9] + l * 64, 0, 0};
            pg8::gemm_phase<pg8::EpiG1, pg8::StaticOrder, PG8_ALIGN, PG8_SP2>(F.lds + RING_OFF, g, S, E);
        } else if (PHM(PH_G1B) && ph == PH_G1B) {
            pg8::Gemm g{H, wb + WO_IN / 2 + (size_t)3584 * DM, NROW, 3072, DM}; pg8::StaticOrder S; S.init(NROW, 3072, F.G, (int)blockIdx.x);
            pg8::EpiG1 E{Y, KA, VA, KB, VB, XR, G, rope, args.in[8] + l * 64, args.in[9] + l * 64, 14, 0};
            pg8::gemm_phase<pg8::EpiG1, pg8::StaticOrder, PG8_ALIGN, PG8_SP2>(F.lds + RING_OFF, g, S, E);
        } else if (PHM(PH_MERGE) && ph == PH_MERGE) {
            pg8::Gemm g{Y, wb + WO_MERGE / 2, NROW, DM, YC}; pg8::StaticOrder S; S.init(NROW, DM, F.G, (int)blockIdx.x);
            pg8::EpiMerge E{G, H};
            pg8::gemm_phase<pg8::EpiMerge, pg8::StaticOrder, PG8_ALIGN, PG8_SP2>(F.lds + RING_OFF, g, S, E);
        } else if (PHM(PH_OUT) && ph == PH_OUT) {
            pg8::Gemm g{H, wb + WO_OUT / 2, NROW, DM, DM}; pg8::StaticOrder S; S.init(NROW, DM, F.G, (int)blockIdx.x);
            pg8::EpiResid E{l == 0 ? args.in[0] : args.out, l == 0 ? args.in[2] : ctxs, args.out, ctxs, modl, 2048, 0};
            pg8::gemm_phase<pg8::EpiResid, pg8::StaticOrder, PG8_ALIGN, PG8_SP2>(F.lds + RING_OFF, g, S, E);
        } else if (PHM(PH_FF1) && ph == PH_FF1) {
            pg8::Gemm g{H, wb + WO_FF1 / 2, NROW, DFF, DM}; pg8::StaticOrder S; S.init(NROW, DFF, F.G, (int)blockIdx.x);
            pg8::EpiNat8<3> E{HID, DFF};
            pg8::gemm_phase<pg8::EpiNat8<3>, pg8::StaticOrder, PG8_ALIGN, PG8_SP2>(F.lds + RING_OFF, g, S, E);
        } else if (PHM(PH_FF2) && ph == PH_FF2) {
            pg8::Gemm g{HID, wb + WO_FF2 / 2, NROW, DM, DFF}; pg8::StaticOrder S; S.init(NROW, DM, F.G, (int)blockIdx.x);
            pg8::EpiResid E{args.out, ctxs, args.out, ctxs, modl, 5120, 0};
            pg8::gemm_phase<pg8::EpiResid, pg8::StaticOrder, PG8_ALIGN, PG8_SP2>(F.lds + RING_OFF, g, S, E);
        }
        if (gp + 1 < hi) xcd_barrier(bar);
    }
}

static void launch_mk(const MkArgs& base, int l, int ph, int grid, hipStream_t stream) {
    MkArgs a = base; a.ph_lo = l * PH_COUNT + ph; a.ph_hi = a.ph_lo + 1; a.layer = l;
    hipLaunchKernelGGL(mk_fwd, dim3(grid), dim3(NWAVES * 64), LDS_BYTES, stream, a);
}
extern "C" void kernel_launch(void* const* d_in, const int* in_sizes, int n_in, void* d_out, int out_size, void* d_ws, size_t ws_size, hipStream_t stream) {
    if (n_in != 27 || ws_size < WS_END) { fprintf(stderr, "kernel_launch: unexpected n_in %d / ws_size %zu\n", n_in, ws_size); return; }
    static int grid = 0;
    if (grid == 0) {
        int dev = 0, cus = 0;
        if (hipGetDevice(&dev) != hipSuccess || hipDeviceGetAttribute(&cus, hipDeviceAttributeMultiprocessorCount, dev) != hipSuccess) { grid = -1; return; }
        if (hipFuncSetAttribute((const void*)mk_fwd, hipFuncAttributeMaxDynamicSharedMemorySize, LDS_BYTES) != hipSuccess) { fprintf(stderr, "hipFuncSetAttribute failed\n"); grid = -1; return; }
        grid = cus;
    }
    if (grid < 0) return;
    const float* x = (const float*)d_in[0]; const float* c = (const float*)d_in[1]; const float* ctx = (const float*)d_in[2]; const float* c_ctx = (const float*)d_in[3];
    const float* w_ada = (const float*)d_in[4]; const float* b_ada = (const float*)d_in[5]; const float* w_in = (const float*)d_in[6]; const float* a_sink = (const float*)d_in[7];
    const float* qgain = (const float*)d_in[8]; const float* kgain = (const float*)d_in[9]; const float* convw = (const float*)d_in[10]; const float* convb = (const float*)d_in[11];
    const float* c_wr = (const float*)d_in[12]; const float* c_br = (const float*)d_in[13]; const float* c_wi = (const float*)d_in[14]; const float* c_bi = (const float*)d_in[15];
    const float* c_lam = (const float*)d_in[16]; const float* w_br_a = (const float*)d_in[17]; const float* w_br_b = (const float*)d_in[18]; const float* w_br_c = (const float*)d_in[19];
    const float* w_out = (const float*)d_in[20]; const float* ln1_g = (const float*)d_in[21]; const float* ln1_b = (const float*)d_in[22]; const float* w_ff1 = (const float*)d_in[23];
    const float* w_ff2 = (const float*)d_in[24]; const float* ln2_g = (const float*)d_in[25]; const float* ln2_b = (const float*)d_in[26];
    char* ws = (char*)d_ws; float* out = (float*)d_out;
    float* mod = (float*)(ws + WS_MOD); float* rope = (float*)(ws + WS_ROPE); float* ctxs = (float*)(ws + WS_CTXS);
    bf16* H = (bf16*)(ws + WS_H); bf16* Y = (bf16*)(ws + WS_Y); bf16* KA = (bf16*)(ws + WS_KA); bf16* VA = (bf16*)(ws + WS_VA); bf16* KB = (bf16*)(ws + WS_KB); bf16* VB = (bf16*)(ws + WS_VB);
    bf16* XR = (bf16*)(ws + WS_XR); bf16* G = (bf16*)(ws + WS_G); bf16* HID = (bf16*)(ws + WS_HID); float* ZRAW = (float*)(ws + WS_ZRAW); bf16* HF = (bf16*)(ws + WS_HF);
    (void)w_in; (void)w_br_a; (void)w_br_b; (void)w_br_c; (void)w_out; (void)w_ff1; (void)w_ff2; (void)G; (void)HID; (void)ZRAW; (void)XR;
    MkArgs base; memset(&base, 0, sizeof(base));
    for (int i = 0; i < 27; ++i) base.in[i] = (const float*)d_in[i];
    base.out = out; base.ws = (unsigned char*)d_ws;

    hipMemsetAsync(ws + WS_CTL, 0, CTL_ZERO_BYTES, stream);
#if defined(MK_MULTI)
    launch_mk(base, 0, PH_PRO, grid, stream); launch_mk(base, 0, PH_W, grid, stream);
    for (int l = 0; l < DEPTH; ++l) for (int ph = PH_G1A; ph < PH_COUNT; ++ph) launch_mk(base, l, ph, grid, stream);
#else
    { MkArgs a = base; a.ph_lo = 0; a.ph_hi = DEPTH * PH_COUNT; a.layer = 0; hipLaunchKernelGGL(mk_fwd, dim3(grid), dim3(NWAVES * 64), LDS_BYTES, stream, a); }
#endif
}
```

```cpp
#include <hip/hip_runtime.h>
#include <cstdio>
#include <cstdint>
#include <cmath>
#include <cstring>

typedef unsigned short bf16;
constexpr int DM = 1024, BATCH = 4, SEQ = 4096, CTXL = 256, DEPTH = 2;
constexpr int NLAT = BATCH * SEQ, NCTX = BATCH * CTXL, NROW = NLAT + NCTX;
constexpr int HD = 64, GRIDW = 64, WINDOW = 128;
constexpr int INC = 6656, DFF = 4096, YC = 2048, GC = 3072;
constexpr int C_QA = 0, C_KA = 512, C_VA = 640, C_QB = 768, C_KB = 1280, C_VB = 1408, C_XR = 1536, C_YR = 2560, C_G = 3584;
constexpr float ALPHA = 1.41421356237309515f;
constexpr float LN_EPS = 1e-5f, RMS_EPS = 1e-6f;
constexpr float QSCALE = 0.125f * 1.4426950408889634f;
constexpr float LOG2E = 1.4426950408889634f;

constexpr size_t MiB = 1u << 20;
constexpr size_t WS_CTL = 0;
constexpr size_t WS_MOD = 37 * MiB;
constexpr size_t WS_ROPE = WS_MOD + 512 * 1024;
constexpr size_t WS_LRUC = WS_ROPE + 16384;
constexpr size_t WS_CTXS = 38 * MiB;
constexpr size_t WS_AGG = 42 * MiB;
constexpr size_t WS_H = 47 * MiB;
constexpr size_t WS_Y = 81 * MiB;
constexpr size_t WS_KA = 149 * MiB, WS_VA = WS_KA + 4352 * 1024, WS_KB = WS_VA + 4352 * 1024, WS_VB = WS_KB + 4352 * 1024;
constexpr size_t WS_XR = 166 * MiB;
constexpr size_t WS_G = 149 * MiB;
constexpr size_t WS_HID = 81 * MiB;
constexpr size_t WS_END = 252 * MiB;

__device__ __forceinline__ float bf2f(bf16 v) { return __uint_as_float(((unsigned)v) << 16); }
__device__ __forceinline__ bf16 f2bf(float f) { unsigned u = __float_as_uint(f); return (bf16)((u + 0x7fffu + ((u >> 16) & 1u)) >> 16); }
__device__ __forceinline__ float bfr(float f) { return bf2f(f2bf(f)); }
__device__ __forceinline__ float sigmoidf_(float x) { return 1.f / (1.f + __expf(-x)); }
__device__ __forceinline__ float gelu_tanh(float x) { const float u = 0.7978845608028654f * (x + 0.044715f * x * x * x); return 0.5f * x * (1.f + tanhf(u)); }
__device__ __forceinline__ int row_batch(int row) { return row < NLAT ? row / SEQ : (row - NLAT) / CTXL; }
__device__ __forceinline__ int row_modidx(int row) { return row < NLAT ? row / SEQ : 4; }

namespace pg8 {

#define PG8_LAS __attribute__((address_space(3)))
typedef unsigned short bf16_t;
typedef short bf16x8 __attribute__((ext_vector_type(8)));
typedef float f32x4 __attribute__((ext_vector_type(4)));
typedef unsigned u32x4 __attribute__((ext_vector_type(4)));
constexpr int BM = 256, BK = 64, HALF = 128, HTB = HALF * BK * 2  , STAGE_BYTES = 8 * HTB, NXCD = 8, WGM = 8;

__host__ __device__ __forceinline__ int lds_byte(int r, int c) { const int st = (r >> 4) * 2 + (c >> 5), rr = r & 15, cc = c & 31, ob = rr * 64 + cc * 2; return st * 1024 + (ob ^ (((ob >> 9) & 1) << 5)); }
__host__ __device__ __forceinline__ void stage_rc(int b, int& R, int& C) { const int st = b / 1024, sb = b % 1024, swz = sb ^ (((sb >> 9) & 1) << 5); R = (st >> 1) * 16 + swz / 64; C = (st & 1) * 32 + (swz % 64) / 2; }
__host__ __device__ __forceinline__ int perm32(int rho) { const int n = rho >> 4, i = rho & 15; return 8 * (i >> 2) + 4 * n + (i & 3); }

struct Unit { int pm, pn; };
struct Gemm { const bf16_t* A; const bf16_t* Bt; int M, N, K; };

struct StaticOrder {
    int nM, nN, nwg, G, c;
    __host__ __device__ void init(int M, int N, int G_, int c_) { nM = M / BM; nN = N / BM; nwg = nM * nN; G = G_; c = c_; }
    __host__ __device__ bool next(int i, Unit& u) const {
        const long L = (long)i * G + c; if (L >= nwg) return false;
        int wgid = (int)L; { const int q = nwg / NXCD, r = nwg % NXCD, xcd = wgid % NXCD, off = wgid / NXCD; wgid = (xcd < r ? xcd * (q + 1) : r * (q + 1) + (xcd - r) * q) + off; }
        const int nig = WGM * nN, gid = wgid / nig, fm = gid * WGM, gsz = (nM - fm) < WGM ? (nM - fm) : WGM;
        u.pm = fm + ((wgid % nig) % gsz); u.pn = (wgid % nig) / gsz; return true;
    }
    __device__ __forceinline__ void a_ready(const Unit&) const {}
    __device__ __forceinline__ void done(const Unit&) const {}
};


typedef float f32x2_c __attribute__((ext_vector_type(2))); typedef __bf16 bf16x2_c __attribute__((ext_vector_type(2)));
__device__ __forceinline__ unsigned cvt_pk_bf16(float lo, float hi) { f32x2_c v = {lo, hi}; bf16x2_c b = __builtin_convertvector(v, bf16x2_c); return __builtin_bit_cast(unsigned, b); }

enum { TT_IDENT = 0, TT_NAT8 = 1, TT_HEAD = 2 };
__host__ __device__ __forceinline__ int tile_pos_of_logical(int tt, int L) {
    if (tt == TT_IDENT) return L;
    if (tt == TT_NAT8) { const int bj = L >> 7, wc = (L >> 5) & 3, fq = (L >> 3) & 3, n = (L >> 2) & 1, j = L & 3; return 128 * bj + 32 * wc + 16 * n + 4 * fq + j; }
    const int wc = L >> 6, d = L & 63, fqh = d >> 5, bj = (d >> 4) & 1, fql = (d >> 3) & 1, n = (d >> 2) & 1, j = d & 3;
    return 128 * bj + 32 * wc + 16 * n + 4 * (2 * fqh + fql) + j;
}
__device__ __forceinline__ float fast_sigmoid(float x) { return __builtin_amdgcn_rcpf(1.f + __builtin_amdgcn_exp2f(-1.4426950408889634f * x)); }
__device__ __forceinline__ float fast_gelu_tanh(float x) { const float u = x * (1.5957691216057308f + 0.0713548162726f * x * x); return x * __builtin_amdgcn_rcpf(1.f + __builtin_amdgcn_exp2f(-1.4426950408889634f * u)); }
template <int FN> __device__ __forceinline__ float epi_fn(float v) { if (FN == 1) return fast_gelu_tanh(v); if (FN == 2) return fast_sigmoid(v); if (FN == 3) { const float r = v > 0.f ? v : 0.f; return r * r; } return v; }
template <int FN> __device__ __forceinline__ void store_nat8(const f32x4 (&acc)[2][2][4][2], bf16_t* dst, int ld, int row0, int col0) {
#pragma unroll
    for (int ai = 0; ai < 2; ++ai)
#pragma unroll
        for (int m = 0; m < 4; ++m) { bf16_t* rowp = dst + (size_t)(row0 + ai * HALF + m * 16) * ld + col0;
#pragma unroll
            for (int bj = 0; bj < 2; ++bj) { const f32x4 v0 = acc[ai][bj][m][0], v1 = acc[ai][bj][m][1]; u32x4 w;
                w.x = cvt_pk_bf16(epi_fn<FN>(v0[0]), epi_fn<FN>(v0[1])); w.y = cvt_pk_bf16(epi_fn<FN>(v0[2]), epi_fn<FN>(v0[3]));
                w.z = cvt_pk_bf16(epi_fn<FN>(v1[0]), epi_fn<FN>(v1[1])); w.w = cvt_pk_bf16(epi_fn<FN>(v1[2]), epi_fn<FN>(v1[3]));
                *(u32x4*)(rowp + bj * HALF) = w; } }
}
template <int FN> struct EpiNat8 {
    static constexpr bool PERM = false, AFTER_DRAIN = false, RESCALE = false;
    bf16_t* dst; int ld;
    __device__ __forceinline__ void operator()(const f32x4 (&acc)[2][2][4][2], const Unit& u, int wr, int wc, int fr, int fq) const {
        store_nat8<FN>(acc, dst + u.pn * BM, ld, u.pm * BM + wr * 64 + fr, wc * 32 + 8 * fq);
    }
};
struct EpiG1 {
    static constexpr bool PERM = false, AFTER_DRAIN = false, RESCALE = false;
    bf16_t *Y, *KA, *VA, *KB, *VB, *XR, *G; const float* rope; const float* qgain; const float* kgain; int pn_off, pad_;
    __device__ __forceinline__ void operator()(const f32x4 (&acc)[2][2][4][2], const Unit& u, int wr, int wc, int fr, int fq) const {
        const int T = u.pn + pn_off, row0 = u.pm * BM + wr * 64 + fr;
        if (T >= 14) { store_nat8<2>(acc, G + (T - 14) * 256, 3072, row0, wc * 32 + 8 * fq); return; }
        if (T >= 10) { store_nat8<1>(acc, Y + 1024 + (T - 10) * 256, 2048, row0, wc * 32 + 8 * fq); return; }
        if (T >= 6) { store_nat8<0>(acc, XR + (T - 6) * 256, 1024, row0, wc * 32 + 8 * fq); return; }
        const bool isB = T >= 3; const int Tl = isB ? T - 3 : T;
        int kind; bf16_t* dst; int ld;
        if (Tl < 2) { kind = 0; dst = Y + (isB ? 512 : 0) + Tl * 256 + wc * 64; ld = 2048; }
        else if (wc < 2) { kind = 1; dst = (isB ? KB : KA) + wc * 64; ld = 128; }
        else { kind = 2; dst = (isB ? VB : VA) + (wc - 2) * 64; ld = 128; }
        const bool lat = u.pm < 64, rms = isB && kind < 2, rot = kind < 2 && lat;
        const int based = 32 * (fq >> 1) + 8 * (fq & 1);
        f32x4 gn[2][2];
#pragma unroll
        for (int bj = 0; bj < 2; ++bj)
#pragma unroll
            for (int n = 0; n < 2; ++n) { const f32x4 gq = *(const f32x4*)(qgain + based + 16 * bj + 4 * n), gk = *(const f32x4*)(kgain + based + 16 * bj + 4 * n); gn[bj][n] = kind == 0 ? gq : gk; }
        const float osc = kind == 0 ? 0.125f * 1.4426950408889634f : 1.f;
#pragma unroll
        for (int ai = 0; ai < 2; ++ai)
#pragma unroll
            for (int m = 0; m < 4; ++m) {
                const int row = row0 + ai * HALF + m * 16;
                f32x4 v[2][2];
#pragma unroll
                for (int bj = 0; bj < 2; ++bj)
#pragma unroll
                    for (int n = 0; n < 2; ++n) v[bj][n] = acc[ai][bj][m][n];
                if (rms) {
                    float ss = 0.f;
#pragma unroll
                    for (int bj = 0; bj < 2; ++bj)
#pragma unroll
                        for (int n = 0; n < 2; ++n) { const f32x4 x = v[bj][n]; ss += (x[0] * x[0] + x[1] * x[1]) + (x[2] * x[2] + x[3] * x[3]); }
                    ss += __shfl_xor(ss, 16); ss += __shfl_xor(ss, 32);
                    const float r = __builtin_amdgcn_rsqf(ss * (1.f / 64.f) + 1e-6f);
#pragma unroll
                    for (int bj = 0; bj < 2; ++bj)
#pragma unroll
                        for (int n = 0; n < 2; ++n) v[bj][n] = v[bj][n] * r * gn[bj][n];
                }
                if (rot) {
                    const int t = row & 4095, pos = (fq >> 1) ? (t & 63) : (t >> 6); const float* cp = rope + pos * 16 + 8 * (fq & 1);
#pragma unroll
                    for (int n = 0; n < 2; ++n) { const f32x4 c = *(const f32x4*)(cp + 4 * n), s = *(const f32x4*)(cp + 1024 + 4 * n); const f32x4 x1 = v[0][n], x2 = v[1][n];
                        v[0][n] = x1 * c - x2 * s; v[1][n] = x1 * s + x2 * c; }
                }
                bf16_t* rowp = dst + (size_t)row * ld + based;
#pragma unroll
                for (int bj = 0; bj < 2; ++bj) { const f32x4 v0 = v[bj][0] * osc, v1 = v[bj][1] * osc; u32x4 w;
                    w.x = cvt_pk_bf16(v0[0], v0[1]); w.y = cvt_pk_bf16(v0[2], v0[3]); w.z = cvt_pk_bf16(v1[0], v1[1]); w.w = cvt_pk_bf16(v1[2], v1[3]);
                    *(u32x4*)(rowp + 16 * bj) = w; }
            }
    }
};
struct EpiMerge {
    static constexpr bool PERM = false, AFTER_DRAIN = false, RESCALE = true;
    const bf16_t* G; bf16_t* Mo;
    __device__ __forceinline__ static void unpack8(const u32x4 w, float (&f)[8]) {
        f[0] = __uint_as_float(w.x << 16); f[1] = __uint_as_float(w.x & 0xffff0000u); f[2] = __uint_as_float(w.y << 16); f[3] = __uint_as_float(w.y & 0xffff0000u);
        f[4] = __uint_as_float(w.z << 16); f[5] = __uint_as_float(w.z & 0xffff0000u); f[6] = __uint_as_float(w.w << 16); f[7] = __uint_as_float(w.w & 0xffff0000u);
    }
    __device__ __forceinline__ void rescale(f32x4 (&acc)[2][2][4][2], const Unit& u, int t, int wr, int wc, int fr, int fq) const {
        const int s = t == 8 ? 0 : 1; int row0 = u.pm * BM + wr * 64 + fr, col0 = u.pn * BM + wc * 32 + 8 * fq;
        asm volatile("" : "+v"(row0), "+v"(col0));
#pragma unroll
        for (int ai = 0; ai < 2; ++ai)
#pragma unroll
            for (int m = 0; m < 4; ++m) { const bf16_t* gp = G + (size_t)(row0 + ai * HALF + m * 16) * 3072 + s * 1024 + col0;
#pragma unroll
                for (int bj = 0; bj < 2; ++bj) { float a[8], b[8]; unpack8(*(const u32x4*)(gp + bj * HALF), a); unpack8(*(const u32x4*)(gp + 1024 + bj * HALF), b);
                    f32x4 f0, f1;
#pragma unroll
                    for (int j = 0; j < 4; ++j) { f0[j] = fmaxf(a[j], 1e-20f) * __builtin_amdgcn_rcpf(fmaxf(b[j], 1e-20f)); f1[j] = fmaxf(a[4 + j], 1e-20f) * __builtin_amdgcn_rcpf(fmaxf(b[4 + j], 1e-20f)); }
                    if (s == 0) {
#pragma unroll
                        for (int j = 0; j < 4; ++j) { f0[j] = a[j] * __builtin_amdgcn_rcpf(fmaxf(b[j], 1e-20f)); f1[j] = a[4 + j] * __builtin_amdgcn_rcpf(fmaxf(b[4 + j], 1e-20f)); } }
                    acc[ai][bj][m][0] *= f0; acc[ai][bj][m][1] *= f1; }
                asm volatile("" ::: "memory"); }
    }
    __device__ __forceinline__ void operator()(const f32x4 (&acc)[2][2][4][2], const Unit& u, int wr, int wc, int fr, int fq) const {
        const int row0 = u.pm * BM + wr * 64 + fr, col0 = u.pn * BM + wc * 32 + 8 * fq;
#pragma unroll
        for (int ai = 0; ai < 2; ++ai)
#pragma unroll
            for (int m = 0; m < 4; ++m) { const size_t ro = (size_t)(row0 + ai * HALF + m * 16);
#pragma unroll
                for (int bj = 0; bj < 2; ++bj) { float c[8]; unpack8(*(const u32x4*)(G + ro * 3072 + 2048 + col0 + bj * HALF), c);
                    const f32x4 v0 = acc[ai][bj][m][0], v1 = acc[ai][bj][m][1]; u32x4 w;
                    w.x = cvt_pk_bf16(v0[0] * fmaxf(c[0], 1e-20f), v0[1] * fmaxf(c[1], 1e-20f)); w.y = cvt_pk_bf16(v0[2] * fmaxf(c[2], 1e-20f), v0[3] * fmaxf(c[3], 1e-20f));
                    w.z = cvt_pk_bf16(v1[0] * fmaxf(c[4], 1e-20f), v1[1] * fmaxf(c[5], 1e-20f)); w.w = cvt_pk_bf16(v1[2] * fmaxf(c[6], 1e-20f), v1[3] * fmaxf(c[7], 1e-20f));
                    *(u32x4*)(Mo + ro * 1024 + col0 + bj * HALF) = w; } }
    }
};
struct EpiResid {
    static constexpr bool PERM = false, AFTER_DRAIN = false, RESCALE = false;
    const float* base_lat; const float* base_ctx; float* out_lat; float* out_ctx; const float* mod; int gate_off, pad_;
    __device__ __forceinline__ void operator()(const f32x4 (&acc)[2][2][4][2], const Unit& u, int wr, int wc, int fr, int fq) const {
        const bool lat = u.pm < 64; const float* base = lat ? base_lat : base_ctx; float* out = lat ? out_lat : out_ctx;
        const int rowt = (lat ? u.pm : u.pm - 64) * BM + wr * 64 + fr, col0 = u.pn * BM + wc * 32 + 4 * fq;
        const float* gp = mod + (size_t)(lat ? (u.pm >> 4) : 4) * 6144 + gate_off + col0;
        f32x4 gv[2][2];
#pragma unroll
        for (int bj = 0; bj < 2; ++bj)
#pragma unroll
            for (int n = 0; n < 2; ++n) gv[bj][n] = *(const f32x4*)(gp + bj * HALF + n * 16);
#pragma unroll
        for (int ai = 0; ai < 2; ++ai)
#pragma unroll
            for (int m = 0; m < 4; ++m) { const size_t off = (size_t)(rowt + ai * HALF + m * 16) * 1024 + col0;
#pragma unroll
                for (int bj = 0; bj < 2; ++bj)
#pragma unroll
                    for (int n = 0; n < 2; ++n) { const f32x4 b = *(const f32x4*)(base + off + bj * HALF + n * 16);
                        *(f32x4*)(out + off + bj * HALF + n * 16) = b * 1.41421356237309515f + gv[bj][n] * acc[ai][bj][m][n]; } }
    }
};

template <class Epi, class Sched, bool ALIGN_EPI = false, bool SP2 = false>
__device__ __forceinline__ void gemm_phase(PG8_LAS unsigned char* lds, const Gemm g, const Sched& S, const Epi& E) {
    int tid_ = threadIdx.x; asm volatile("" : "+v"(tid_));
    const int tid = tid_, wid = __builtin_amdgcn_readfirstlane(tid >> 6), lane = tid & 63, wr = wid >> 2, wc = wid & 3, fr = lane & 15, fq = lane >> 4;
    const int K = g.K, nt = K / BK;
    unsigned voffA[2], voffB[2];
#pragma unroll
    for (int i = 0; i < 2; ++i) { int R, C; stage_rc(tid * 16 + i * 8192, R, C); const int Rb = Epi::PERM ? ((R & ~31) + perm32(R & 31)) : R;
        voffA[i] = (unsigned)(R * K + C) * 2u; voffB[i] = (unsigned)(Rb * K + C) * 2u; }
    const size_t kstep = (size_t)(BK * 2);
    const size_t hstep = (size_t)HALF * K * 2;
    const size_t tstep = 2 * hstep;
    const unsigned ldsw = (unsigned)wid * 1024u;
    const int aoff = lds_byte(wr * 64 + fr, fq * 8), boff = lds_byte(wc * 32 + fr, fq * 8);
#define PG8_SA(b, h) (((b) * 2 + (h)) * HTB)
#define PG8_SB(b, h) ((4 + (b) * 2 + (h)) * HTB)
#define PG8_STAGE(bufoff, gbase, voff) do { _Pragma("unroll") for (int _i = 0; _i < 2; ++_i) \
        __builtin_amdgcn_global_load_lds((const unsigned*)((const char*)(gbase) + (voff)[_i]), (PG8_LAS unsigned*)(lds + (bufoff) + ldsw + _i * 8192), 16, 0, 0); } while (0)
#define PG8_LDA(dst, b, h) do { _Pragma("unroll") for (int m = 0; m < 4; ++m) _Pragma("unroll") for (int k = 0; k < 2; ++k) dst[m][k] = *(const PG8_LAS bf16x8*)(lds + PG8_SA(b, h) + aoff + m * 2048 + k * 1024); } while (0)
#define PG8_LDB(dst, b, h) do { _Pragma("unroll") for (int n = 0; n < 2; ++n) _Pragma("unroll") for (int k = 0; k < 2; ++k) dst[n][k] = *(const PG8_LAS bf16x8*)(lds + PG8_SB(b, h) + boff + n * 2048 + k * 1024); } while (0)
#define PG8_MMA(ai, bj, At, Bt) do { __builtin_amdgcn_s_setprio(1); _Pragma("unroll") for (int m = 0; m < 4; ++m) _Pragma("unroll") for (int n = 0; n < 2; ++n) _Pragma("unroll") for (int k = 0; k < 2; ++k) \
        acc[ai][bj][m][n] = __builtin_amdgcn_mfma_f32_16x16x32_bf16(Bt[n][k], At[m][k], acc[ai][bj][m][n], 0, 0, 0); __builtin_amdgcn_s_setprio(0); } while (0)
#define PG8_WAIT_V(n) asm volatile("s_waitcnt vmcnt(" #n ")" ::: "memory")
#define PG8_WAIT_L(n) asm volatile("s_waitcnt lgkmcnt(" #n ")" ::: "memory")
#define PG8_BAR __builtin_amdgcn_s_barrier()
#define PG8_SCHED __builtin_amdgcn_sched_barrier(0)
    Unit cur, nxt; int ui = 0;
    if (!S.next(0, cur)) return;
    f32x4 acc[2][2][4][2];
#pragma unroll
    for (int a = 0; a < 2; ++a)
#pragma unroll
        for (int b = 0; b < 2; ++b)
#pragma unroll
            for (int m = 0; m < 4; ++m)
#pragma unroll
                for (int n = 0; n < 2; ++n) acc[a][b][m][n] = (f32x4){0.f, 0.f, 0.f, 0.f};
    bf16x8 At[4][2], B0[2][2], B1[2][2];
    const char* cA = (const char*)g.A + (size_t)cur.pm * tstep; const char* cB = (const char*)g.Bt + (size_t)cur.pn * tstep;
    S.a_ready(cur);
    if constexpr (SP2) {
        PG8_STAGE(PG8_SB(0, 0), cB, voffB); PG8_STAGE(PG8_SB(0, 1), cB + hstep, voffB); PG8_STAGE(PG8_SA(0, 0), cA, voffA); PG8_STAGE(PG8_SA(0, 1), cA + hstep, voffA);
        if (wr == 1) PG8_BAR;
        PG8_WAIT_V(2); PG8_BAR;
        PG8_STAGE(PG8_SB(1, 0), cB + kstep, voffB); PG8_STAGE(PG8_SA(1, 0), cA + kstep, voffA); PG8_STAGE(PG8_SB(1, 1), cB + hstep + kstep, voffB);
        PG8_WAIT_V(6); PG8_BAR;
    } else {
        PG8_STAGE(PG8_SB(0, 0), cB, voffB); PG8_STAGE(PG8_SA(0, 0), cA, voffA); PG8_STAGE(PG8_SB(0, 1), cB + hstep, voffB); PG8_STAGE(PG8_SA(0, 1), cA + hstep, voffA);
        if (wr == 1) PG8_BAR;
        PG8_WAIT_V(4); PG8_BAR;
        PG8_STAGE(PG8_SB(1, 0), cB + kstep, voffB); PG8_STAGE(PG8_SA(1, 0), cA + kstep, voffA); PG8_STAGE(PG8_SB(1, 1), cB + hstep + kstep, voffB);
        PG8_WAIT_V(6); PG8_BAR;
    }
    for (;;) {
        const bool has_next = S.next(ui + 1, nxt);
        const char* nA = has_next ? (const char*)g.A + (size_t)nxt.pm * tstep : cA; const char* nB = has_next ? (const char*)g.Bt + (size_t)nxt.pn * tstep : cB;
        for (int t = 0; t < nt; t += 2) {
            if constexpr (Epi::RESCALE) { if (t == 8 || t == 16) E.rescale(acc, cur, t, wr, wc, fr, fq); }
            const bool last = (t == nt - 2);
            const char* a1 = cA + (size_t)(t + 1) * kstep;
            const char* a2 = last ? nA : cA + (size_t)(t + 2) * kstep; const char* b2 = last ? nB : cB + (size_t)(t + 2) * kstep;
            const char* a3 = a2 + kstep; const char* b3 = b2 + kstep;
            if (last && has_next) S.a_ready(nxt);
            if constexpr (SP2) {
            PG8_LDB(B0, 0, 0); PG8_LDB(B1, 0, 1); PG8_SCHED; PG8_LDA(At, 0, 0); PG8_STAGE(PG8_SA(1, 1), a1 + hstep, voffA);
            PG8_WAIT_V(8); PG8_WAIT_L(0); PG8_BAR; PG8_MMA(0, 0, At, B0); PG8_MMA(0, 1, At, B1); PG8_BAR; PG8_SCHED;
            PG8_LDA(At, 0, 1); PG8_STAGE(PG8_SB(0, 0), b2, voffB); PG8_STAGE(PG8_SB(0, 1), b2 + hstep, voffB); PG8_STAGE(PG8_SA(0, 0), a2, voffA);
            PG8_WAIT_V(8); PG8_WAIT_L(0); PG8_BAR; PG8_MMA(1, 0, At, B0); PG8_MMA(1, 1, At, B1); PG8_BAR; PG8_SCHED;
            PG8_LDB(B0, 1, 0); PG8_LDB(B1, 1, 1); PG8_SCHED; PG8_LDA(At, 1, 0); PG8_STAGE(PG8_SA(0, 1), a2 + hstep, voffA);
            PG8_WAIT_V(8); PG8_WAIT_L(0); PG8_BAR; PG8_MMA(0, 0, At, B0); PG8_MMA(0, 1, At, B1); PG8_BAR; PG8_SCHED;
            PG8_LDA(At, 1, 1); PG8_STAGE(PG8_SB(1, 0), b3, voffB); PG8_STAGE(PG8_SB(1, 1), b3 + hstep, voffB); PG8_STAGE(PG8_SA(1, 0), a3, voffA);
            PG8_WAIT_V(8); PG8_WAIT_L(0); PG8_BAR; PG8_MMA(1, 0, At, B0); PG8_MMA(1, 1, At, B1); PG8_BAR; PG8_SCHED;
            } else {
            PG8_LDB(B0, 0, 0); PG8_SCHED; PG8_LDA(At, 0, 0); PG8_STAGE(PG8_SA(1, 1), a1 + hstep, voffA);
            PG8_WAIT_L(8); PG8_BAR; PG8_WAIT_L(0); PG8_MMA(0, 0, At, B0); PG8_BAR; PG8_SCHED;
            PG8_LDB(B1, 0, 1); PG8_STAGE(PG8_SB(0, 0), b2, voffB);
            PG8_BAR; PG8_WAIT_L(0); PG8_MMA(0, 1, At, B1); PG8_BAR;
            PG8_LDA(At, 0, 1); PG8_STAGE(PG8_SA(0, 0), a2, voffA);
            PG8_BAR; PG8_WAIT_L(0); PG8_MMA(1, 0, At, B0); PG8_BAR; PG8_SCHED;
            PG8_STAGE(PG8_SB(0, 1), b2 + hstep, voffB);
            PG8_WAIT_V(6); PG8_BAR; PG8_MMA(1, 1, At, B1); PG8_BAR;
            PG8_LDB(B0, 1, 0); PG8_SCHED; PG8_LDA(At, 1, 0); PG8_STAGE(PG8_SA(0, 1), a2 + hstep, voffA);
            PG8_WAIT_L(8); PG8_BAR; PG8_WAIT_L(0); PG8_MMA(0, 0, At, B0); PG8_BAR; PG8_SCHED;
            PG8_LDB(B1, 1, 1); PG8_STAGE(PG8_SB(1, 0), b3, voffB);
            PG8_BAR; PG8_WAIT_L(0); PG8_MMA(0, 1, At, B1); PG8_BAR;
            PG8_LDA(At, 1, 1); PG8_STAGE(PG8_SA(1, 0), a3, voffA);
            PG8_BAR; PG8_WAIT_L(0); PG8_MMA(1, 0, At, B0); PG8_BAR; PG8_SCHED;
            PG8_STAGE(PG8_SB(1, 1), b3 + hstep, voffB);
            PG8_WAIT_V(6); PG8_BAR; PG8_MMA(1, 1, At, B1); PG8_BAR;
            }
        }
        if constexpr (ALIGN_EPI) { if (wr == 0) PG8_BAR; }
        if constexpr (!Epi::AFTER_DRAIN) { E(acc, cur, wr, wc, fr, fq); S.done(cur); }
        if (!has_next) break;
#pragma unroll
        for (int a = 0; a < 2; ++a)
#pragma unroll
            for (int b = 0; b < 2; ++b)
#pragma unroll
                for (int m = 0; m < 4; ++m)
#pragma unroll
                    for (int n = 0; n < 2; ++n) acc[a][b][m][n] = (f32x4){0.f, 0.f, 0.f, 0.f};
        cur = nxt; cA = nA; cB = nB; ++ui;
        if constexpr (ALIGN_EPI) { if (wr == 1) PG8_BAR; }
    }
    PG8_WAIT_V(0);
    if constexpr (!ALIGN_EPI) { if (wr == 0) PG8_BAR; }
    PG8_BAR;
    if constexpr (Epi::AFTER_DRAIN) { E.fused(acc, cur, wr, wc, fr, fq, lds, wid, lane); S.done(cur); }
#undef PG8_SA
#undef PG8_SB
#undef PG8_STAGE
#undef PG8_LDA
#undef PG8_LDB
#undef PG8_MMA
#undef PG8_WAIT_V
#undef PG8_WAIT_L
#undef PG8_BAR
#undef PG8_SCHED
}
}

namespace lru {
#define LAS __attribute__((address_space(3)))
typedef short bf16x8 __attribute__((ext_vector_type(8)));
typedef float f32x4 __attribute__((ext_vector_type(4)));
typedef unsigned u32x4 __attribute__((ext_vector_type(4)));
constexpr int NCH = 68;
template <int CTRL> __device__ __forceinline__ float dpp(float oldv, float src) {
    return __int_as_float(__builtin_amdgcn_update_dpp(__float_as_int(oldv), __float_as_int(src), CTRL, 0xf, 0xf, false));
}
__device__ __forceinline__ float bfe(const bf16x8& v, int j) { return __uint_as_float(((unsigned)(unsigned short)v[j]) << 16); }
__device__ __forceinline__ float sigm(float x) { return __builtin_amdgcn_rcpf(1.f + __builtin_amdgcn_exp2f(-1.4426950408889634f * x)); }
template <int DIR> __device__ __forceinline__ void row_scan(float (&TA)[8], float (&TU)[8]) {
#define LRU_STEP(D) { _Pragma("unroll") for (int j = 0; j < 8; ++j) { const float pA = dpp<(DIR ? 0x100 : 0x110) | D>(1.f, TA[j]), pU = dpp<(DIR ? 0x100 : 0x110) | D>(0.f, TU[j]); TU[j] = TA[j] * pU + TU[j]; TA[j] = TA[j] * pA; } }
    LRU_STEP(1) LRU_STEP(2) LRU_STEP(4) LRU_STEP(8)
#undef LRU_STEP
}
struct Params { const bf16* XR; const float* convw; const float* convb; const bf16* Wg; const float* br; const float* bi; const float* c2; float* agg; bf16* Y; };

template <int PASS> __device__ __forceinline__ void item(const Params& P, int b, int c, int blk, int lane, LAS f32x4* hfl  ) {
    const int fr = lane & 15, fq = lane >> 4;
    const bool isctx = c < 4; const int L = isctx ? CTXL : SEQ, t0 = (isctx ? c : c - 4) * 64 + 4 * fr, rbase = isctx ? NLAT + b * CTXL : b * SEQ;
    bf16x8 Af[4][2];
#pragma unroll
    for (int ks = 0; ks < 2; ++ks) {
        const int ch0 = blk * 64 + 32 * ks + 8 * fq;
        float xr[7][8];
#pragma unroll
        for (int i = 0; i < 7; ++i) { const int t = t0 - 1 + i; u32x4 w = (u32x4){0u, 0u, 0u, 0u};
            if (t >= 0 && t < L) w = *(const u32x4*)(P.XR + (size_t)(rbase + t) * DM + ch0);
            xr[i][0] = __uint_as_float(w.x << 16); xr[i][1] = __uint_as_float(w.x & 0xffff0000u); xr[i][2] = __uint_as_float(w.y << 16); xr[i][3] = __uint_as_float(w.y & 0xffff0000u);
            xr[i][4] = __uint_as_float(w.z << 16); xr[i][5] = __uint_as_float(w.z & 0xffff0000u); xr[i][6] = __uint_as_float(w.w << 16); xr[i][7] = __uint_as_float(w.w & 0xffff0000u); }
        float o[4][8];
        { const f32x4 b0 = *(const f32x4*)(P.convb + ch0), b1 = *(const f32x4*)(P.convb + ch0 + 4);
#pragma unroll
          for (int m = 0; m < 4; ++m) { o[m][0] = b0[0]; o[m][1] = b0[1]; o[m][2] = b0[2]; o[m][3] = b0[3]; o[m][4] = b1[0]; o[m][5] = b1[1]; o[m][6] = b1[2]; o[m][7] = b1[3]; } }
#pragma unroll
        for (int k = 0; k < 4; ++k) { const f32x4 w0 = *(const f32x4*)(P.convw + k * DM + ch0), w1 = *(const f32x4*)(P.convw + k * DM + ch0 + 4);
#pragma unroll
            for (int m = 0; m < 4; ++m) {
#pragma unroll
                for (int j = 0; j < 4; ++j) { o[m][j] += w0[j] * xr[m + k][j]; o[m][4 + j] += w1[j] * xr[m + k][4 + j]; } } }
#pragma unroll
        for (int m = 0; m < 4; ++m) { u32x4 w; w.x = pg8::cvt_pk_bf16(o[m][0], o[m][1]); w.y = pg8::cvt_pk_bf16(o[m][2], o[m][3]); w.z = pg8::cvt_pk_bf16(o[m][4], o[m][5]); w.w = pg8::cvt_pk_bf16(o[m][6], o[m][7]);
            Af[m][ks] = __builtin_bit_cast(bf16x8, w); }
    }
#pragma unroll
    for (int p = 0; p < 2; ++p) {
        const int chp = blk * 64 + 32 * p + 8 * fq;
#pragma unroll
        for (int dir = 0; dir < 2; ++dir) {
            float hinv[8];
            if (PASS == 2) {
                const int pos = dir == 0 ? c : (c < 4 ? 3 - c : 71 - c);
                float CA[8], CU[8];
#pragma unroll
                for (int j = 0; j < 8; ++j) { CA[j] = 1.f; CU[j] = 0.f; }
                for (int i = 5 * fr; i < 5 * fr + 5 && i < pos; ++i) {
                    const int cid = dir == 0 ? i : (i < 4 ? 3 - i : 71 - i);
                    const float* ap = P.agg + ((size_t)((dir * BATCH + b) * NCH + cid)) * 2048 + chp;
                    const f32x4 p0 = *(const f32x4*)(ap), p1 = *(const f32x4*)(ap + 4), s0 = *(const f32x4*)(ap + 1024), s1 = *(const f32x4*)(ap + 1028);
#pragma unroll
                    for (int j = 0; j < 4; ++j) { CU[j] = p0[j] * CU[j] + s0[j]; CA[j] = p0[j] * CA[j]; CU[4 + j] = p1[j] * CU[4 + j] + s1[j]; CA[4 + j] = p1[j] * CA[4 + j]; }
                }
                row_scan<0>(CA, CU);
#pragma unroll
                for (int j = 0; j < 8; ++j) hinv[j] = __int_as_float(__builtin_amdgcn_ds_bpermute(((lane & 48) | 15) << 2, __float_as_int(CU[j])));
            }
            f32x4 aR[4][2], aI[4][2];
#pragma unroll
            for (int nn = 0; nn < 2; ++nn) { const f32x4 vr = *(const f32x4*)(P.br + dir * DM + chp + 4 * nn), vi = *(const f32x4*)(P.bi + dir * DM + chp + 4 * nn);
#pragma unroll
                for (int m = 0; m < 4; ++m) { aR[m][nn] = vr; aI[m][nn] = vi; } }
#pragma unroll
            for (int gate = 0; gate < 2; ++gate) {
                bf16x8 Bf[2][2];
#pragma unroll
                for (int nn = 0; nn < 2; ++nn)
#pragma unroll
                    for (int ks = 0; ks < 2; ++ks) Bf[nn][ks] = *(const bf16x8*)(P.Wg + ((size_t)(((dir * 2 + gate) * 16 + blk) * 64 + 16 * (2 * p + nn) + fr)) * 64 + 32 * ks + 8 * fq);
#pragma unroll
                for (int m = 0; m < 4; ++m)
#pragma unroll
                    for (int nn = 0; nn < 2; ++nn)
#pragma unroll
                        for (int ks = 0; ks < 2; ++ks) { if (gate == 0) aR[m][nn] = __builtin_amdgcn_mfma_f32_16x16x32_bf16(Bf[nn][ks], Af[m][ks], aR[m][nn], 0, 0, 0);
                                                         else aI[m][nn] = __builtin_amdgcn_mfma_f32_16x16x32_bf16(Bf[nn][ks], Af[m][ks], aI[m][nn], 0, 0, 0); }
            }
            float c2v[8]; { const f32x4 x0 = *(const f32x4*)(P.c2 + dir * DM + chp), x1 = *(const f32x4*)(P.c2 + dir * DM + chp + 4); c2v[0] = x0[0]; c2v[1] = x0[1]; c2v[2] = x0[2]; c2v[3] = x0[3]; c2v[4] = x1[0]; c2v[5] = x1[1]; c2v[6] = x1[2]; c2v[7] = x1[3]; }
            float A[4][8], U[4][8];
#pragma unroll
            for (int m = 0; m < 4; ++m)
#pragma unroll
                for (int j = 0; j < 8; ++j) { const float rr = sigm(aR[m][j >> 2][j & 3]), ii = sigm(aI[m][j >> 2][j & 3]); const float av = __builtin_amdgcn_exp2f(rr * c2v[j]);
                    A[m][j] = av; U[m][j] = __builtin_amdgcn_sqrtf(fmaxf(1.f - av * av, 0.f)) * (ii * bfe(Af[m][p], j)); }
            if (dir == 0) {
#pragma unroll
                for (int m = 1; m < 4; ++m)
#pragma unroll
                    for (int j = 0; j < 8; ++j) { U[m][j] = A[m][j] * U[m - 1][j] + U[m][j]; A[m][j] = A[m][j] * A[m - 1][j]; }
            } else {
#pragma unroll
                for (int m = 2; m >= 0; --m)
#pragma unroll
                    for (int j = 0; j < 8; ++j) { U[m][j] = A[m][j] * U[m + 1][j] + U[m][j]; A[m][j] = A[m][j] * A[m + 1][j]; }
            }
            float TA[8], TU[8];
#pragma unroll
            for (int j = 0; j < 8; ++j) { TA[j] = A[dir ? 0 : 3][j]; TU[j] = U[dir ? 0 : 3][j]; }
            if (dir == 0) row_scan<0>(TA, TU); else row_scan<1>(TA, TU);
            if (PASS == 1) {
                if (fr == (dir ? 0 : 15)) { float* ap = P.agg + ((size_t)((dir * BATCH + b) * NCH + c)) * 2048 + chp;
                    *(f32x4*)(ap) = (f32x4){TA[0], TA[1], TA[2], TA[3]}; *(f32x4*)(ap + 4) = (f32x4){TA[4], TA[5], TA[6], TA[7]};
                    *(f32x4*)(ap + 1024) = (f32x4){TU[0], TU[1], TU[2], TU[3]}; *(f32x4*)(ap + 1028) = (f32x4){TU[4], TU[5], TU[6], TU[7]}; }
            } else {
                float s[8];
#pragma unroll
                for (int j = 0; j < 8; ++j) { const float hin = hinv[j];
                    const float EA = dir == 0 ? dpp<0x111>(1.f, TA[j]) : dpp<0x101>(1.f, TA[j]), EU = dir == 0 ? dpp<0x111>(0.f, TU[j]) : dpp<0x101>(0.f, TU[j]);
                    s[j] = EU + EA * hin; }
                if (dir == 0) {
#pragma unroll
                    for (int m = 0; m < 4; ++m) { float h[8];
#pragma unroll
                        for (int j = 0; j < 8; ++j) h[j] = U[m][j] + A[m][j] * s[j];
                        hfl[(2 * m) * 64 + lane] = (f32x4){h[0], h[1], h[2], h[3]}; hfl[(2 * m + 1) * 64 + lane] = (f32x4){h[4], h[5], h[6], h[7]}; }
                } else {
#pragma unroll
                    for (int m = 0; m < 4; ++m) { bf16* yp = P.Y + (size_t)(rbase + (isctx ? c : c - 4) * 64 + 4 * fr + m) * YC + 1024 + chp;
                        const u32x4 g = *(const u32x4*)yp; float gv[8];
                        gv[0] = __uint_as_float(g.x << 16); gv[1] = __uint_as_float(g.x & 0xffff0000u); gv[2] = __uint_as_float(g.y << 16); gv[3] = __uint_as_float(g.y & 0xffff0000u);
                        gv[4] = __uint_as_float(g.z << 16); gv[5] = __uint_as_float(g.z & 0xffff0000u); gv[6] = __uint_as_float(g.w << 16); gv[7] = __uint_as_float(g.w & 0xffff0000u);
                        float o[8];
                        const f32x4 h0 = hfl[(2 * m) * 64 + lane], h1 = hfl[(2 * m + 1) * 64 + lane]; const float hfv[8] = {h0[0], h0[1], h0[2], h0[3], h1[0], h1[1], h1[2], h1[3]};
#pragma unroll
                        for (int j = 0; j < 8; ++j) o[j] = (hfv[j] + U[m][j] + A[m][j] * s[j]) * gv[j];
                        u32x4 w; w.x = pg8::cvt_pk_bf16(o[0], o[1]); w.y = pg8::cvt_pk_bf16(o[2], o[3]); w.z = pg8::cvt_pk_bf16(o[4], o[5]); w.w = pg8::cvt_pk_bf16(o[6], o[7]);
                        *(u32x4*)yp = w; }
                }
            }
        }
    }
}
template <int PASS> __device__ __forceinline__ void phase(const Params& P, int gw, int NGW, int lane, LAS f32x4* hfl, bool skip_ctx) {
    for (int it = gw; it < BATCH * NCH * 16; it += NGW) { const int blk = it & 15, bc = it >> 4, c = bc % NCH; if (skip_ctx && c < 4) continue; item<PASS>(P, bc / NCH, c, blk, lane, hfl); }
}
#undef LAS
}

#include <hip/hip_bf16.h>
#include <cmath>
namespace attn_body {
using bf16=__hip_bfloat16;
using bf16x8=__attribute__((ext_vector_type(8)))short;
using s16x4=__attribute__((ext_vector_type(4)))short;
using f32x16=__attribute__((ext_vector_type(16)))float;
using u32x4=__attribute__((ext_vector_type(4)))unsigned;
constexpr int D=64, QP=2048  , KP=128  ;
constexpr int NW=8,QBLK=32,QB=QBLK*NW,KVBLK=64;
constexpr int ATTN_UNIT_ROWS=QB;
__device__ __forceinline__ int crow(int r,int hi){return (r&3)+8*(r>>2)+4*hi;}
#define SBAR() __builtin_amdgcn_sched_barrier(0)
__device__ __forceinline__ void wmask(f32x16&p0,f32x16&p1,int d,int hi){
  const float NEG=-INFINITY; const int kb=d+4*hi;
  #pragma unroll
  for(int r=0;r<16;++r){const int x=kb+(r&3)+8*(r>>2); if(x<-128||x>128)p0[r]=NEG; if(x+32<-128||x+32>128)p1[r]=NEG;}
}

constexpr int NSLOT=3, SLOTB=8192;
constexpr int LDS_K=0, LDS_V=NSLOT*SLOTB, LDS_WS=2*NSLOT*SLOTB, LDS_OST=LDS_WS+NW*64*4, LDS_BYTES=LDS_OST+NW*4096;
constexpr float C2=0.125f*1.4426950408889634f;
__device__ __forceinline__ void glds16(const void*gsrc,unsigned lds_dst){unsigned keep;
  asm volatile("s_mov_b32 %0, m0\n\ts_mov_b32 m0, %2\n\ts_nop 0\n\tglobal_load_lds_dwordx4 %1, off\n\ts_mov_b32 m0, %0":"=&s"(keep):"v"(gsrc),"s"(lds_dst):"memory");}
__device__ __forceinline__ float max3f(float a,float b,float c){float r;asm("v_max3_f32 %0, %1, %2, %3":"=v"(r):"v"(a),"v"(b),"v"(c));return r;}
__device__ __forceinline__ float max2f(float a,float b){float r;asm("v_max_f32_e32 %0, %1, %2":"=v"(r):"v"(a),"v"(b));return r;}
__device__ __forceinline__ float fadd_s(float a,float b){float r;asm("v_add_f32_e32 %0, %1, %2":"=v"(r):"v"(a),"v"(b));return r;}
__device__ __forceinline__ float fsub_s(float a,float b){float r;asm("v_sub_f32_e32 %0, %1, %2":"=v"(r):"v"(a),"v"(b));return r;}
typedef float f32x2_t __attribute__((ext_vector_type(2))); typedef __bf16 bf16x2_t __attribute__((ext_vector_type(2)));
__device__ __forceinline__ unsigned cvtpk_s(float lo,float hi){f32x2_t v={lo,hi};bf16x2_t b=__builtin_convertvector(v,bf16x2_t);return __builtin_bit_cast(unsigned,b);}
#define WAIT_BAR(N) asm volatile("s_waitcnt vmcnt(" #N ") lgkmcnt(0)\n\ts_barrier":::"memory")

__device__ __forceinline__ void qkt(f32x16&p0,f32x16&p1,const char*Kslot,const bf16x8*qr,const f32x16&negm,int r32,int hi){
  const char*kb=Kslot+hi*1024+r32*16;
  #pragma unroll
  for(int d0=0;d0<4;++d0){
    const bf16x8 b0=*reinterpret_cast<const bf16x8*>(kb+d0*2048);
    const bf16x8 b1=*reinterpret_cast<const bf16x8*>(kb+d0*2048+512);
    if(d0==0){p0=__builtin_amdgcn_mfma_f32_32x32x16_bf16(b0,qr[0],negm,0,0,0);p1=__builtin_amdgcn_mfma_f32_32x32x16_bf16(b1,qr[0],negm,0,0,0);}
    else{p0=__builtin_amdgcn_mfma_f32_32x32x16_bf16(b0,qr[d0],p0,0,0,0);p1=__builtin_amdgcn_mfma_f32_32x32x16_bf16(b1,qr[d0],p1,0,0,0);}}
}
typedef __attribute__((address_space(3))) const char* lds_cptr;
typedef short v4i16_t __attribute__((ext_vector_type(4)));
__device__ __forceinline__ void kload8(bf16x8*kf,lds_cptr kp){
  kf[0]=*(const __attribute__((address_space(3))) bf16x8*)(kp);      kf[1]=*(const __attribute__((address_space(3))) bf16x8*)(kp+512);
  kf[2]=*(const __attribute__((address_space(3))) bf16x8*)(kp+2048); kf[3]=*(const __attribute__((address_space(3))) bf16x8*)(kp+2560);
  kf[4]=*(const __attribute__((address_space(3))) bf16x8*)(kp+4096); kf[5]=*(const __attribute__((address_space(3))) bf16x8*)(kp+4608);
  kf[6]=*(const __attribute__((address_space(3))) bf16x8*)(kp+6144); kf[7]=*(const __attribute__((address_space(3))) bf16x8*)(kp+6656);
}
__device__ __forceinline__ void kload2(bf16x8*kf,lds_cptr kp,int j){ kf[2*j]=*(const __attribute__((address_space(3))) bf16x8*)(kp+j*2048); kf[2*j+1]=*(const __attribute__((address_space(3))) bf16x8*)(kp+j*2048+512); }
__device__ __forceinline__ s16x4 vtr(lds_cptr p){ return __builtin_bit_cast(s16x4,__builtin_amdgcn_ds_read_tr16_b64_v4i16((__attribute__((address_space(3))) v4i16_t*)p)); }
__device__ __forceinline__ float rowmax(const f32x16&p0,const f32x16&p1){
  float a=max3f(p0[0],p0[1],p1[0]),b=max3f(p0[2],p0[3],p1[1]);a=max3f(a,p1[2],p1[3]);
  #pragma unroll
  for(int r=4;r<16;r+=4){a=max3f(a,p0[r],p0[r+1]);b=max3f(b,p0[r+2],p0[r+3]);a=max3f(a,p1[r],p1[r+1]);b=max3f(b,p1[r+2],p1[r+3]);}
  const float m=max2f(a,b);
  auto rr=__builtin_amdgcn_permlane32_swap(__float_as_uint(m),__float_as_uint(m),false,false);
  return max2f(__uint_as_float(rr[0]),__uint_as_float(rr[1]));
}
__device__ __forceinline__ void pv(f32x16*o,int vb,bf16x8 pa0,bf16x8 pa1,bf16x8 pa2,bf16x8 pa3){
  #pragma unroll
  for(int d0=0;d0<2;++d0){s16x4 lo[4],hi[4];
    #pragma unroll
    for(int ks=0;ks<4;++ks){
      asm volatile("ds_read_b64_tr_b16 %0,%1 offset:%c2":"=&v"(lo[ks]):"v"(vb),"i"(d0*4096+ks*1024):"memory");
      asm volatile("ds_read_b64_tr_b16 %0,%1 offset:%c2":"=&v"(hi[ks]):"v"(vb),"i"(d0*4096+ks*1024+512):"memory");}
    asm volatile("s_waitcnt lgkmcnt(0)":::"memory");SBAR();
    #define PK(k) (bf16x8){lo[k][0],lo[k][1],lo[k][2],lo[k][3],hi[k][0],hi[k][1],hi[k][2],hi[k][3]}
    o[d0]=__builtin_amdgcn_mfma_f32_32x32x16_bf16(pa0,PK(0),o[d0],0,0,0);
    o[d0]=__builtin_amdgcn_mfma_f32_32x32x16_bf16(pa1,PK(1),o[d0],0,0,0);
    o[d0]=__builtin_amdgcn_mfma_f32_32x32x16_bf16(pa2,PK(2),o[d0],0,0,0);
    o[d0]=__builtin_amdgcn_mfma_f32_32x32x16_bf16(pa3,PK(3),o[d0],0,0,0);
    #undef PK
  }
}

#ifndef ATTN_STORE16
#define ATTN_STORE16(p,v) (*(u32x4*)(p)=(v))
#endif
struct UnitDesc { int qrow0, qcol, kvcol, NT, n0, r0, r1, mq0, mk0; float sink2; };
template<int KIND,int THRL> __device__ __forceinline__ void attn_unit(const UnitDesc&ud,bf16*Y,const bf16*__restrict__ K,const bf16*__restrict__ V,char*shm){
  int tid_=threadIdx.x; asm volatile("":"+v"(tid_));
  const int tid=tid_,lane=tid&63,r32=lane&31,hi=lane>>5; const int wid=__builtin_amdgcn_readfirstlane(tid>>6);
  const bf16*Qw=Y+(long)(ud.qrow0+wid*QBLK)*QP+ud.qcol;
  const bf16*Kh=K+ud.kvcol,*Vh=V+ud.kvcol;
  #define TROW(t) ((long)((t)<ud.n0?ud.r0+64*(t):ud.r1+64*((t)-ud.n0)))
  const unsigned lds0=(unsigned)(uintptr_t)shm;
  float*wsf=(float*)(shm+LDS_WS)+wid*64;
  const bf16*ksrc=Kh+(long)lane*KP+wid*8;
  const bf16*vsrc=Vh+(long)(16*(wid&3)+(lane>>2))*KP+(wid>>2)*32+(lane&3)*8;
  const unsigned kdst=lds0+LDS_K+wid*1024, vdst=lds0+LDS_V+wid*1024;
  #define DMA_K(t,slot) glds16(ksrc+TROW(t)*KP,(unsigned)__builtin_amdgcn_readfirstlane(kdst+(slot)))
  #define DMA_V(t,slot) glds16(vsrc+TROW(t)*KP,(unsigned)__builtin_amdgcn_readfirstlane(vdst+(slot)))
  const int vb0=(int)(lds0+LDS_V)+((lane>>4)&1)*32+(lane&3)*8+(4*hi+((lane&15)>>2))*64;
  const char*Kbase=shm+LDS_K; bf16x8 kf[8];
  const lds_cptr shm3=(lds_cptr)shm; const lds_cptr kp0=shm3+LDS_K+hi*1024+r32*16; const lds_cptr vp0=shm3+LDS_V+((lane>>4)&1)*32+(lane&3)*8+(4*hi+((lane&15)>>2))*64;
  const int NT=ud.NT;
  DMA_K(0,0);DMA_V(0,0);DMA_K(1,SLOTB);
  bf16x8 qr[4];
  #pragma unroll
  for(int d0=0;d0<4;++d0)qr[d0]=*reinterpret_cast<const bf16x8*>(&Qw[(long)r32*QP+d0*16+hi*8]);
  float mhat=0.f,l_reg=0.f;f32x16 o[2];o[0]=f32x16{};o[1]=f32x16{};f32x16 negm=f32x16{};asm volatile("":"+v"(negm));
  const int qoff=ud.mq0+wid*QBLK+r32;
  #define CMASK(P0,P1,t) do{ if(KIND==0&&(t)>=4)wmask(P0,P1,ud.mk0+64*((t)-4)-qoff,hi); }while(0)
  bool resc=false;
  #define START(P0,P1) do{ const float rm=rowmax(P0,P1); resc=false; \
    { const float dl=rm; mhat=fadd_s(mhat,dl); \
      _Pragma("unroll") for(int r=0;r<16;++r){P0[r]=fsub_s(P0[r],dl);P1[r]=fsub_s(P1[r],dl);} \
      _Pragma("unroll") for(int r=0;r<16;++r)negm[r]=-mhat; asm volatile("":"+v"(negm)); } \
    _Pragma("unroll") for(int r=0;r<16;++r)P0[r]=__builtin_amdgcn_exp2f(P0[r]); }while(0)
  #define RESC() do{ if(resc){ asm volatile("s_waitcnt lgkmcnt(0)":::"memory"); \
      _Pragma("unroll") for(int d_=0;d_<2;++d_) _Pragma("unroll") for(int r=0;r<16;++r)o[d_][r]*=wsf[crow(r,hi)]; } }while(0)
  f32x16 pA0,pA1,pB0,pB1;
  int sl_prev=0,sl_cur=0,sl_next=SLOTB;
  #define ROT() do{sl_prev=sl_cur;sl_cur=sl_next;sl_next=(sl_next==(NSLOT-1)*SLOTB)?0:sl_next+SLOTB;}while(0)
  DMA_K(2,2*SLOTB);
  WAIT_BAR(3);
  qkt(pA0,pA1,Kbase,qr,negm,r32,hi);asm volatile("s_nop 15\n\ts_nop 7":"+v"(pA0),"+v"(pA1));CMASK(pA0,pA1,0);
  START(pA0,pA1);
  _Pragma("unroll") for(int r=0;r<16;++r)pA1[r]=__builtin_amdgcn_exp2f(pA1[r]);
  WAIT_BAR(0);
  DMA_K(3,0);DMA_V(1,SLOTB);
  ROT();
  kload8(kf,kp0+sl_cur);
  WAIT_BAR(2);
  s16x4 vlo[8],vhi[8]; u32x4 pw0,pw1,pw2,pw3;
  #define PKW(P,B) cvtpk_s(P[B],P[B+1])
  #define PAF(k) __builtin_bit_cast(bf16x8,pw##k)
  #define VFR(i) (bf16x8){vlo[i][0],vlo[i][1],vlo[i][2],vlo[i][3],vhi[i][0],vhi[i][1],vhi[i][2],vhi[i][3]}
  #define PIN(x) asm volatile("":"+v"(x))
  #define MX3(a,b,c) __builtin_fmaxf(__builtin_fmaxf((a),(b)),(c))
  #define GAPA(MF,A0,A1,A2,A3,W0,W1,PW) do{ MF; sacc+=A0; sacc+=A1; sacc+=A2; sacc+=A3; PIN(sacc); W0; W1; PIN(PW); SBAR(); }while(0)
  #define EX(v) __builtin_amdgcn_exp2f(v)
  #define GAPB(MF,X,B) do{ MF; X[B]=EX(X[B]); X[B+1]=EX(X[B+1]); X[B+2]=EX(X[B+2]); X[B+3]=EX(X[B+3]); PIN(X); SBAR(); }while(0)
  #define VRD(i) do{ vlo[i]=vtr(vp_+(((i)>>2)*4096+((i)&3)*1024)); vhi[i]=vtr(vp_+(((i)>>2)*4096+((i)&3)*1024+512)); }while(0)
  #define KRD(G,j) do{ if(G){ kload2(kf,kp0+sl_next,j); SBAR(); } }while(0)
  #define STEP(C0,C1,P0,P1,t,GK,GV,GL) do{ SBAR(); \
    const lds_cptr vp_=vp0+sl_prev; \
    VRD(0); SBAR(); float sacc=(P0[0]+P0[1]); \
    GAPA(C0=__builtin_amdgcn_mfma_f32_32x32x16_bf16(kf[0],qr[0],negm,0,0,0), P0[2],P0[3],P0[4],P0[5],     pw0[0]=PKW(P0,0), pw0[1]=PKW(P0,2), pw0); \
    VRD(4); SBAR(); GAPA(C1=__builtin_amdgcn_mfma_f32_32x32x16_bf16(kf[1],qr[0],negm,0,0,0), P0[6],P0[7],P0[8],P0[9],     pw0[2]=PKW(P0,4), pw0[3]=PKW(P0,6), pw0); \
    VRD(1); SBAR(); GAPA(C0=__builtin_amdgcn_mfma_f32_32x32x16_bf16(kf[2],qr[1],C0,0,0,0),   P0[10],P0[11],P0[12],P0[13], pw1[0]=PKW(P0,8), pw1[1]=PKW(P0,10), pw1); \
    VRD(5); SBAR(); GAPA(C1=__builtin_amdgcn_mfma_f32_32x32x16_bf16(kf[3],qr[1],C1,0,0,0),   P0[14],P0[15],P1[0],P1[1],   pw1[2]=PKW(P0,12),pw1[3]=PKW(P0,14), pw1); \
    VRD(2); SBAR(); GAPA(C0=__builtin_amdgcn_mfma_f32_32x32x16_bf16(kf[4],qr[2],C0,0,0,0),   P1[2],P1[3],P1[4],P1[5],     pw2[0]=PKW(P1,0), pw2[1]=PKW(P1,2), pw2); \
    VRD(6); SBAR(); GAPA(C1=__builtin_amdgcn_mfma_f32_32x32x16_bf16(kf[5],qr[2],C1,0,0,0),   P1[6],P1[7],P1[8],P1[9],     pw2[2]=PKW(P1,4), pw2[3]=PKW(P1,6), pw2); \
    VRD(3); SBAR(); GAPA(C0=__builtin_amdgcn_mfma_f32_32x32x16_bf16(kf[6],qr[3],C0,0,0,0),   P1[10],P1[11],P1[12],P1[13], pw3[0]=PKW(P1,8), pw3[1]=PKW(P1,10), pw3); \
    VRD(7); SBAR(); GAPA(C1=__builtin_amdgcn_mfma_f32_32x32x16_bf16(kf[7],qr[3],C1,0,0,0),   P1[14],P1[15],0.f,0.f,       pw3[2]=PKW(P1,12),pw3[3]=PKW(P1,14), pw3); \
    l_reg+=sacc; \
    if(GK){DMA_K((t)+3,sl_cur);} if(GV){DMA_V((t)+1,sl_next);} \
    CMASK(C0,C1,t); \
    { float a=MX3(C0[0],C0[1],C1[0]),b=MX3(C0[2],C0[3],C1[1]); a=MX3(a,C1[2],C1[3]); \
      _Pragma("unroll") for(int r=4;r<16;r+=4){a=MX3(a,C0[r],C0[r+1]);b=MX3(b,C0[r+2],C0[r+3]);a=MX3(a,C1[r],C1[r+1]);b=MX3(b,C1[r+2],C1[r+3]);} \
      float rm=__builtin_fmaxf(a,b); { auto rr=__builtin_amdgcn_permlane32_swap(__float_as_uint(rm),__float_as_uint(rm),false,false); rm=__builtin_fmaxf(__uint_as_float(rr[0]),__uint_as_float(rr[1])); } \
      resc=false; \
      if(__builtin_expect(__any(rm>(float)THRL),0)){ const float dl=__builtin_fmaxf(rm,0.f); mhat+=dl; \
        _Pragma("unroll") for(int r=0;r<16;++r){C0[r]-=dl;C1[r]-=dl;} \
        _Pragma("unroll") for(int r=0;r<16;++r)negm[r]=-mhat; asm volatile("":"+v"(negm)); \
        const float f=__builtin_amdgcn_exp2f(-dl); l_reg*=f; if(hi==0)wsf[r32]=f; resc=true; } } \
    SBAR(); \
    GAPB(o[0]=__builtin_amdgcn_mfma_f32_32x32x16_bf16(PAF(0),VFR(0),o[0],0,0,0), C0,0); \
    GAPB(o[1]=__builtin_amdgcn_mfma_f32_32x32x16_bf16(PAF(0),VFR(4),o[1],0,0,0), C0,4); \
    KRD(GL,0); GAPB(o[0]=__builtin_amdgcn_mfma_f32_32x32x16_bf16(PAF(1),VFR(1),o[0],0,0,0), C0,8); \
    KRD(GL,1); GAPB(o[1]=__builtin_amdgcn_mfma_f32_32x32x16_bf16(PAF(1),VFR(5),o[1],0,0,0), C0,12); \
    KRD(GL,2); GAPB(o[0]=__builtin_amdgcn_mfma_f32_32x32x16_bf16(PAF(2),VFR(2),o[0],0,0,0), C1,0); \
    KRD(GL,3); GAPB(o[1]=__builtin_amdgcn_mfma_f32_32x32x16_bf16(PAF(2),VFR(6),o[1],0,0,0), C1,4); \
    GAPB(o[0]=__builtin_amdgcn_mfma_f32_32x32x16_bf16(PAF(3),VFR(3),o[0],0,0,0), C1,8); \
    GAPB(o[1]=__builtin_amdgcn_mfma_f32_32x32x16_bf16(PAF(3),VFR(7),o[1],0,0,0), C1,12); \
    }while(0)
  int t=1;
  for(;t+5<NT;t+=2){
    STEP(pB0,pB1,pA0,pA1,t,true,true,true);     WAIT_BAR(2); RESC(); ROT();
    STEP(pA0,pA1,pB0,pB1,t+1,true,true,true);   WAIT_BAR(2); RESC(); ROT();
  }
  #define ENDW(tt) do{ if((tt)+3<NT){WAIT_BAR(2);} else if((tt)+2<NT){WAIT_BAR(1);} else {WAIT_BAR(0);} }while(0)
  for(;t+1<NT;t+=2){
    STEP(pB0,pB1,pA0,pA1,t,(t+3<NT),(t+1<NT),(t+1<NT));       ENDW(t);   RESC(); ROT();
    STEP(pA0,pA1,pB0,pB1,t+1,(t+4<NT),(t+2<NT),(t+2<NT));     ENDW(t+1); RESC(); ROT();
  }
  STEP(pB0,pB1,pA0,pA1,NT-1,false,false,false); RESC();
  { float sacc=pB0[0]+pB0[1]; _Pragma("unroll") for(int r=2;r<16;++r)sacc+=pB0[r]; _Pragma("unroll") for(int r=0;r<16;++r)sacc+=pB1[r]; l_reg+=sacc;
    pw0=(u32x4){PKW(pB0,0),PKW(pB0,2),PKW(pB0,4),PKW(pB0,6)};pw1=(u32x4){PKW(pB0,8),PKW(pB0,10),PKW(pB0,12),PKW(pB0,14)};pw2=(u32x4){PKW(pB1,0),PKW(pB1,2),PKW(pB1,4),PKW(pB1,6)};pw3=(u32x4){PKW(pB1,8),PKW(pB1,10),PKW(pB1,12),PKW(pB1,14)};
    SBAR(); pv(o,vb0+sl_cur,PAF(0),PAF(1),PAF(2),PAF(3)); }
  #undef PKW
  #undef PAF
  #undef VFR
  #undef PIN
  #undef MX3
  #undef GAPA
  #undef GAPB
  #undef EX
  #undef VRD
  #undef KRD
  #undef STEP
  #undef ENDW
  {auto rr=__builtin_amdgcn_permlane32_swap(__float_as_uint(l_reg),__float_as_uint(l_reg),false,false);l_reg=__uint_as_float(rr[0])+__uint_as_float(rr[1]);}
  if(KIND==0)l_reg+=__builtin_amdgcn_exp2f(ud.sink2-mhat);
  if(hi==0)wsf[32+r32]=l_reg;asm volatile("s_waitcnt lgkmcnt(0)":::"memory");
  float rli[16];
  #pragma unroll
  for(int r=0;r<16;++r)rli[r]=__builtin_amdgcn_rcpf(wsf[32+crow(r,hi)]);
  bf16*Ow=Y+(long)(ud.qrow0+wid*QBLK)*QP+ud.qcol;
  { bf16*stg=(bf16*)(shm+LDS_OST)+wid*2048;
    #pragma unroll
    for(int r=0;r<16;++r){const int orow=crow(r,hi);
      #pragma unroll
      for(int d0=0;d0<2;++d0)stg[orow*64+d0*32+r32]=__float2bfloat16(o[d0][r]*rli[r]);}
    asm volatile("s_waitcnt lgkmcnt(0)":::"memory");
    #pragma unroll
    for(int i=0;i<4;++i){const int row=i*8+(lane>>3),ch=lane&7; const u32x4 v=*(const u32x4*)(stg+row*64+ch*8); ATTN_STORE16(Ow+(long)row*QP+ch*8,v);} }
  asm volatile("s_waitcnt lgkmcnt(0)\n\ts_barrier":::"memory");
  #undef DMA_K
  #undef DMA_V
  #undef TROW
  #undef CMASK
  #undef START
  #undef RESC
  #undef ROT
}
constexpr int ATTN_LDS_BYTES=LDS_BYTES;
#undef SBAR
#undef WAIT_BAR
}

#ifndef PG8_SP2
#define PG8_SP2 true
#endif
#ifndef PG8_ALIGN
#define PG8_ALIGN true
#endif

#ifndef PG8_SP2
#define PG8_SP2 true
#endif
#ifndef PG8_ALIGN
#define PG8_ALIGN true
#endif
constexpr int NWAVES = 8;
constexpr int RING_OFF = 0, RING_BYTES = 131072;
constexpr int LDSCTL_OFF = RING_BYTES, MISC_OFF = LDSCTL_OFF + 320;
constexpr int LDS_BYTES = 147456;
constexpr size_t WS_W = 1 * MiB;
constexpr size_t WO_IN = 0, WO_MERGE = 13 * MiB, WO_OUT = 17 * MiB, WO_FF1 = 19 * MiB, WO_FF2 = 27 * MiB, WO_LRU = 35 * MiB;
constexpr int CW_TMO = 0, CW_CODE = 1, CW_BAR = 4096;
constexpr size_t CTL_ZERO_BYTES = 64 * 1024;

#define GAS __attribute__((address_space(1)))
#define LAS __attribute__((address_space(3)))
typedef unsigned v4u __attribute__((ext_vector_type(4)));
typedef float f32x4 __attribute__((ext_vector_type(4)));
typedef short bf16x8 __attribute__((ext_vector_type(8)));
typedef GAS unsigned gu32;
typedef GAS unsigned long long gu64;
#define RLX_AGENT __ATOMIC_RELAXED, __HIP_MEMORY_SCOPE_AGENT
#define LDS_WAIT() asm volatile("s_waitcnt lgkmcnt(0)" ::: "memory")
#define VM_WAIT() asm volatile("s_waitcnt vmcnt(0)" ::: "memory")
__device__ __forceinline__ unsigned long long rt() { return __builtin_amdgcn_s_memrealtime(); }
__device__ __forceinline__ unsigned f2bfu(float f) { unsigned u = __builtin_bit_cast(unsigned, f); return (u + 0x7fffu + ((u >> 16) & 1u)) >> 16; }
__device__ __forceinline__ unsigned pk2(float lo, float hi) { return f2bfu(lo) | (f2bfu(hi) << 16); }

#define XB_TMO      128
#define XB_XCNT(j)  (256  + 64 * (j))
#define XB_XSUB(j)  (1280 + 64 * (j))
#define XB_XGEN(j)  (2304 + 64 * (j))
#define XB_TOP      3328
#define XB_TOPGEN   3392
#define XCD_BAR_WORDS 3456
#define XB_SPIN_CAP (1u << 18)

__device__ __forceinline__ unsigned xb_ld(unsigned* p)              { return __hip_atomic_load(p, __ATOMIC_RELAXED, __HIP_MEMORY_SCOPE_AGENT); }
__device__ __forceinline__ unsigned xb_add(unsigned* p, unsigned v) { return __hip_atomic_fetch_add(p, v, __ATOMIC_RELAXED, __HIP_MEMORY_SCOPE_AGENT); }
__device__ __forceinline__ unsigned xb_xcc_id() { return (unsigned)__builtin_amdgcn_s_getreg((3 << 11) | 20) & 0xFu; }
#define XB_SPIN(cond, bar) do { unsigned _sp = 0; while (cond) { __builtin_amdgcn_s_sleep(1); \
    if ((++_sp & 255u) == 0u) { if (xb_ld(&(bar)[XB_TMO])) break; if (_sp > XB_SPIN_CAP) { atomicAdd(&(bar)[XB_TMO], 1u); break; } } } } while (0)

struct XcdBarrier {
    unsigned* bar; unsigned x;
    volatile LAS unsigned* st;
};

__device__ __forceinline__ XcdBarrier xcd_barrier_post(unsigned* bar, volatile LAS unsigned* st) {
    XcdBarrier b; b.bar = bar; b.x = xb_xcc_id(); b.st = st;
    if (threadIdx.x == 0) (void)xb_add(&bar[XB_XCNT(b.x)], 1u);
    return b;
}
__device__ __forceinline__ void xcd_barrier_complete(unsigned* bar, unsigned x, unsigned& nloc, unsigned& nx) {
    const unsigned G = gridDim.x * gridDim.y * gridDim.z;
    unsigned sum, cnt, mine, sp = 0u;
    for (;;) {
        sum = 0u; cnt = 0u; mine = 0u;
#pragma unroll
        for (unsigned j = 0; j < 16; ++j) { const unsigned c = xb_ld(&bar[XB_XCNT(j)]); sum += c; cnt += (c > 0u) ? 1u : 0u; mine = (j == x) ? c : mine; }
        if (sum == G) break;
        __builtin_amdgcn_s_sleep(1);
        if ((++sp & 255u) == 0u) { if (xb_ld(&bar[XB_TMO])) break; if (sp > XB_SPIN_CAP) { atomicAdd(&bar[XB_TMO], 1u); break; } }
    }
    nloc = mine > 0u ? mine : 1u; nx = cnt > 0u ? cnt : 1u;
}

__device__ __forceinline__ void xcd_barrier(const XcdBarrier& b) {
    asm volatile("s_waitcnt vmcnt(0)" ::: "memory");
    __syncthreads();
    if (threadIdx.x == 0) {
        unsigned* bar = b.bar;
        __builtin_amdgcn_s_waitcnt(0);
        unsigned nloc = b.st[0], nx = b.st[1];
        if (nloc == 0u) { xcd_barrier_complete(bar, b.x, nloc, nx); b.st[0] = nloc; b.st[1] = nx; }
        const unsigned old = xb_add(&bar[XB_XSUB(b.x)], 1u);
        const unsigned gen = old / nloc;
        if (old + 1u == (gen + 1u) * nloc) {
            __builtin_amdgcn_fence(__ATOMIC_RELEASE, "agent");
            asm volatile("s_waitcnt vmcnt(0)" ::: "memory");
            const unsigned og = xb_add(&bar[XB_TOP], 1u);
            const unsigned tg = og / nx;
            if (og + 1u == (tg + 1u) * nx) xb_add(&bar[XB_TOPGEN], 1u);
            else XB_SPIN(xb_ld(&bar[XB_TOPGEN]) == tg, bar);
            __builtin_amdgcn_fence(__ATOMIC_ACQUIRE, "agent");
            xb_add(&bar[XB_XGEN(b.x)], 1u);
            asm volatile("s_waitcnt vmcnt(0)" ::: "memory");
        } else {
            XB_SPIN(xb_ld(&bar[XB_XGEN(b.x)]) == gen, bar);
            __builtin_amdgcn_fence(__ATOMIC_ACQUIRE, "agent");
            asm volatile("s_waitcnt vmcnt(0)" ::: "memory");
        }
    }
    __syncthreads();
}


template <int KIND> __device__ __forceinline__ void attn_latent(char* lds, bf16* Y, const bf16* K, const bf16* V, int vcu, int G, const float* sink) {
    for (int U = vcu; U < 512; U += G) {
        const int grp = (U & 255) >> 5, loc = U & 31, u = loc * 2 + (U >> 8), b = grp >> 1, kvh = grp & 1, h = kvh * 4 + (u >> 4), qb = u & 15;
        attn_body::UnitDesc ud; ud.qrow0 = b * SEQ + 256 * qb; ud.qcol = (KIND == 0 ? 0 : 512) + h * 64; ud.kvcol = kvh * 64;
        if (KIND == 1) { ud.NT = 68; ud.n0 = 64; ud.r0 = b * SEQ; ud.r1 = NLAT + b * CTXL; ud.mq0 = 0; ud.mk0 = 0; ud.sink2 = 0.f; }
        else { const int tl0 = 4 * qb - 2 < 0 ? 0 : 4 * qb - 2, tl1 = 4 * qb + 5 > 63 ? 63 : 4 * qb + 5;
            ud.NT = 4 + (tl1 - tl0 + 1); ud.n0 = 4; ud.r0 = NLAT + b * CTXL; ud.r1 = b * SEQ + 64 * tl0; ud.mq0 = 256 * qb; ud.mk0 = 64 * tl0; ud.sink2 = sink[h] * LOG2E; }
        attn_body::attn_unit<KIND, 8>(ud, (attn_body::bf16*)Y, (const attn_body::bf16*)K, (const attn_body::bf16*)V, lds);
    }
}
template <int KIND> __device__ __forceinline__ void attn_context(char* lds, bf16* Y, const bf16* K, const bf16* V, int vcu, int G, const float* sink) {
    for (int j = 0; j < 32; ++j) {
        const int b = j >> 3, h = j & 7, kvh = h >> 2, tgt = ((b * 2 + kvh) * 32 + 8 + (h & 3) + 4 * KIND) % G;
        if (tgt != vcu) continue;
        attn_body::UnitDesc ud; ud.qrow0 = NLAT + b * CTXL; ud.qcol = (KIND == 0 ? 0 : 512) + h * 64; ud.kvcol = kvh * 64;
        ud.NT = 4; ud.n0 = 4; ud.r0 = NLAT + b * CTXL; ud.r1 = 0; ud.mq0 = 0; ud.mk0 = 0; ud.sink2 = KIND == 0 ? sink[h] * LOG2E : 0.f;
        attn_body::attn_unit<KIND, 8>(ud, (attn_body::bf16*)Y, (const attn_body::bf16*)K, (const attn_body::bf16*)V, lds);
    }
}

#ifndef ATTN_ON
#define ATTN_ON 1
#endif
#ifndef PHMASK
#define PHMASK 0xffffffffu
#endif
#define PHM(p) ((PHMASK >> (p)) & 1u)
struct MkArgs { const float* in[27]; float* out; unsigned char* ws; int ph_lo, ph_hi, layer, pad; };
typedef const __attribute__((address_space(4))) MkArgs& KArgs;
struct Frame {
    LAS unsigned char* lds; volatile LAS unsigned* MISC; gu32* ctl;
    int tid, lane, wave, vcu, G;
};
enum { PH_PRO = 0, PH_W = 1, PH_G1A = 2, PH_MIX1 = 3, PH_MIX2 = 4, PH_G1B = 5, PH_MERGE = 6, PH_OUT = 7, PH_LN1 = 8, PH_FF1 = 9, PH_FF2 = 10, PH_LN2 = 11, PH_COUNT = 12 };

__device__ __forceinline__ int tt_of_tile(int kind, int tile) { return kind == 0 ? pg8::TT_IDENT : kind == 1 ? pg8::TT_NAT8 : (tile < 6 ? pg8::TT_HEAD : pg8::TT_NAT8); }
__device__ __forceinline__ void transpose_item(const float* W, int ldw, int N, bf16* WT, int dpitch, int koff, int kind, LAS float* scr, int item, int lane) {
    const int nblk = N / 32, kb = item / nblk, nb = item % nblk, k0 = 64 * kb, n0 = 32 * nb;
#pragma unroll 8
    for (int i = 0; i < 32; ++i) { const int kk = 2 * i + (lane >> 5); scr[kk * 33 + (lane & 31)] = W[(size_t)(k0 + kk) * ldw + n0 + (lane & 31)]; }
    LDS_WAIT(); asm volatile("" ::: "memory");
    const int c = lane & 7;
#pragma unroll
    for (int j = 0; j < 4; ++j) { const int n = (lane >> 3) + 8 * j; const LAS float* s = scr + (8 * c) * 33 + n;
        v4u o; o.x = pk2(s[0 * 33], s[1 * 33]); o.y = pk2(s[2 * 33], s[3 * 33]); o.z = pk2(s[4 * 33], s[5 * 33]); o.w = pk2(s[6 * 33], s[7 * 33]);
        const int cl = n0 + n, tile = cl >> 8, drow = tile * 256 + pg8::tile_pos_of_logical(tt_of_tile(kind, tile), cl & 255);
        *(GAS v4u*)(WT + (size_t)drow * dpitch + koff + k0 + 8 * c) = o; }
    LDS_WAIT(); asm volatile("" ::: "memory");
}
__device__ __forceinline__ void phase_weights(Frame& F, KArgs a, int l) {
    LAS float* scr = (LAS float*)(F.lds + RING_OFF + F.wave * 16384);
    const int gw = F.vcu * NWAVES + F.wave, NGW = F.G * NWAVES;
    bf16* wb = (bf16*)(a.ws + WS_W);
    bf16 *Wi = wb + WO_IN / 2, *Wm = wb + WO_MERGE / 2, *Wo = wb + WO_OUT / 2, *W1 = wb + WO_FF1 / 2, *W2 = wb + WO_FF2 / 2;
    const float* w_in = a.in[6] + (size_t)l * DM * INC; const float* wa = a.in[17] + (size_t)l * 512 * DM; const float* wbb = a.in[18] + (size_t)l * 512 * DM; const float* wc = a.in[19] + (size_t)l * DM * DM;
    const float* wo = a.in[20] + (size_t)l * DM * DM; const float* w1 = a.in[23] + (size_t)l * DM * DFF; const float* w2 = a.in[24] + (size_t)l * DFF * DM;
    constexpr int I_IN = 16 * (INC / 32), I_A = 8 * 32, I_C = 16 * 32, I_O = 16 * 32, I_1 = 16 * (DFF / 32), I_2 = 64 * 32;
    constexpr int NITEMS = I_IN + 2 * I_A + I_C + I_O + I_1 + I_2;
    for (int it = gw; it < NITEMS; it += NGW) {
        int r = it;
        if (r < I_IN) { transpose_item(w_in, INC, INC, Wi, DM, 0, 2, scr, r, F.lane); continue; } r -= I_IN;
        if (r < I_A) { transpose_item(wa, DM, DM, Wm, YC, 0, 1, scr, r, F.lane); continue; } r -= I_A;
        if (r < I_A) { transpose_item(wbb, DM, DM, Wm, YC, 512, 1, scr, r, F.lane); continue; } r -= I_A;
        if (r < I_C) { transpose_item(wc, DM, DM, Wm, YC, 1024, 1, scr, r, F.lane); continue; } r -= I_C;
        if (r < I_O) { transpose_item(wo, DM, DM, Wo, DM, 0, 0, scr, r, F.lane); continue; } r -= I_O;
        if (r < I_1) { transpose_item(w1, DFF, DFF, W1, DM, 0, 1, scr, r, F.lane); continue; } r -= I_1;
        transpose_item(w2, DM, DM, W2, DFF, 0, 0, scr, r, F.lane);
    }
    { bf16* Wg = wb + WO_LRU / 2; const float* wr = a.in[12] + (size_t)l * 2 * 16 * 4096; const float* wi = a.in[14] + (size_t)l * 2 * 16 * 4096;
      for (int idx = gw * 64 + F.lane; idx < 2 * 2 * 16 * 64 * 8; idx += NGW * 64) {
          const int dc = idx & 7, rho = (idx >> 3) & 63, blk = (idx >> 9) & 15, gate = (idx >> 13) & 1, dir = idx >> 14;
          const int n = rho >> 4, i = rho & 15, e = 32 * (n >> 1) + 8 * (i >> 2) + 4 * (n & 1) + (i & 3);
          const float* src = (gate ? wi : wr) + ((size_t)(dir * 16 + blk) * 64 + dc * 8) * 64 + e;
          v4u o; o.x = pk2(src[0], src[64]); o.y = pk2(src[128], src[192]); o.z = pk2(src[256], src[320]); o.w = pk2(src[384], src[448]);
          *(GAS v4u*)(Wg + (size_t)(idx >> 3) * 64 + dc * 8) = o; }
      float* c2 = (float*)(a.ws + WS_LRUC); const float* lam = a.in[16] + (size_t)l * 2 * DM;
      for (int idx = gw * 64 + F.lane; idx < 2 * DM; idx += NGW * 64) c2[idx] = -8.f * 1.4426950408889634f * log1pf(__expf(-lam[idx])); }
}


__device__ __forceinline__ float wave_sum(float v) {
#pragma unroll
    for (int o = 1; o < 64; o <<= 1) v += __shfl_xor(v, o);
    return v;
}
__device__ __forceinline__ void phase_pro(Frame& F, KArgs a, float* mod, float* rope) {
    LAS float* red = (LAS float*)(F.lds + RING_OFF);
    const float* c = a.in[1]; const float* c_ctx = a.in[3]; const float* w_ada = a.in[4]; const float* b_ada = a.in[5];
    for (int it = F.vcu; it < DEPTH * 96; it += F.G) {
        const int l = it / 96, n = (it % 96) * 64 + F.lane;
        float acc[5] = {0.f, 0.f, 0.f, 0.f, 0.f};
        const float* wp = w_ada + ((size_t)l * DM + F.wave * 128) * 6144 + n;
#pragma unroll 4
        for (int k = 0; k < 128; ++k) { const float w = wp[(size_t)k * 6144]; const int kk = F.wave * 128 + k;
#pragma unroll
            for (int v = 0; v < 5; ++v) { const float x = v < 4 ? c[v * DM + kk] : c_ctx[kk]; acc[v] += (x / (1.f + __expf(-x))) * w; } }
        __syncthreads();
#pragma unroll
        for (int v = 0; v < 5; ++v) red[(F.wave * 5 + v) * 64 + F.lane] = acc[v];
        __syncthreads();
        if (F.wave < 5) { float s = b_ada[l * 6144 + n];
#pragma unroll
            for (int w = 0; w < 8; ++w) s += red[(w * 5 + F.wave) * 64 + F.lane];
            mod[((size_t)l * 5 + F.wave) * 6144 + n] = s; }
    }
    if (blockIdx.x == 0) for (int i = F.tid; i < 1024; i += NWAVES * 64) { const int pos = i / 16, f = i % 16;
        float inv = 1.f;
        inv = f == 1 ? 5.623413324e-01f : inv; inv = f == 2 ? 3.162277639e-01f : inv; inv = f == 3 ? 1.778279394e-01f : inv; inv = f == 4 ? 1.000000015e-01f : inv; inv = f == 5 ? 5.623413250e-02f : inv;
        inv = f == 6 ? 3.162277490e-02f : inv; inv = f == 7 ? 1.778279431e-02f : inv; inv = f == 8 ? 9.999999776e-03f : inv; inv = f == 9 ? 5.623413250e-03f : inv; inv = f == 10 ? 3.162277630e-03f : inv;
        inv = f == 11 ? 1.778279431e-03f : inv; inv = f == 12 ? 1.000000047e-03f : inv; inv = f == 13 ? 5.623413017e-04f : inv; inv = f == 14 ? 3.162277571e-04f : inv; inv = f == 15 ? 1.778279402e-04f : inv;
        const float ang = (float)pos * inv; rope[i] = cosf(ang); rope[1024 + i] = sinf(ang); }
}
__device__ __forceinline__ void phase_modulate(Frame& F, const float* xlat, const float* xctx, const float* modl, int sh_off, int sc_off, bf16* H) {
    const int gw = F.vcu * NWAVES + F.wave, NGW = F.G * NWAVES;
    for (int row = gw; row < NROW; row += NGW) {
        const float* xr = row < NLAT ? xlat + (size_t)row * DM : xctx + (size_t)(row - NLAT) * DM; const float* m = modl + (size_t)(row < NLAT ? row / SEQ : 4) * 6144;
        GAS unsigned long long* o8 = (GAS unsigned long long*)(H + (size_t)row * DM) + F.lane;
#pragma unroll
        for (int j = 0; j < 4; ++j) { const int c = 4 * F.lane + 256 * j; const f32x4 v = *(const f32x4*)(xr + c), sc = *(const f32x4*)(m + sc_off + c), sh = *(const f32x4*)(m + sh_off + c);
            const f32x4 y = v * (sc + 1.f) + sh; o8[64 * j] = (unsigned long long)pk2(y.x, y.y) | ((unsigned long long)pk2(y.z, y.w) << 32); }
    }
}
__device__ __forceinline__ void phase_ln(Frame& F, float* xlat, float* xctx, const float* g, const float* bta, const float* modl, int sh_off, int sc_off, bf16* H, int nrows) {
    const int gw = F.vcu * NWAVES + F.wave, NGW = F.G * NWAVES;
    for (int row = gw; row < nrows; row += NGW) {
        float* xr = row < NLAT ? xlat + (size_t)row * DM : xctx + (size_t)(row - NLAT) * DM;
        f32x4 v[4]; float s = 0.f;
#pragma unroll
        for (int j = 0; j < 4; ++j) { v[j] = *(const f32x4*)(xr + 4 * F.lane + 256 * j); s += (v[j].x + v[j].y) + (v[j].z + v[j].w); }
        const float mean = wave_sum(s) * (1.f / DM); float q = 0.f;
#pragma unroll
        for (int j = 0; j < 4; ++j) { v[j] = v[j] - mean; q += (v[j].x * v[j].x + v[j].y * v[j].y) + (v[j].z * v[j].z + v[j].w * v[j].w); }
        const float rstd = 1.f / sqrtf(wave_sum(q) * (1.f / DM) + LN_EPS);
        const float* m = modl ? modl + (size_t)(row < NLAT ? row / SEQ : 4) * 6144 : nullptr;
        GAS unsigned long long* o8 = (GAS unsigned long long*)(H + (size_t)row * DM) + F.lane;
#pragma unroll
        for (int j = 0; j < 4; ++j) { const int c = 4 * F.lane + 256 * j; const f32x4 y = v[j] * rstd * *(const f32x4*)(g + c) + *(const f32x4*)(bta + c);
            *(f32x4*)(xr + c) = y;
            if (modl) { const f32x4 z = y * (*(const f32x4*)(m + sc_off + c) + 1.f) + *(const f32x4*)(m + sh_off + c); o8[64 * j] = (unsigned long long)pk2(z.x, z.y) | ((unsigned long long)pk2(z.z, z.w) << 32); } }
    }
}

__global__ void __launch_bounds__(NWAVES * 64, 2) mk_fwd(MkArgs args_k) {
    extern __shared__ __attribute__((aligned(16))) unsigned char lds[];
    Frame F;
    F.lds = (LAS unsigned char*)lds; F.MISC = (volatile LAS unsigned*)(F.lds + MISC_OFF);
    F.tid = threadIdx.x; F.lane = F.tid & 63; F.wave = __builtin_amdgcn_readfirstlane(F.tid >> 6);
    F.G = gridDim.x; { const int bx = blockIdx.x; F.vcu = (F.G % 8 == 0) ? (bx % 8) * (F.G / 8) + bx / 8 : bx; }
    F.ctl = (gu32*)(args_k.ws + WS_CTL);
    for (int u = F.tid; u < (LDS_BYTES - LDSCTL_OFF) / 4; u += NWAVES * 64) ((LAS unsigned*)(F.lds + LDSCTL_OFF))[u] = 0u;
    __syncthreads();
    XcdBarrier bar = xcd_barrier_post((unsigned*)(F.ctl + CW_BAR), F.MISC + 8);
    const int lo = args_k.ph_lo, hi = args_k.ph_hi;
    for (int gp = lo; gp < hi; ++gp) {
        const int l = gp / PH_COUNT, ph = gp % PH_COUNT;
        if (l > 0 && (ph == PH_PRO || ph == PH_W)) continue;
        unsigned long long kpi_ = (unsigned long long)__builtin_amdgcn_kernarg_segment_ptr(); asm volatile("" : "+s"(kpi_));
        KArgs args = *(const __attribute__((address_space(4))) MkArgs*)kpi_;
        unsigned long long wsi_ = (unsigned long long)args.ws; asm volatile("" : "+s"(wsi_)); unsigned char* ws = (unsigned char*)(GAS unsigned char*)wsi_;
        float* mod = (float*)(ws + WS_MOD); float* rope = (float*)(ws + WS_ROPE); float* ctxs = (float*)(ws + WS_CTXS);
        bf16* H = (bf16*)(ws + WS_H); bf16* Y = (bf16*)(ws + WS_Y); bf16* KA = (bf16*)(ws + WS_KA); bf16* VA = (bf16*)(ws + WS_VA); bf16* KB = (bf16*)(ws + WS_KB); bf16* VB = (bf16*)(ws + WS_VB);
        bf16* XR = (bf16*)(ws + WS_XR); bf16* G = (bf16*)(ws + WS_G); bf16* HID = (bf16*)(ws + WS_HID);
        bf16* wb = (bf16*)(ws + WS_W);
        { int t_ = threadIdx.x; asm volatile("" : "+v"(t_)); F.tid = t_; F.lane = t_ & 63; }
        const float* modl = mod + (size_t)l * 5 * 6144;
        const int MR = (l + 1 < DEPTH) ? NROW : NLAT;
        if (PHM(PH_PRO) && ph == PH_PRO) { if (l == 0) phase_pro(F, args, mod, rope); }
        else if (PHM(PH_W) && ph == PH_W) { phase_weights(F, args, l); if (l == 0) phase_modulate(F, args.in[0], args.in[2], modl, 0, 1024, H); }
        else if ((PHM(PH_MIX1) && ph == PH_MIX1) || (PHM(PH_MIX2) && ph == PH_MIX2)) {
            lru::Params LP{XR, args.in[10] + (size_t)l * 4 * DM, args.in[11] + (size_t)l * DM, wb + WO_LRU / 2, args.in[13] + (size_t)l * 2 * DM, args.in[15] + (size_t)l * 2 * DM, (const float*)(ws + WS_LRUC), (float*)(ws + WS_AGG), Y};
            LAS lru::f32x4* hfl = (LAS lru::f32x4*)(F.lds + RING_OFF + F.wave * 8192);
            if (ph == PH_MIX1) lru::phase<1>(LP, F.vcu * NWAVES + F.wave, F.G * NWAVES, F.lane, hfl, false); else lru::phase<2>(LP, F.vcu * NWAVES + F.wave, F.G * NWAVES, F.lane, hfl, l + 1 == DEPTH);
            __syncthreads();
            const float* sink = args.in[7] + l * 8;
            if (ATTN_ON) {
            if (ph == PH_MIX1) { attn_latent<0>((char*)lds, Y, KA, VA, F.vcu, F.G, sink); if (l == 0) { attn_context<0>((char*)lds, Y, KA, VA, F.vcu, F.G, sink); attn_context<1>((char*)lds, Y, KB, VB, F.vcu, F.G, sink); } }
            else attn_latent<1>((char*)lds, Y, KB, VB, F.vcu, F.G, sink);
            }
        }
        else if (PHM(PH_LN1) && ph == PH_LN1) phase_ln(F, args.out, ctxs, args.in[21] + l * DM, args.in[22] + l * DM, modl, 3072, 4096, H, MR);
        else if (PHM(PH_LN2) && ph == PH_LN2) { phase_ln(F, args.out, ctxs, args.in[25] + l * DM, args.in[26] + l * DM, l + 1 < DEPTH ? modl + 5 * 6144 : nullptr, 0, 1024, H, MR); if (l + 1 < DEPTH) phase_weights(F, args, l + 1); }
        else if (PHM(PH_G1A) && ph == PH_G1A) {
            pg8::Gemm g{H, wb + WO_IN / 2, NROW, 3584, DM}; pg8::StaticOrder S; S.init(NROW, 3584, F.G, (int)blockIdx.x);
            pg8::EpiG1 E{Y, KA, VA, KB, VB, XR, G, rope, args.in[8] + l * 64, args.in[9] + l * 64, 0, 0};
            pg8::gemm_phase<pg8::EpiG1, pg8::StaticOrder, PG8_ALIGN, PG8_SP2>(F.lds + RING_OFF, g, S, E);
        } else if (PHM(PH_G1B) && ph == PH_G1B) {
            pg8::Gemm g{H, wb + WO_IN / 2 + (size_t)3584 * DM, MR, 3072, DM}; pg8::StaticOrder S; S.init(MR, 3072, F.G, (int)blockIdx.x);
            pg8::EpiG1 E{Y, KA, VA, KB, VB, XR, G, rope, args.in[8] + l * 64, args.in[9] + l * 64, 14, 0};
            pg8::gemm_phase<pg8::EpiG1, pg8::StaticOrder, PG8_ALIGN, PG8_SP2>(F.lds + RING_OFF, g, S, E);
        } else if (PHM(PH_MERGE) && ph == PH_MERGE) {
            pg8::Gemm g{Y, wb + WO_MERGE / 2, MR, DM, YC}; pg8::StaticOrder S; S.init(MR, DM, F.G, (int)blockIdx.x);
            pg8::EpiMerge E{G, H};
            pg8::gemm_phase<pg8::EpiMerge, pg8::StaticOrder, PG8_ALIGN, PG8_SP2>(F.lds + RING_OFF, g, S, E);
        } else if (PHM(PH_OUT) && ph == PH_OUT) {
            pg8::Gemm g{H, wb + WO_OUT / 2, MR, DM, DM}; pg8::StaticOrder S; S.init(MR, DM, F.G, (int)blockIdx.x);
            pg8::EpiResid E{l == 0 ? args.in[0] : args.out, l == 0 ? args.in[2] : ctxs, args.out, ctxs, modl, 2048, 0};
            pg8::gemm_phase<pg8::EpiResid, pg8::StaticOrder, PG8_ALIGN, PG8_SP2>(F.lds + RING_OFF, g, S, E);
        } else if (PHM(PH_FF1) && ph == PH_FF1) {
            pg8::Gemm g{H, wb + WO_FF1 / 2, MR, DFF, DM}; pg8::StaticOrder S; S.init(MR, DFF, F.G, (int)blockIdx.x);
            pg8::EpiNat8<3> E{HID, DFF};
            pg8::gemm_phase<pg8::EpiNat8<3>, pg8::StaticOrder, PG8_ALIGN, PG8_SP2>(F.lds + RING_OFF, g, S, E);
        } else if (PHM(PH_FF2) && ph == PH_FF2) {
            pg8::Gemm g{HID, wb + WO_FF2 / 2, MR, DM, DFF}; pg8::StaticOrder S; S.init(MR, DM, F.G, (int)blockIdx.x);
            pg8::EpiResid E{args.out, ctxs, args.out, ctxs, modl, 5120, 0};
            pg8::gemm_phase<pg8::EpiResid, pg8::StaticOrder, PG8_ALIGN, PG8_SP2>(F.lds + RING_OFF, g, S, E);
        }
        if (gp + 1 < hi) xcd_barrier(bar);
    }
}

static void launch_mk(const MkArgs& base, int l, int ph, int grid, hipStream_t stream) {
    MkArgs a = base; a.ph_lo = l * PH_COUNT + ph; a.ph_hi = a.ph_lo + 1; a.layer = l;
    hipLaunchKernelGGL(mk_fwd, dim3(grid), dim3(NWAVES * 64), LDS_BYTES, stream, a);
}
extern "C" void kernel_launch(void* const* d_in, const int* in_sizes, int n_in, void* d_out, int out_size, void* d_ws, size_t ws_size, hipStream_t stream) {
    if (n_in != 27 || ws_size < WS_END) { fprintf(stderr, "kernel_launch: unexpected n_in %d / ws_size %zu\n", n_in, ws_size); return; }
    static int grid = 0;
    if (grid == 0) {
        int dev = 0, cus = 0;
        if (hipGetDevice(&dev) != hipSuccess || hipDeviceGetAttribute(&cus, hipDeviceAttributeMultiprocessorCount, dev) != hipSuccess) { grid = -1; return; }
        if (hipFuncSetAttribute((const void*)mk_fwd, hipFuncAttributeMaxDynamicSharedMemorySize, LDS_BYTES) != hipSuccess) { fprintf(stderr, "hipFuncSetAttribute failed\n"); grid = -1; return; }
        grid = cus;
    }
    if (grid < 0) return;
    char* ws = (char*)d_ws; float* out = (float*)d_out;
    MkArgs base; memset(&base, 0, sizeof(base));
    for (int i = 0; i < 27; ++i) base.in[i] = (const float*)d_in[i];
    base.out = out; base.ws = (unsigned char*)d_ws;

    hipMemsetAsync(ws + WS_CTL, 0, CTL_ZERO_BYTES, stream);
#if defined(MK_MULTI)
    launch_mk(base, 0, PH_PRO, grid, stream); launch_mk(base, 0, PH_W, grid, stream);
    for (int l = 0; l < DEPTH; ++l) for (int ph = PH_G1A; ph < PH_COUNT; ++ph) launch_mk(base, l, ph, grid, stream);
#else
    { MkArgs a = base; a.ph_lo = 0; a.ph_hi = DEPTH * PH_COUNT; a.layer = 0; hipLaunchKernelGGL(mk_fwd, dim3(grid), dim3(NWAVES * 64), LDS_BYTES, stream, a); }
#endif
}
```

```cpp
#include <hip/hip_runtime.h>
#include <cstdio>
#include <cstdint>
#include <cmath>
#include <cstring>

typedef unsigned short bf16;
constexpr int DM = 1024, BATCH = 4, SEQ = 4096, CTXL = 256, DEPTH = 2;
constexpr int NLAT = BATCH * SEQ, NCTX = BATCH * CTXL, NROW = NLAT + NCTX;
constexpr int HD = 64, GRIDW = 64, WINDOW = 128;
constexpr int INC = 6656, DFF = 4096, YC = 2048, GC = 3072;
constexpr int C_QA = 0, C_KA = 512, C_VA = 640, C_QB = 768, C_KB = 1280, C_VB = 1408, C_XR = 1536, C_YR = 2560, C_G = 3584;
constexpr float ALPHA = 1.41421356237309515f;
constexpr float LN_EPS = 1e-5f, RMS_EPS = 1e-6f;
constexpr float QSCALE = 0.125f * 1.4426950408889634f;
constexpr float LOG2E = 1.4426950408889634f;

constexpr size_t MiB = 1u << 20;
constexpr size_t WS_CTL = 0;
constexpr size_t WS_MOD = 37 * MiB;
constexpr size_t WS_ROPE = WS_MOD + 512 * 1024;
constexpr size_t WS_LRUC = WS_ROPE + 16384;
constexpr size_t WS_CTXS = 38 * MiB;
constexpr size_t WS_AGG = 42 * MiB;
constexpr size_t WS_H = 47 * MiB;
constexpr size_t WS_Y = 81 * MiB;
constexpr size_t WS_KA = 149 * MiB, WS_VA = WS_KA + 4352 * 1024, WS_KB = WS_VA + 4352 * 1024, WS_VB = WS_KB + 4352 * 1024;
constexpr size_t WS_XR = 166 * MiB;
constexpr size_t WS_G = 149 * MiB;
constexpr size_t WS_HID = 81 * MiB;
constexpr size_t WS_END = 252 * MiB;

__device__ __forceinline__ float bf2f(bf16 v) { return __uint_as_float(((unsigned)v) << 16); }
__device__ __forceinline__ bf16 f2bf(float f) { unsigned u = __float_as_uint(f); return (bf16)((u + 0x7fffu + ((u >> 16) & 1u)) >> 16); }
__device__ __forceinline__ float bfr(float f) { return bf2f(f2bf(f)); }
__device__ __forceinline__ float sigmoidf_(float x) { return 1.f / (1.f + __expf(-x)); }
__device__ __forceinline__ float gelu_tanh(float x) { const float u = 0.7978845608028654f * (x + 0.044715f * x * x * x); return 0.5f * x * (1.f + tanhf(u)); }
__device__ __forceinline__ int row_batch(int row) { return row < NLAT ? row / SEQ : (row - NLAT) / CTXL; }
__device__ __forceinline__ int row_modidx(int row) { return row < NLAT ? row / SEQ : 4; }

__device__ __forceinline__ int tid_from_wave(int wave_s) { int w_ = wave_s; asm volatile("" : "+s"(w_)); int ln_ = (int)__builtin_amdgcn_mbcnt_hi(~0u, __builtin_amdgcn_mbcnt_lo(~0u, 0u)); asm volatile("" : "+v"(ln_)); return w_ * 64 + ln_; }
namespace pg8 {

#define PG8_LAS __attribute__((address_space(3)))
typedef unsigned short bf16_t;
typedef short bf16x8 __attribute__((ext_vector_type(8)));
typedef float f32x4 __attribute__((ext_vector_type(4)));
typedef unsigned u32x4 __attribute__((ext_vector_type(4)));
constexpr int BM = 256, BK = 64, HALF = 128, HTB = HALF * BK * 2  , STAGE_BYTES = 8 * HTB, NXCD = 8, WGM = 8;

__host__ __device__ __forceinline__ int lds_byte(int r, int c) { const int st = (r >> 4) * 2 + (c >> 5), rr = r & 15, cc = c & 31, ob = rr * 64 + cc * 2; return st * 1024 + (ob ^ (((ob >> 9) & 1) << 5)); }
__host__ __device__ __forceinline__ void stage_rc(int b, int& R, int& C) { const int st = b / 1024, sb = b % 1024, swz = sb ^ (((sb >> 9) & 1) << 5); R = (st >> 1) * 16 + swz / 64; C = (st & 1) * 32 + (swz % 64) / 2; }
__host__ __device__ __forceinline__ int perm32(int rho) { const int n = rho >> 4, i = rho & 15; return 8 * (i >> 2) + 4 * n + (i & 3); }

struct Unit { int pm, pn; };
struct Gemm { const bf16_t* A; const bf16_t* Bt; int M, N, K; };

struct StaticOrder {
    int nM, nN, nwg, G, c;
    __host__ __device__ void init(int M, int N, int G_, int c_) { nM = M / BM; nN = N / BM; nwg = nM * nN; G = G_; c = c_; }
    __host__ __device__ bool next(int i, Unit& u) const {
        const long L = (long)i * G + c; if (L >= nwg) return false;
        int wgid = (int)L; { const int q = nwg / NXCD, r = nwg % NXCD, xcd = wgid % NXCD, off = wgid / NXCD; wgid = (xcd < r ? xcd * (q + 1) : r * (q + 1) + (xcd - r) * q) + off; }
        const int nig = WGM * nN, gid = wgid / nig, fm = gid * WGM, gsz = (nM - fm) < WGM ? (nM - fm) : WGM;
        u.pm = fm + ((wgid % nig) % gsz); u.pn = (wgid % nig) / gsz; return true;
    }
    __device__ __forceinline__ void a_ready(const Unit&) const {}
    __device__ __forceinline__ void done(const Unit&) const {}
};


typedef float f32x2_c __attribute__((ext_vector_type(2))); typedef __bf16 bf16x2_c __attribute__((ext_vector_type(2)));
__device__ __forceinline__ unsigned cvt_pk_bf16(float lo, float hi) { f32x2_c v = {lo, hi}; bf16x2_c b = __builtin_convertvector(v, bf16x2_c); return __builtin_bit_cast(unsigned, b); }

enum { TT_IDENT = 0, TT_NAT8 = 1, TT_HEAD = 2 };
__host__ __device__ __forceinline__ int tile_pos_of_logical(int tt, int L) {
    if (tt == TT_IDENT) return L;
    if (tt == TT_NAT8) { const int bj = L >> 7, wc = (L >> 5) & 3, fq = (L >> 3) & 3, n = (L >> 2) & 1, j = L & 3; return 128 * bj + 32 * wc + 16 * n + 4 * fq + j; }
    const int wc = L >> 6, d = L & 63, fqh = d >> 5, bj = (d >> 4) & 1, fql = (d >> 3) & 1, n = (d >> 2) & 1, j = d & 3;
    return 128 * bj + 32 * wc + 16 * n + 4 * (2 * fqh + fql) + j;
}
__device__ __forceinline__ float fast_sigmoid(float x) { return __builtin_amdgcn_rcpf(1.f + __builtin_amdgcn_exp2f(-1.4426950408889634f * x)); }
__device__ __forceinline__ float fast_gelu_tanh(float x) { const float u = x * (1.5957691216057308f + 0.0713548162726f * x * x); return x * __builtin_amdgcn_rcpf(1.f + __builtin_amdgcn_exp2f(-1.4426950408889634f * u)); }
template <int FN> __device__ __forceinline__ float epi_fn(float v) { if (FN == 1) return fast_gelu_tanh(v); if (FN == 2) return fast_sigmoid(v); if (FN == 3) { const float r = v > 0.f ? v : 0.f; return r * r; } return v; }
template <int FN> __device__ __forceinline__ void store_nat8(const f32x4 (&acc)[2][2][4][2], bf16_t* dst, int ld, int row0, int col0) {
#pragma unroll
    for (int ai = 0; ai < 2; ++ai)
#pragma unroll
        for (int m = 0; m < 4; ++m) { bf16_t* rowp = dst + (size_t)(row0 + ai * HALF + m * 16) * ld + col0;
#pragma unroll
            for (int bj = 0; bj < 2; ++bj) { const f32x4 v0 = acc[ai][bj][m][0], v1 = acc[ai][bj][m][1]; u32x4 w;
                w.x = cvt_pk_bf16(epi_fn<FN>(v0[0]), epi_fn<FN>(v0[1])); w.y = cvt_pk_bf16(epi_fn<FN>(v0[2]), epi_fn<FN>(v0[3]));
                w.z = cvt_pk_bf16(epi_fn<FN>(v1[0]), epi_fn<FN>(v1[1])); w.w = cvt_pk_bf16(epi_fn<FN>(v1[2]), epi_fn<FN>(v1[3]));
                *(u32x4*)(rowp + bj * HALF) = w; } }
}
template <int FN> struct EpiNat8 {
    static constexpr bool PERM = false, AFTER_DRAIN = false, RESCALE = false;
    bf16_t* dst; int ld;
    __device__ __forceinline__ void operator()(const f32x4 (&acc)[2][2][4][2], const Unit& u, int wr, int wc, int fr, int fq) const {
        store_nat8<FN>(acc, dst + u.pn * BM, ld, u.pm * BM + wr * 64 + fr, wc * 32 + 8 * fq);
    }
};
struct EpiG1 {
    static constexpr bool PERM = false, AFTER_DRAIN = false, RESCALE = false;
    bf16_t *Y, *KA, *VA, *KB, *VB, *XR, *G; const float* rope; const float* qgain; const float* kgain; int pn_off, pad_;
    __device__ __forceinline__ void operator()(const f32x4 (&acc)[2][2][4][2], const Unit& u, int wr, int wc, int fr, int fq) const {
        const int T = u.pn + pn_off, row0 = u.pm * BM + wr * 64 + fr;
        if (T >= 14) { store_nat8<2>(acc, G + (T - 14) * 256, 3072, row0, wc * 32 + 8 * fq); return; }
        if (T >= 10) { store_nat8<1>(acc, Y + 1024 + (T - 10) * 256, 2048, row0, wc * 32 + 8 * fq); return; }
        if (T >= 6) { store_nat8<0>(acc, XR + (T - 6) * 256, 1024, row0, wc * 32 + 8 * fq); return; }
        const bool isB = T >= 3; const int Tl = isB ? T - 3 : T;
        int kind; bf16_t* dst; int ld;
        if (Tl < 2) { kind = 0; dst = Y + (isB ? 512 : 0) + Tl * 256 + wc * 64; ld = 2048; }
        else if (wc < 2) { kind = 1; dst = (isB ? KB : KA) + wc * 64; ld = 128; }
        else { kind = 2; dst = (isB ? VB : VA) + (wc - 2) * 64; ld = 128; }
        const bool lat = u.pm < 64, rms = isB && kind < 2, rot = kind < 2 && lat;
        const int based = 32 * (fq >> 1) + 8 * (fq & 1);
        f32x4 gn[2][2];
#pragma unroll
        for (int bj = 0; bj < 2; ++bj)
#pragma unroll
            for (int n = 0; n < 2; ++n) { const f32x4 gq = *(const f32x4*)(qgain + based + 16 * bj + 4 * n), gk = *(const f32x4*)(kgain + based + 16 * bj + 4 * n); gn[bj][n] = kind == 0 ? gq : gk; }
        const float osc = kind == 0 ? 0.125f * 1.4426950408889634f : 1.f;
#pragma unroll
        for (int ai = 0; ai < 2; ++ai)
#pragma unroll
            for (int m = 0; m < 4; ++m) {
                const int row = row0 + ai * HALF + m * 16;
                f32x4 v[2][2];
#pragma unroll
                for (int bj = 0; bj < 2; ++bj)
#pragma unroll
                    for (int n = 0; n < 2; ++n) v[bj][n] = acc[ai][bj][m][n];
                if (rms) {
                    float ss = 0.f;
#pragma unroll
                    for (int bj = 0; bj < 2; ++bj)
#pragma unroll
                        for (int n = 0; n < 2; ++n) { const f32x4 x = v[bj][n]; ss += (x[0] * x[0] + x[1] * x[1]) + (x[2] * x[2] + x[3] * x[3]); }
                    { const int ln = fr + 16 * fq;
                      ss += __int_as_float(__builtin_amdgcn_ds_bpermute((ln ^ 16) << 2, __float_as_int(ss))); ss += __int_as_float(__builtin_amdgcn_ds_bpermute((ln ^ 32) << 2, __float_as_int(ss))); }
                    const float r = __builtin_amdgcn_rsqf(ss * (1.f / 64.f) + 1e-6f);
#pragma unroll
                    for (int bj = 0; bj < 2; ++bj)
#pragma unroll
                        for (int n = 0; n < 2; ++n) v[bj][n] = v[bj][n] * r * gn[bj][n];
                }
                if (rot) {
                    const int t = row & 4095, pos = (fq >> 1) ? (t & 63) : (t >> 6); const float* cp = rope + pos * 16 + 8 * (fq & 1);
#pragma unroll
                    for (int n = 0; n < 2; ++n) { const f32x4 c = *(const f32x4*)(cp + 4 * n), s = *(const f32x4*)(cp + 1024 + 4 * n); const f32x4 x1 = v[0][n], x2 = v[1][n];
                        v[0][n] = x1 * c - x2 * s; v[1][n] = x1 * s + x2 * c; }
                }
                bf16_t* rowp = dst + (size_t)row * ld + based;
#pragma unroll
                for (int bj = 0; bj < 2; ++bj) { const f32x4 v0 = v[bj][0] * osc, v1 = v[bj][1] * osc; u32x4 w;
                    w.x = cvt_pk_bf16(v0[0], v0[1]); w.y = cvt_pk_bf16(v0[2], v0[3]); w.z = cvt_pk_bf16(v1[0], v1[1]); w.w = cvt_pk_bf16(v1[2], v1[3]);
                    *(u32x4*)(rowp + 16 * bj) = w; }
            }
    }
};
struct EpiMerge {
    static constexpr bool PERM = false, AFTER_DRAIN = false, RESCALE = true;
    const bf16_t* G; bf16_t* Mo;
    __device__ __forceinline__ static void unpack8(const u32x4 w, float (&f)[8]) {
        f[0] = __uint_as_float(w.x << 16); f[1] = __uint_as_float(w.x & 0xffff0000u); f[2] = __uint_as_float(w.y << 16); f[3] = __uint_as_float(w.y & 0xffff0000u);
        f[4] = __uint_as_float(w.z << 16); f[5] = __uint_as_float(w.z & 0xffff0000u); f[6] = __uint_as_float(w.w << 16); f[7] = __uint_as_float(w.w & 0xffff0000u);
    }
    __device__ __forceinline__ void rescale(f32x4 (&acc)[2][2][4][2], const Unit& u, int t, int wr, int wc, int fr, int fq) const {
        const int s = t == 8 ? 0 : 1; int row0 = u.pm * BM + wr * 64 + fr, col0 = u.pn * BM + wc * 32 + 8 * fq;
        asm volatile("" : "+v"(row0), "+v"(col0));
#pragma unroll
        for (int ai = 0; ai < 2; ++ai)
#pragma unroll
            for (int m = 0; m < 4; ++m) { const bf16_t* gp = G + (size_t)(row0 + ai * HALF + m * 16) * 3072 + s * 1024 + col0;
#pragma unroll
                for (int bj = 0; bj < 2; ++bj) { float a[8], b[8]; unpack8(*(const u32x4*)(gp + bj * HALF), a); unpack8(*(const u32x4*)(gp + 1024 + bj * HALF), b);
                    f32x4 f0, f1;
#pragma unroll
                    for (int j = 0; j < 4; ++j) { f0[j] = fmaxf(a[j], 1e-20f) * __builtin_amdgcn_rcpf(fmaxf(b[j], 1e-20f)); f1[j] = fmaxf(a[4 + j], 1e-20f) * __builtin_amdgcn_rcpf(fmaxf(b[4 + j], 1e-20f)); }
                    if (s == 0) {
#pragma unroll
                        for (int j = 0; j < 4; ++j) { f0[j] = a[j] * __builtin_amdgcn_rcpf(fmaxf(b[j], 1e-20f)); f1[j] = a[4 + j] * __builtin_amdgcn_rcpf(fmaxf(b[4 + j], 1e-20f)); } }
                    acc[ai][bj][m][0] *= f0; acc[ai][bj][m][1] *= f1; }
                asm volatile("" ::: "memory"); }
    }
    __device__ __forceinline__ void operator()(const f32x4 (&acc)[2][2][4][2], const Unit& u, int wr, int wc, int fr, int fq) const {
        const int row0 = u.pm * BM + wr * 64 + fr, col0 = u.pn * BM + wc * 32 + 8 * fq;
#pragma unroll
        for (int ai = 0; ai < 2; ++ai)
#pragma unroll
            for (int m = 0; m < 4; ++m) { const size_t ro = (size_t)(row0 + ai * HALF + m * 16);
#pragma unroll
                for (int bj = 0; bj < 2; ++bj) { float c[8]; unpack8(*(const u32x4*)(G + ro * 3072 + 2048 + col0 + bj * HALF), c);
                    const f32x4 v0 = acc[ai][bj][m][0], v1 = acc[ai][bj][m][1]; u32x4 w;
                    w.x = cvt_pk_bf16(v0[0] * fmaxf(c[0], 1e-20f), v0[1] * fmaxf(c[1], 1e-20f)); w.y = cvt_pk_bf16(v0[2] * fmaxf(c[2], 1e-20f), v0[3] * fmaxf(c[3], 1e-20f));
                    w.z = cvt_pk_bf16(v1[0] * fmaxf(c[4], 1e-20f), v1[1] * fmaxf(c[5], 1e-20f)); w.w = cvt_pk_bf16(v1[2] * fmaxf(c[6], 1e-20f), v1[3] * fmaxf(c[7], 1e-20f));
                    *(u32x4*)(Mo + ro * 1024 + col0 + bj * HALF) = w; } }
    }
};
struct EpiResid {
    static constexpr bool PERM = false, AFTER_DRAIN = false, RESCALE = false;
    const float* base_lat; const float* base_ctx; float* out_lat; float* out_ctx; const float* mod; int gate_off, pad_;
    __device__ __forceinline__ void operator()(const f32x4 (&acc)[2][2][4][2], const Unit& u, int wr, int wc, int fr, int fq) const {
        const bool lat = u.pm < 64; const float* base = lat ? base_lat : base_ctx; float* out = lat ? out_lat : out_ctx;
        const int rowt = (lat ? u.pm : u.pm - 64) * BM + wr * 64 + fr, col0 = u.pn * BM + wc * 32 + 4 * fq;
        const float* gp = mod + (size_t)(lat ? (u.pm >> 4) : 4) * 6144 + gate_off + col0;
        f32x4 gv[2][2];
#pragma unroll
        for (int bj = 0; bj < 2; ++bj)
#pragma unroll
            for (int n = 0; n < 2; ++n) gv[bj][n] = *(const f32x4*)(gp + bj * HALF + n * 16);
#pragma unroll
        for (int ai = 0; ai < 2; ++ai)
#pragma unroll
            for (int m = 0; m < 4; ++m) { const size_t off = (size_t)(rowt + ai * HALF + m * 16) * 1024 + col0;
#pragma unroll
                for (int bj = 0; bj < 2; ++bj)
#pragma unroll
                    for (int n = 0; n < 2; ++n) { const f32x4 b = *(const f32x4*)(base + off + bj * HALF + n * 16);
                        *(f32x4*)(out + off + bj * HALF + n * 16) = b * 1.41421356237309515f + gv[bj][n] * acc[ai][bj][m][n]; } }
    }
};

template <class Epi, class Sched, bool ALIGN_EPI = false, bool SP2 = false>
__device__ __forceinline__ void gemm_phase(PG8_LAS unsigned char* lds, const Gemm g, const Sched& S, const Epi& E, int tid_in) {
    int tid_ = tid_in; asm volatile("" : "+v"(tid_));
    const int tid = tid_, wid = __builtin_amdgcn_readfirstlane(tid >> 6), lane = tid & 63, wr = wid >> 2, wc = wid & 3, fr = lane & 15, fq = lane >> 4;
    const int K = g.K, nt = K / BK;
    unsigned voffA[2], voffB[2];
#pragma unroll
    for (int i = 0; i < 2; ++i) { int R, C; stage_rc(tid * 16 + i * 8192, R, C); const int Rb = Epi::PERM ? ((R & ~31) + perm32(R & 31)) : R;
        voffA[i] = (unsigned)(R * K + C) * 2u; voffB[i] = (unsigned)(Rb * K + C) * 2u; }
    const size_t kstep = (size_t)(BK * 2);
    const size_t hstep = (size_t)HALF * K * 2;
    const size_t tstep = 2 * hstep;
    const unsigned ldsw = (unsigned)wid * 1024u;
    const int aoff = lds_byte(wr * 64 + fr, fq * 8), boff = lds_byte(wc * 32 + fr, fq * 8);
#define PG8_SA(b, h) (((b) * 2 + (h)) * HTB)
#define PG8_SB(b, h) ((4 + (b) * 2 + (h)) * HTB)
#define PG8_STAGE(bufoff, gbase, voff) do { _Pragma("unroll") for (int _i = 0; _i < 2; ++_i) \
        __builtin_amdgcn_global_load_lds((const unsigned*)((const char*)(gbase) + (voff)[_i]), (PG8_LAS unsigned*)(lds + (bufoff) + ldsw + _i * 8192), 16, 0, 0); } while (0)
#define PG8_LDA(dst, b, h) do { _Pragma("unroll") for (int m = 0; m < 4; ++m) _Pragma("unroll") for (int k = 0; k < 2; ++k) dst[m][k] = *(const PG8_LAS bf16x8*)(lds + PG8_SA(b, h) + aoff + m * 2048 + k * 1024); } while (0)
#define PG8_LDB(dst, b, h) do { _Pragma("unroll") for (int n = 0; n < 2; ++n) _Pragma("unroll") for (int k = 0; k < 2; ++k) dst[n][k] = *(const PG8_LAS bf16x8*)(lds + PG8_SB(b, h) + boff + n * 2048 + k * 1024); } while (0)
#define PG8_MMA(ai, bj, At, Bt) do { __builtin_amdgcn_s_setprio(1); _Pragma("unroll") for (int m = 0; m < 4; ++m) _Pragma("unroll") for (int n = 0; n < 2; ++n) _Pragma("unroll") for (int k = 0; k < 2; ++k) \
        acc[ai][bj][m][n] = __builtin_amdgcn_mfma_f32_16x16x32_bf16(Bt[n][k], At[m][k], acc[ai][bj][m][n], 0, 0, 0); __builtin_amdgcn_s_setprio(0); } while (0)
#define PG8_WAIT_V(n) asm volatile("s_waitcnt vmcnt(" #n ")" ::: "memory")
#define PG8_WAIT_L(n) asm volatile("s_waitcnt lgkmcnt(" #n ")" ::: "memory")
#define PG8_BAR __builtin_amdgcn_s_barrier()
#define PG8_SCHED __builtin_amdgcn_sched_barrier(0)
    Unit cur, nxt; int ui = 0;
    if (!S.next(0, cur)) return;
    f32x4 acc[2][2][4][2];
#pragma unroll
    for (int a = 0; a < 2; ++a)
#pragma unroll
        for (int b = 0; b < 2; ++b)
#pragma unroll
            for (int m = 0; m < 4; ++m)
#pragma unroll
                for (int n = 0; n < 2; ++n) acc[a][b][m][n] = (f32x4){0.f, 0.f, 0.f, 0.f};
    bf16x8 At[4][2], B0[2][2], B1[2][2];
    const char* cA = (const char*)g.A + (size_t)cur.pm * tstep; const char* cB = (const char*)g.Bt + (size_t)cur.pn * tstep;
    S.a_ready(cur);
    if constexpr (SP2) {
        PG8_STAGE(PG8_SB(0, 0), cB, voffB); PG8_STAGE(PG8_SB(0, 1), cB + hstep, voffB); PG8_STAGE(PG8_SA(0, 0), cA, voffA); PG8_STAGE(PG8_SA(0, 1), cA + hstep, voffA);
        if (wr == 1) PG8_BAR;
        PG8_WAIT_V(2); PG8_BAR;
        PG8_STAGE(PG8_SB(1, 0), cB + kstep, voffB); PG8_STAGE(PG8_SA(1, 0), cA + kstep, voffA); PG8_STAGE(PG8_SB(1, 1), cB + hstep + kstep, voffB);
        PG8_WAIT_V(6); PG8_BAR;
    } else {
        PG8_STAGE(PG8_SB(0, 0), cB, voffB); PG8_STAGE(PG8_SA(0, 0), cA, voffA); PG8_STAGE(PG8_SB(0, 1), cB + hstep, voffB); PG8_STAGE(PG8_SA(0, 1), cA + hstep, voffA);
        if (wr == 1) PG8_BAR;
        PG8_WAIT_V(4); PG8_BAR;
        PG8_STAGE(PG8_SB(1, 0), cB + kstep, voffB); PG8_STAGE(PG8_SA(1, 0), cA + kstep, voffA); PG8_STAGE(PG8_SB(1, 1), cB + hstep + kstep, voffB);
        PG8_WAIT_V(6); PG8_BAR;
    }
    for (;;) {
        const bool has_next = S.next(ui + 1, nxt);
        const char* nA = has_next ? (const char*)g.A + (size_t)nxt.pm * tstep : cA; const char* nB = has_next ? (const char*)g.Bt + (size_t)nxt.pn * tstep : cB;
        for (int t = 0; t < nt; t += 2) {
            if constexpr (Epi::RESCALE) { if (t == 8 || t == 16) E.rescale(acc, cur, t, wr, wc, fr, fq); }
            const bool last = (t == nt - 2);
            const char* a1 = cA + (size_t)(t + 1) * kstep;
            const char* a2 = last ? nA : cA + (size_t)(t + 2) * kstep; const char* b2 = last ? nB : cB + (size_t)(t + 2) * kstep;
            const char* a3 = a2 + kstep; const char* b3 = b2 + kstep;
            if (last && has_next) S.a_ready(nxt);
            if constexpr (SP2) {
            PG8_LDB(B0, 0, 0); PG8_LDB(B1, 0, 1); PG8_SCHED; PG8_LDA(At, 0, 0); PG8_STAGE(PG8_SA(1, 1), a1 + hstep, voffA);
            PG8_WAIT_V(8); PG8_WAIT_L(0); PG8_BAR; PG8_MMA(0, 0, At, B0); PG8_MMA(0, 1, At, B1); PG8_BAR; PG8_SCHED;
            PG8_LDA(At, 0, 1); PG8_STAGE(PG8_SB(0, 0), b2, voffB); PG8_STAGE(PG8_SB(0, 1), b2 + hstep, voffB); PG8_STAGE(PG8_SA(0, 0), a2, voffA);
            PG8_WAIT_V(8); PG8_WAIT_L(0); PG8_BAR; PG8_MMA(1, 0, At, B0); PG8_MMA(1, 1, At, B1); PG8_BAR; PG8_SCHED;
            PG8_LDB(B0, 1, 0); PG8_LDB(B1, 1, 1); PG8_SCHED; PG8_LDA(At, 1, 0); PG8_STAGE(PG8_SA(0, 1), a2 + hstep, voffA);
            PG8_WAIT_V(8); PG8_WAIT_L(0); PG8_BAR; PG8_MMA(0, 0, At, B0); PG8_MMA(0, 1, At, B1); PG8_BAR; PG8_SCHED;
            PG8_LDA(At, 1, 1); PG8_STAGE(PG8_SB(1, 0), b3, voffB); PG8_STAGE(PG8_SB(1, 1), b3 + hstep, voffB); PG8_STAGE(PG8_SA(1, 0), a3, voffA);
            PG8_WAIT_V(8); PG8_WAIT_L(0); PG8_BAR; PG8_MMA(1, 0, At, B0); PG8_MMA(1, 1, At, B1); PG8_BAR; PG8_SCHED;
            } else {
            PG8_LDB(B0, 0, 0); PG8_SCHED; PG8_LDA(At, 0, 0); PG8_STAGE(PG8_SA(1, 1), a1 + hstep, voffA);
            PG8_WAIT_L(8); PG8_BAR; PG8_WAIT_L(0); PG8_MMA(0, 0, At, B0); PG8_BAR; PG8_SCHED;
            PG8_LDB(B1, 0, 1); PG8_STAGE(PG8_SB(0, 0), b2, voffB);
            PG8_BAR; PG8_WAIT_L(0); PG8_MMA(0, 1, At, B1); PG8_BAR;
            PG8_LDA(At, 0, 1); PG8_STAGE(PG8_SA(0, 0), a2, voffA);
            PG8_BAR; PG8_WAIT_L(0); PG8_MMA(1, 0, At, B0); PG8_BAR; PG8_SCHED;
            PG8_STAGE(PG8_SB(0, 1), b2 + hstep, voffB);
            PG8_WAIT_V(6); PG8_BAR; PG8_MMA(1, 1, At, B1); PG8_BAR;
            PG8_LDB(B0, 1, 0); PG8_SCHED; PG8_LDA(At, 1, 0); PG8_STAGE(PG8_SA(0, 1), a2 + hstep, voffA);
            PG8_WAIT_L(8); PG8_BAR; PG8_WAIT_L(0); PG8_MMA(0, 0, At, B0); PG8_BAR; PG8_SCHED;
            PG8_LDB(B1, 1, 1); PG8_STAGE(PG8_SB(1, 0), b3, voffB);
            PG8_BAR; PG8_WAIT_L(0); PG8_MMA(0, 1, At, B1); PG8_BAR;
            PG8_LDA(At, 1, 1); PG8_STAGE(PG8_SA(1, 0), a3, voffA);
            PG8_BAR; PG8_WAIT_L(0); PG8_MMA(1, 0, At, B0); PG8_BAR; PG8_SCHED;
            PG8_STAGE(PG8_SB(1, 1), b3 + hstep, voffB);
            PG8_WAIT_V(6); PG8_BAR; PG8_MMA(1, 1, At, B1); PG8_BAR;
            }
        }
        if constexpr (ALIGN_EPI) { if (wr == 0) PG8_BAR; }
        if constexpr (!Epi::AFTER_DRAIN) { E(acc, cur, wr, wc, fr, fq); S.done(cur); }
        if (!has_next) break;
#pragma unroll
        for (int a = 0; a < 2; ++a)
#pragma unroll
            for (int b = 0; b < 2; ++b)
#pragma unroll
                for (int m = 0; m < 4; ++m)
#pragma unroll
                    for (int n = 0; n < 2; ++n) acc[a][b][m][n] = (f32x4){0.f, 0.f, 0.f, 0.f};
        cur = nxt; cA = nA; cB = nB; ++ui;
        if constexpr (ALIGN_EPI) { if (wr == 1) PG8_BAR; }
    }
    PG8_WAIT_V(0);
    if constexpr (!ALIGN_EPI) { if (wr == 0) PG8_BAR; }
    PG8_BAR;
    if constexpr (Epi::AFTER_DRAIN) { E.fused(acc, cur, wr, wc, fr, fq, lds, wid, lane); S.done(cur); }
#undef PG8_SA
#undef PG8_SB
#undef PG8_STAGE
#undef PG8_LDA
#undef PG8_LDB
#undef PG8_MMA
#undef PG8_WAIT_V
#undef PG8_WAIT_L
#undef PG8_BAR
#undef PG8_SCHED
}
}

namespace cg {
using pg8::bf16_t; using pg8::bf16x8; using pg8::f32x4; using pg8::u32x4;
constexpr int TM = 64, TN = 128, ABYTES = 8192, BBYTES = 16384, STG = ABYTES + BBYTES;
struct Ctx { PG8_LAS unsigned char* lds; int wid, lane, fr, fq, wm, wn; unsigned voffA, voffB[2], ldsw; int aoff, boff; };
__device__ __forceinline__ void init(Ctx& c, PG8_LAS unsigned char* lds, int lda, int ldb, int tid_in) {
    int tid_ = tid_in; asm volatile("" : "+v"(tid_));
    c.lds = lds; c.wid = __builtin_amdgcn_readfirstlane(tid_ >> 6); c.lane = tid_ & 63; c.fr = c.lane & 15; c.fq = c.lane >> 4; c.wm = c.wid >> 2; c.wn = c.wid & 3;
    int R, C; pg8::stage_rc(tid_ * 16, R, C); c.voffA = (unsigned)(R * lda + C) * 2u; c.voffB[0] = (unsigned)(R * ldb + C) * 2u;
    pg8::stage_rc(tid_ * 16 + 8192, R, C); c.voffB[1] = (unsigned)(R * ldb + C) * 2u;
    c.ldsw = (unsigned)c.wid * 1024u;
    c.aoff = pg8::lds_byte(c.wm * 32 + c.fr, c.fq * 8); c.boff = ABYTES + pg8::lds_byte(c.wn * 32 + c.fr, c.fq * 8);
}
__device__ __forceinline__ void kloop(const Ctx& c, f32x4 (&acc)[2][2], const bf16_t* Ag, const bf16_t* Bg, int K) {
    const int nt = K / 64;
#define CG_STAGE(s, kt) do { const char* ga_ = (const char*)Ag + (size_t)(kt) * 128; const char* gb_ = (const char*)Bg + (size_t)(kt) * 128; \
        __builtin_amdgcn_global_load_lds((const unsigned*)(ga_ + c.voffA), (PG8_LAS unsigned*)(c.lds + (s) * STG + c.ldsw), 16, 0, 0); \
        __builtin_amdgcn_global_load_lds((const unsigned*)(gb_ + c.voffB[0]), (PG8_LAS unsigned*)(c.lds + (s) * STG + ABYTES + c.ldsw), 16, 0, 0); \
        __builtin_amdgcn_global_load_lds((const unsigned*)(gb_ + c.voffB[1]), (PG8_LAS unsigned*)(c.lds + (s) * STG + ABYTES + 8192 + c.ldsw), 16, 0, 0); } while (0)
    CG_STAGE(0, 0);
    for (int t = 0; t < nt; ++t) {
        const int s = t & 1;
        if (t + 1 < nt) { CG_STAGE(s ^ 1, t + 1); asm volatile("s_waitcnt vmcnt(3)" ::: "memory"); } else { asm volatile("s_waitcnt vmcnt(0)" ::: "memory"); }
        __builtin_amdgcn_s_barrier(); asm volatile("" ::: "memory");
        bf16x8 Af[2][2], Bf[2][2];
#pragma unroll
        for (int m = 0; m < 2; ++m)
#pragma unroll
            for (int k = 0; k < 2; ++k) { Af[m][k] = *(const PG8_LAS bf16x8*)(c.lds + s * STG + c.aoff + m * 2048 + k * 1024); Bf[m][k] = *(const PG8_LAS bf16x8*)(c.lds + s * STG + c.boff + m * 2048 + k * 1024); }
#pragma unroll
        for (int m = 0; m < 2; ++m)
#pragma unroll
            for (int n = 0; n < 2; ++n)
#pragma unroll
                for (int k = 0; k < 2; ++k) acc[m][n] = __builtin_amdgcn_mfma_f32_16x16x32_bf16(Bf[n][k], Af[m][k], acc[m][n], 0, 0, 0);
        asm volatile("s_waitcnt lgkmcnt(0)" ::: "memory"); __builtin_amdgcn_s_barrier(); asm volatile("" ::: "memory");
    }
#undef CG_STAGE
}
__device__ __forceinline__ void zero(f32x4 (&acc)[2][2]) {
#pragma unroll
    for (int m = 0; m < 2; ++m)
#pragma unroll
        for (int n = 0; n < 2; ++n) acc[m][n] = (f32x4){0.f, 0.f, 0.f, 0.f};
}
template <int FN> __device__ __forceinline__ void store_nat8(const Ctx& c, const f32x4 (&acc)[2][2], bf16_t* dst  , int ld) {
#pragma unroll
    for (int m = 0; m < 2; ++m) { const f32x4 v0 = acc[m][0], v1 = acc[m][1]; u32x4 w;
        w.x = pg8::cvt_pk_bf16(pg8::epi_fn<FN>(v0[0]), pg8::epi_fn<FN>(v0[1])); w.y = pg8::cvt_pk_bf16(pg8::epi_fn<FN>(v0[2]), pg8::epi_fn<FN>(v0[3]));
        w.z = pg8::cvt_pk_bf16(pg8::epi_fn<FN>(v1[0]), pg8::epi_fn<FN>(v1[1])); w.w = pg8::cvt_pk_bf16(pg8::epi_fn<FN>(v1[2]), pg8::epi_fn<FN>(v1[3]));
        *(u32x4*)(dst + (size_t)(c.wm * 32 + m * 16 + c.fr) * ld + c.wn * 32 + 8 * c.fq) = w; }
}
template <int FN, bool RESID> __device__ __forceinline__ void gemm_ctx(PG8_LAS unsigned char* lds, const bf16_t* A, int lda, const bf16_t* Bt, int ldb, int N, int K, int vcu, int G,
                                                                       bf16_t* dst, int ld, const float* base, float* out, const float* gate  , int tid_in) {
    Ctx c; init(c, lds, lda, ldb, tid_in);
    const int ntn = N / TN, nunits = (NCTX / TM) * ntn;
    for (int u = vcu; u < nunits; u += G) {
        const int tm = u / ntn, tn = u % ntn;
        f32x4 acc[2][2]; zero(acc);
        kloop(c, acc, A + (size_t)tm * TM * lda, Bt + (size_t)tn * TN * ldb, K);
        if (!RESID) store_nat8<FN>(c, acc, dst + (size_t)tm * TM * ld + tn * TN, ld);
        else {
#pragma unroll
            for (int m = 0; m < 2; ++m)
#pragma unroll
                for (int n = 0; n < 2; ++n) { const int row = tm * TM + c.wm * 32 + m * 16 + c.fr, col = tn * TN + c.wn * 32 + 16 * n + 4 * c.fq; const size_t off = (size_t)row * 1024 + col;
                    *(f32x4*)(out + off) = *(const f32x4*)(base + off) * 1.41421356237309515f + *(const f32x4*)(gate + col) * acc[m][n]; }
        }
    }
}
__device__ __forceinline__ void merge_ctx(PG8_LAS unsigned char* lds, const bf16_t* Yc, const bf16_t* Wm, const bf16_t* Gc, bf16_t* Mo, int vcu, int G, int tid_in) {
    Ctx c; init(c, lds, 2048, 2048, tid_in);
    const int ntn = 1024 / TN, nunits = (NCTX / TM) * ntn;
    for (int u = vcu; u < nunits; u += G) {
        const int tm = u / ntn, tn = u % ntn;
        f32x4 tot[2][2]; zero(tot);
#pragma unroll
        for (int s = 0; s < 3; ++s) {
            f32x4 acc[2][2]; zero(acc);
            const int k0 = s == 0 ? 0 : s == 1 ? 512 : 1024, kl = s == 2 ? 1024 : 512;
            kloop(c, acc, Yc + (size_t)tm * TM * 2048 + k0, Wm + (size_t)tn * TN * 2048 + k0, kl);
#pragma unroll
            for (int m = 0; m < 2; ++m) { const u32x4 g = *(const u32x4*)(Gc + (size_t)(tm * TM + c.wm * 32 + m * 16 + c.fr) * 3072 + s * 1024 + tn * TN + c.wn * 32 + 8 * c.fq);
                const f32x4 g0 = {__uint_as_float(g.x << 16), __uint_as_float(g.x & 0xffff0000u), __uint_as_float(g.y << 16), __uint_as_float(g.y & 0xffff0000u)};
                const f32x4 g1 = {__uint_as_float(g.z << 16), __uint_as_float(g.z & 0xffff0000u), __uint_as_float(g.w << 16), __uint_as_float(g.w & 0xffff0000u)};
                tot[m][0] += g0 * acc[m][0]; tot[m][1] += g1 * acc[m][1]; }
        }
        store_nat8<0>(c, tot, Mo + (size_t)tm * TM * 1024 + tn * TN, 1024);
    }
}
}

namespace lru {
#define LAS __attribute__((address_space(3)))
typedef short bf16x8 __attribute__((ext_vector_type(8)));
typedef float f32x4 __attribute__((ext_vector_type(4)));
typedef unsigned u32x4 __attribute__((ext_vector_type(4)));
constexpr int NCH = 68;
template <int CTRL> __device__ __forceinline__ float dpp(float oldv, float src) {
    return __int_as_float(__builtin_amdgcn_update_dpp(__float_as_int(oldv), __float_as_int(src), CTRL, 0xf, 0xf, false));
}
__device__ __forceinline__ float bfe(const bf16x8& v, int j) { return __uint_as_float(((unsigned)(unsigned short)v[j]) << 16); }
__device__ __forceinline__ float sigm(float x) { return __builtin_amdgcn_rcpf(1.f + __builtin_amdgcn_exp2f(-1.4426950408889634f * x)); }
template <int DIR> __device__ __forceinline__ void row_scan(float (&TA)[8], float (&TU)[8]) {
#define LRU_STEP(D) { _Pragma("unroll") for (int j = 0; j < 8; ++j) { const float pA = dpp<(DIR ? 0x100 : 0x110) | D>(1.f, TA[j]), pU = dpp<(DIR ? 0x100 : 0x110) | D>(0.f, TU[j]); TU[j] = TA[j] * pU + TU[j]; TA[j] = TA[j] * pA; } }
    LRU_STEP(1) LRU_STEP(2) LRU_STEP(4) LRU_STEP(8)
#undef LRU_STEP
}
struct Params { const bf16* XR; const float* convw; const float* convb; const bf16* Wg; const float* br; const float* bi; const float* c2; float* agg; bf16* Y; };

template <int PASS> __device__ __forceinline__ void item(const Params& P, int b, int c, int blk, int lane, LAS f32x4* hfl  ) {
    const int fr = lane & 15, fq = lane >> 4;
    const bool isctx = c < 4; const int L = isctx ? CTXL : SEQ, t0 = (isctx ? c : c - 4) * 64 + 4 * fr, rbase = isctx ? NLAT + b * CTXL : b * SEQ;
    bf16x8 Af[4][2];
#pragma unroll
    for (int ks = 0; ks < 2; ++ks) {
        const int ch0 = blk * 64 + 32 * ks + 8 * fq;
        float xr[7][8];
#pragma unroll
        for (int i = 0; i < 7; ++i) { const int t = t0 - 1 + i; u32x4 w = (u32x4){0u, 0u, 0u, 0u};
            if (t >= 0 && t < L) w = *(const u32x4*)(P.XR + (size_t)(rbase + t) * DM + ch0);
            xr[i][0] = __uint_as_float(w.x << 16); xr[i][1] = __uint_as_float(w.x & 0xffff0000u); xr[i][2] = __uint_as_float(w.y << 16); xr[i][3] = __uint_as_float(w.y & 0xffff0000u);
            xr[i][4] = __uint_as_float(w.z << 16); xr[i][5] = __uint_as_float(w.z & 0xffff0000u); xr[i][6] = __uint_as_float(w.w << 16); xr[i][7] = __uint_as_float(w.w & 0xffff0000u); }
        float o[4][8];
        { const f32x4 b0 = *(const f32x4*)(P.convb + ch0), b1 = *(const f32x4*)(P.convb + ch0 + 4);
#pragma unroll
          for (int m = 0; m < 4; ++m) { o[m][0] = b0[0]; o[m][1] = b0[1]; o[m][2] = b0[2]; o[m][3] = b0[3]; o[m][4] = b1[0]; o[m][5] = b1[1]; o[m][6] = b1[2]; o[m][7] = b1[3]; } }
#pragma unroll
        for (int k = 0; k < 4; ++k) { const f32x4 w0 = *(const f32x4*)(P.convw + k * DM + ch0), w1 = *(const f32x4*)(P.convw + k * DM + ch0 + 4);
#pragma unroll
            for (int m = 0; m < 4; ++m) {
#pragma unroll
                for (int j = 0; j < 4; ++j) { o[m][j] += w0[j] * xr[m + k][j]; o[m][4 + j] += w1[j] * xr[m + k][4 + j]; } } }
#pragma unroll
        for (int m = 0; m < 4; ++m) { u32x4 w; w.x = pg8::cvt_pk_bf16(o[m][0], o[m][1]); w.y = pg8::cvt_pk_bf16(o[m][2], o[m][3]); w.z = pg8::cvt_pk_bf16(o[m][4], o[m][5]); w.w = pg8::cvt_pk_bf16(o[m][6], o[m][7]);
            Af[m][ks] = __builtin_bit_cast(bf16x8, w); }
    }
#pragma unroll
    for (int p = 0; p < 2; ++p) {
        const int chp = blk * 64 + 32 * p + 8 * fq;
#pragma unroll
        for (int dir = 0; dir < 2; ++dir) {
            float hinv[8];
            if (PASS == 2) {
                const int pos = dir == 0 ? c : (c < 4 ? 3 - c : 71 - c);
                float CA[8], CU[8];
#pragma unroll
                for (int j = 0; j < 8; ++j) { CA[j] = 1.f; CU[j] = 0.f; }
                for (int i = 5 * fr; i < 5 * fr + 5 && i < pos; ++i) {
                    const int cid = dir == 0 ? i : (i < 4 ? 3 - i : 71 - i);
                    const float* ap = P.agg + ((size_t)((dir * BATCH + b) * NCH + cid)) * 2048 + chp;
                    const f32x4 p0 = *(const f32x4*)(ap), p1 = *(const f32x4*)(ap + 4), s0 = *(const f32x4*)(ap + 1024), s1 = *(const f32x4*)(ap + 1028);
#pragma unroll
                    for (int j = 0; j < 4; ++j) { CU[j] = p0[j] * CU[j] + s0[j]; CA[j] = p0[j] * CA[j]; CU[4 + j] = p1[j] * CU[4 + j] + s1[j]; CA[4 + j] = p1[j] * CA[4 + j]; }
                }
                row_scan<0>(CA, CU);
#pragma unroll
                for (int j = 0; j < 8; ++j) hinv[j] = __int_as_float(__builtin_amdgcn_ds_bpermute(((lane & 48) | 15) << 2, __float_as_int(CU[j])));
            }
            f32x4 aR[4][2], aI[4][2];
#pragma unroll
            for (int nn = 0; nn < 2; ++nn) { const f32x4 vr = *(const f32x4*)(P.br + dir * DM + chp + 4 * nn), vi = *(const f32x4*)(P.bi + dir * DM + chp + 4 * nn);
#pragma unroll
                for (int m = 0; m < 4; ++m) { aR[m][nn] = vr; aI[m][nn] = vi; } }
#pragma unroll
            for (int gate = 0; gate < 2; ++gate) {
                bf16x8 Bf[2][2];
#pragma unroll
                for (int nn = 0; nn < 2; ++nn)
#pragma unroll
                    for (int ks = 0; ks < 2; ++ks) Bf[nn][ks] = *(const bf16x8*)(P.Wg + ((size_t)(((dir * 2 + gate) * 16 + blk) * 64 + 16 * (2 * p + nn) + fr)) * 64 + 32 * ks + 8 * fq);
#pragma unroll
                for (int m = 0; m < 4; ++m)
#pragma unroll
                    for (int nn = 0; nn < 2; ++nn)
#pragma unroll
                        for (int ks = 0; ks < 2; ++ks) { if (gate == 0) aR[m][nn] = __builtin_amdgcn_mfma_f32_16x16x32_bf16(Bf[nn][ks], Af[m][ks], aR[m][nn], 0, 0, 0);
                                                         else aI[m][nn] = __builtin_amdgcn_mfma_f32_16x16x32_bf16(Bf[nn][ks], Af[m][ks], aI[m][nn], 0, 0, 0); }
            }
            float c2v[8]; { const f32x4 x0 = *(const f32x4*)(P.c2 + dir * DM + chp), x1 = *(const f32x4*)(P.c2 + dir * DM + chp + 4); c2v[0] = x0[0]; c2v[1] = x0[1]; c2v[2] = x0[2]; c2v[3] = x0[3]; c2v[4] = x1[0]; c2v[5] = x1[1]; c2v[6] = x1[2]; c2v[7] = x1[3]; }
            float A[4][8], U[4][8];
#pragma unroll
            for (int m = 0; m < 4; ++m)
#pragma unroll
                for (int j = 0; j < 8; ++j) { const float rr = sigm(aR[m][j >> 2][j & 3]), ii = sigm(aI[m][j >> 2][j & 3]); const float av = __builtin_amdgcn_exp2f(rr * c2v[j]);
                    A[m][j] = av; U[m][j] = __builtin_amdgcn_sqrtf(fmaxf(1.f - av * av, 0.f)) * (ii * bfe(Af[m][p], j)); }
            if (dir == 0) {
#pragma unroll
                for (int m = 1; m < 4; ++m)
#pragma unroll
                    for (int j = 0; j < 8; ++j) { U[m][j] = A[m][j] * U[m - 1][j] + U[m][j]; A[m][j] = A[m][j] * A[m - 1][j]; }
            } else {
#pragma unroll
                for (int m = 2; m >= 0; --m)
#pragma unroll
                    for (int j = 0; j < 8; ++j) { U[m][j] = A[m][j] * U[m + 1][j] + U[m][j]; A[m][j] = A[m][j] * A[m + 1][j]; }
            }
            float TA[8], TU[8];
#pragma unroll
            for (int j = 0; j < 8; ++j) { TA[j] = A[dir ? 0 : 3][j]; TU[j] = U[dir ? 0 : 3][j]; }
            if (dir == 0) row_scan<0>(TA, TU); else row_scan<1>(TA, TU);
            if (PASS == 1) {
                if (fr == (dir ? 0 : 15)) { float* ap = P.agg + ((size_t)((dir * BATCH + b) * NCH + c)) * 2048 + chp;
                    *(f32x4*)(ap) = (f32x4){TA[0], TA[1], TA[2], TA[3]}; *(f32x4*)(ap + 4) = (f32x4){TA[4], TA[5], TA[6], TA[7]};
                    *(f32x4*)(ap + 1024) = (f32x4){TU[0], TU[1], TU[2], TU[3]}; *(f32x4*)(ap + 1028) = (f32x4){TU[4], TU[5], TU[6], TU[7]}; }
            } else {
                float s[8];
#pragma unroll
                for (int j = 0; j < 8; ++j) { const float hin = hinv[j];
                    const float EA = dir == 0 ? dpp<0x111>(1.f, TA[j]) : dpp<0x101>(1.f, TA[j]), EU = dir == 0 ? dpp<0x111>(0.f, TU[j]) : dpp<0x101>(0.f, TU[j]);
                    s[j] = EU + EA * hin; }
                if (dir == 0) {
#pragma unroll
                    for (int m = 0; m < 4; ++m) { float h[8];
#pragma unroll
                        for (int j = 0; j < 8; ++j) h[j] = U[m][j] + A[m][j] * s[j];
                        hfl[(2 * m) * 64 + lane] = (f32x4){h[0], h[1], h[2], h[3]}; hfl[(2 * m + 1) * 64 + lane] = (f32x4){h[4], h[5], h[6], h[7]}; }
                } else {
#pragma unroll
                    for (int m = 0; m < 4; ++m) { bf16* yp = P.Y + (size_t)(rbase + (isctx ? c : c - 4) * 64 + 4 * fr + m) * YC + 1024 + chp;
                        const u32x4 g = *(const u32x4*)yp; float gv[8];
                        gv[0] = __uint_as_float(g.x << 16); gv[1] = __uint_as_float(g.x & 0xffff0000u); gv[2] = __uint_as_float(g.y << 16); gv[3] = __uint_as_float(g.y & 0xffff0000u);
                        gv[4] = __uint_as_float(g.z << 16); gv[5] = __uint_as_float(g.z & 0xffff0000u); gv[6] = __uint_as_float(g.w << 16); gv[7] = __uint_as_float(g.w & 0xffff0000u);
                        float o[8];
                        const f32x4 h0 = hfl[(2 * m) * 64 + lane], h1 = hfl[(2 * m + 1) * 64 + lane]; const float hfv[8] = {h0[0], h0[1], h0[2], h0[3], h1[0], h1[1], h1[2], h1[3]};
#pragma unroll
                        for (int j = 0; j < 8; ++j) o[j] = (hfv[j] + U[m][j] + A[m][j] * s[j]) * gv[j];
                        u32x4 w; w.x = pg8::cvt_pk_bf16(o[0], o[1]); w.y = pg8::cvt_pk_bf16(o[2], o[3]); w.z = pg8::cvt_pk_bf16(o[4], o[5]); w.w = pg8::cvt_pk_bf16(o[6], o[7]);
                        *(u32x4*)yp = w; }
                }
            }
        }
    }
}
template <int PASS> __device__ __forceinline__ void phase(const Params& P, int gw, int NGW, int lane, LAS f32x4* hfl, bool skip_ctx) {
    for (int it = gw; it < BATCH * NCH * 16; it += NGW) { const int blk = it & 15, bc = it >> 4, c = bc % NCH; if (skip_ctx && c < 4) continue; item<PASS>(P, bc / NCH, c, blk, lane, hfl); }
}
#undef LAS
}

#include <hip/hip_bf16.h>
#include <cmath>
namespace attn_body {
using bf16=__hip_bfloat16;
using bf16x8=__attribute__((ext_vector_type(8)))short;
using s16x4=__attribute__((ext_vector_type(4)))short;
using f32x16=__attribute__((ext_vector_type(16)))float;
using u32x4=__attribute__((ext_vector_type(4)))unsigned;
constexpr int D=64, QP=2048  , KP=128  ;
constexpr int NW=8,QBLK=32,QB=QBLK*NW,KVBLK=64;
constexpr int ATTN_UNIT_ROWS=QB;
__device__ __forceinline__ int crow(int r,int hi){return (r&3)+8*(r>>2)+4*hi;}
#define SBAR() __builtin_amdgcn_sched_barrier(0)
__device__ __forceinline__ void wmask(f32x16&p0,f32x16&p1,int d,int hi){
  const float NEG=-INFINITY; const int kb=d+4*hi;
  #pragma unroll
  for(int r=0;r<16;++r){const int x=kb+(r&3)+8*(r>>2); if(x<-128||x>128)p0[r]=NEG; if(x+32<-128||x+32>128)p1[r]=NEG;}
}

constexpr int NSLOT=3, SLOTB=8192;
constexpr int LDS_K=0, LDS_V=NSLOT*SLOTB, LDS_WS=2*NSLOT*SLOTB, LDS_OST=LDS_WS+NW*64*4, LDS_BYTES=LDS_OST+NW*4096;
constexpr float C2=0.125f*1.4426950408889634f;
__device__ __forceinline__ void glds16(const void*gsrc,unsigned lds_dst){unsigned keep;
  asm volatile("s_mov_b32 %0, m0\n\ts_mov_b32 m0, %2\n\ts_nop 0\n\tglobal_load_lds_dwordx4 %1, off\n\ts_mov_b32 m0, %0":"=&s"(keep):"v"(gsrc),"s"(lds_dst):"memory");}
__device__ __forceinline__ float max3f(float a,float b,float c){float r;asm("v_max3_f32 %0, %1, %2, %3":"=v"(r):"v"(a),"v"(b),"v"(c));return r;}
__device__ __forceinline__ float max2f(float a,float b){float r;asm("v_max_f32_e32 %0, %1, %2":"=v"(r):"v"(a),"v"(b));return r;}
__device__ __forceinline__ float fadd_s(float a,float b){float r;asm("v_add_f32_e32 %0, %1, %2":"=v"(r):"v"(a),"v"(b));return r;}
__device__ __forceinline__ float fsub_s(float a,float b){float r;asm("v_sub_f32_e32 %0, %1, %2":"=v"(r):"v"(a),"v"(b));return r;}
typedef float f32x2_t __attribute__((ext_vector_type(2))); typedef __bf16 bf16x2_t __attribute__((ext_vector_type(2)));
__device__ __forceinline__ unsigned cvtpk_s(float lo,float hi){f32x2_t v={lo,hi};bf16x2_t b=__builtin_convertvector(v,bf16x2_t);return __builtin_bit_cast(unsigned,b);}
#define WAIT_BAR(N) asm volatile("s_waitcnt vmcnt(" #N ") lgkmcnt(0)\n\ts_barrier":::"memory")

__device__ __forceinline__ void qkt(f32x16&p0,f32x16&p1,const char*Kslot,const bf16x8*qr,const f32x16&negm,int r32,int hi){
  const char*kb=Kslot+hi*1024+r32*16;
  #pragma unroll
  for(int d0=0;d0<4;++d0){
    const bf16x8 b0=*reinterpret_cast<const bf16x8*>(kb+d0*2048);
    const bf16x8 b1=*reinterpret_cast<const bf16x8*>(kb+d0*2048+512);
    if(d0==0){p0=__builtin_amdgcn_mfma_f32_32x32x16_bf16(b0,qr[0],negm,0,0,0);p1=__builtin_amdgcn_mfma_f32_32x32x16_bf16(b1,qr[0],negm,0,0,0);}
    else{p0=__builtin_amdgcn_mfma_f32_32x32x16_bf16(b0,qr[d0],p0,0,0,0);p1=__builtin_amdgcn_mfma_f32_32x32x16_bf16(b1,qr[d0],p1,0,0,0);}}
}
typedef __attribute__((address_space(3))) const char* lds_cptr;
typedef short v4i16_t __attribute__((ext_vector_type(4)));
__device__ __forceinline__ void kload8(bf16x8*kf,lds_cptr kp){
  kf[0]=*(const __attribute__((address_space(3))) bf16x8*)(kp);      kf[1]=*(const __attribute__((address_space(3))) bf16x8*)(kp+512);
  kf[2]=*(const __attribute__((address_space(3))) bf16x8*)(kp+2048); kf[3]=*(const __attribute__((address_space(3))) bf16x8*)(kp+2560);
  kf[4]=*(const __attribute__((address_space(3))) bf16x8*)(kp+4096); kf[5]=*(const __attribute__((address_space(3))) bf16x8*)(kp+4608);
  kf[6]=*(const __attribute__((address_space(3))) bf16x8*)(kp+6144); kf[7]=*(const __attribute__((address_space(3))) bf16x8*)(kp+6656);
}
__device__ __forceinline__ void kload2(bf16x8*kf,lds_cptr kp,int j){ kf[2*j]=*(const __attribute__((address_space(3))) bf16x8*)(kp+j*2048); kf[2*j+1]=*(const __attribute__((address_space(3))) bf16x8*)(kp+j*2048+512); }
__device__ __forceinline__ s16x4 vtr(lds_cptr p){ return __builtin_bit_cast(s16x4,__builtin_amdgcn_ds_read_tr16_b64_v4i16((__attribute__((address_space(3))) v4i16_t*)p)); }
__device__ __forceinline__ float rowmax(const f32x16&p0,const f32x16&p1){
  float a=max3f(p0[0],p0[1],p1[0]),b=max3f(p0[2],p0[3],p1[1]);a=max3f(a,p1[2],p1[3]);
  #pragma unroll
  for(int r=4;r<16;r+=4){a=max3f(a,p0[r],p0[r+1]);b=max3f(b,p0[r+2],p0[r+3]);a=max3f(a,p1[r],p1[r+1]);b=max3f(b,p1[r+2],p1[r+3]);}
  const float m=max2f(a,b);
  auto rr=__builtin_amdgcn_permlane32_swap(__float_as_uint(m),__float_as_uint(m),false,false);
  return max2f(__uint_as_float(rr[0]),__uint_as_float(rr[1]));
}
__device__ __forceinline__ void pv(f32x16*o,int vb,bf16x8 pa0,bf16x8 pa1,bf16x8 pa2,bf16x8 pa3){
  #pragma unroll
  for(int d0=0;d0<2;++d0){s16x4 lo[4],hi[4];
    #pragma unroll
    for(int ks=0;ks<4;++ks){
      asm volatile("ds_read_b64_tr_b16 %0,%1 offset:%c2":"=&v"(lo[ks]):"v"(vb),"i"(d0*4096+ks*1024):"memory");
      asm volatile("ds_read_b64_tr_b16 %0,%1 offset:%c2":"=&v"(hi[ks]):"v"(vb),"i"(d0*4096+ks*1024+512):"memory");}
    asm volatile("s_waitcnt lgkmcnt(0)":::"memory");SBAR();
    #define PK(k) (bf16x8){lo[k][0],lo[k][1],lo[k][2],lo[k][3],hi[k][0],hi[k][1],hi[k][2],hi[k][3]}
    o[d0]=__builtin_amdgcn_mfma_f32_32x32x16_bf16(pa0,PK(0),o[d0],0,0,0);
    o[d0]=__builtin_amdgcn_mfma_f32_32x32x16_bf16(pa1,PK(1),o[d0],0,0,0);
    o[d0]=__builtin_amdgcn_mfma_f32_32x32x16_bf16(pa2,PK(2),o[d0],0,0,0);
    o[d0]=__builtin_amdgcn_mfma_f32_32x32x16_bf16(pa3,PK(3),o[d0],0,0,0);
    #undef PK
  }
}

#ifndef ATTN_STORE16
#define ATTN_STORE16(p,v) (*(u32x4*)(p)=(v))
#endif
struct UnitDesc { int qrow0, qcol, kvcol, NT, n0, r0, r1, mq0, mk0; float sink2; };
template<int KIND,int THRL> __device__ __forceinline__ void attn_unit(const UnitDesc&ud,bf16*Y,const bf16*__restrict__ K,const bf16*__restrict__ V,char*shm,int tid_in){
  int tid_=tid_in; asm volatile("":"+v"(tid_));
  const int tid=tid_,lane=tid&63,r32=lane&31,hi=lane>>5; const int wid=__builtin_amdgcn_readfirstlane(tid>>6);
  const bf16*Qw=Y+(long)(ud.qrow0+wid*QBLK)*QP+ud.qcol;
  const bf16*Kh=K+ud.kvcol,*Vh=V+ud.kvcol;
  #define TROW(t) ((long)((t)<ud.n0?ud.r0+64*(t):ud.r1+64*((t)-ud.n0)))
  const unsigned lds0=(unsigned)(uintptr_t)shm;
  float*wsf=(float*)(shm+LDS_WS)+wid*64;
  const bf16*ksrc=Kh+(long)lane*KP+wid*8;
  const bf16*vsrc=Vh+(long)(16*(wid&3)+(lane>>2))*KP+(wid>>2)*32+(lane&3)*8;
  const unsigned kdst=lds0+LDS_K+wid*1024, vdst=lds0+LDS_V+wid*1024;
  #define DMA_K(t,slot) glds16(ksrc+TROW(t)*KP,(unsigned)__builtin_amdgcn_readfirstlane(kdst+(slot)))
  #define DMA_V(t,slot) glds16(vsrc+TROW(t)*KP,(unsigned)__builtin_amdgcn_readfirstlane(vdst+(slot)))
  const int vb0=(int)(lds0+LDS_V)+((lane>>4)&1)*32+(lane&3)*8+(4*hi+((lane&15)>>2))*64;
  const char*Kbase=shm+LDS_K; bf16x8 kf[8];
  const lds_cptr shm3=(lds_cptr)shm; const lds_cptr kp0=shm3+LDS_K+hi*1024+r32*16; const lds_cptr vp0=shm3+LDS_V+((lane>>4)&1)*32+(lane&3)*8+(4*hi+((lane&15)>>2))*64;
  const int NT=ud.NT;
  DMA_K(0,0);DMA_V(0,0);DMA_K(1,SLOTB);
  bf16x8 qr[4];
  #pragma unroll
  for(int d0=0;d0<4;++d0)qr[d0]=*reinterpret_cast<const bf16x8*>(&Qw[(long)r32*QP+d0*16+hi*8]);
  float mhat=0.f,l_reg=0.f;f32x16 o[2];o[0]=f32x16{};o[1]=f32x16{};f32x16 negm=f32x16{};asm volatile("":"+v"(negm));
  const int qoff=ud.mq0+wid*QBLK+r32;
  #define CMASK(P0,P1,t) do{ if(KIND==0&&(t)>=4)wmask(P0,P1,ud.mk0+64*((t)-4)-qoff,hi); }while(0)
  bool resc=false;
  #define START(P0,P1) do{ const float rm=rowmax(P0,P1); resc=false; \
    { const float dl=rm; mhat=fadd_s(mhat,dl); \
      _Pragma("unroll") for(int r=0;r<16;++r){P0[r]=fsub_s(P0[r],dl);P1[r]=fsub_s(P1[r],dl);} \
      _Pragma("unroll") for(int r=0;r<16;++r)negm[r]=-mhat; asm volatile("":"+v"(negm)); } \
    _Pragma("unroll") for(int r=0;r<16;++r)P0[r]=__builtin_amdgcn_exp2f(P0[r]); }while(0)
  #define RESC() do{ if(resc){ asm volatile("s_waitcnt lgkmcnt(0)":::"memory"); \
      _Pragma("unroll") for(int d_=0;d_<2;++d_) _Pragma("unroll") for(int r=0;r<16;++r)o[d_][r]*=wsf[crow(r,hi)]; } }while(0)
  f32x16 pA0,pA1,pB0,pB1;
  int sl_prev=0,sl_cur=0,sl_next=SLOTB;
  #define ROT() do{sl_prev=sl_cur;sl_cur=sl_next;sl_next=(sl_next==(NSLOT-1)*SLOTB)?0:sl_next+SLOTB;}while(0)
  DMA_K(2,2*SLOTB);
  WAIT_BAR(3);
  qkt(pA0,pA1,Kbase,qr,negm,r32,hi);asm volatile("s_nop 15\n\ts_nop 7":"+v"(pA0),"+v"(pA1));CMASK(pA0,pA1,0);
  START(pA0,pA1);
  _Pragma("unroll") for(int r=0;r<16;++r)pA1[r]=__builtin_amdgcn_exp2f(pA1[r]);
  WAIT_BAR(0);
  DMA_K(3,0);DMA_V(1,SLOTB);
  ROT();
  kload8(kf,kp0+sl_cur);
  WAIT_BAR(2);
  s16x4 vlo[8],vhi[8]; u32x4 pw0,pw1,pw2,pw3;
  #define PKW(P,B) cvtpk_s(P[B],P[B+1])
  #define PAF(k) __builtin_bit_cast(bf16x8,pw##k)
  #define VFR(i) (bf16x8){vlo[i][0],vlo[i][1],vlo[i][2],vlo[i][3],vhi[i][0],vhi[i][1],vhi[i][2],vhi[i][3]}
  #define PIN(x) asm volatile("":"+v"(x))
  #define MX3(a,b,c) __builtin_fmaxf(__builtin_fmaxf((a),(b)),(c))
  #define GAPA(MF,A0,A1,A2,A3,W0,W1,PW) do{ MF; sacc+=A0; sacc+=A1; sacc+=A2; sacc+=A3; PIN(sacc); W0; W1; PIN(PW); SBAR(); }while(0)
  #define EX(v) __builtin_amdgcn_exp2f(v)
  #define GAPB(MF,X,B) do{ MF; X[B]=EX(X[B]); X[B+1]=EX(X[B+1]); X[B+2]=EX(X[B+2]); X[B+3]=EX(X[B+3]); PIN(X); SBAR(); }while(0)
  #define VRD(i) do{ vlo[i]=vtr(vp_+(((i)>>2)*4096+((i)&3)*1024)); vhi[i]=vtr(vp_+(((i)>>2)*4096+((i)&3)*1024+512)); }while(0)
  #define KRD(G,j) do{ if(G){ kload2(kf,kp0+sl_next,j); SBAR(); } }while(0)
  #define STEP(C0,C1,P0,P1,t,GK,GV,GL) do{ SBAR(); \
    const lds_cptr vp_=vp0+sl_prev; \
    VRD(0); SBAR(); float sacc=(P0[0]+P0[1]); \
    GAPA(C0=__builtin_amdgcn_mfma_f32_32x32x16_bf16(kf[0],qr[0],negm,0,0,0), P0[2],P0[3],P0[4],P0[5],     pw0[0]=PKW(P0,0), pw0[1]=PKW(P0,2), pw0); \
    VRD(4); SBAR(); GAPA(C1=__builtin_amdgcn_mfma_f32_32x32x16_bf16(kf[1],qr[0],negm,0,0,0), P0[6],P0[7],P0[8],P0[9],     pw0[2]=PKW(P0,4), pw0[3]=PKW(P0,6), pw0); \
    VRD(1); SBAR(); GAPA(C0=__builtin_amdgcn_mfma_f32_32x32x16_bf16(kf[2],qr[1],C0,0,0,0),   P0[10],P0[11],P0[12],P0[13], pw1[0]=PKW(P0,8), pw1[1]=PKW(P0,10), pw1); \
    VRD(5); SBAR(); GAPA(C1=__builtin_amdgcn_mfma_f32_32x32x16_bf16(kf[3],qr[1],C1,0,0,0),   P0[14],P0[15],P1[0],P1[1],   pw1[2]=PKW(P0,12),pw1[3]=PKW(P0,14), pw1); \
    VRD(2); SBAR(); GAPA(C0=__builtin_amdgcn_mfma_f32_32x32x16_bf16(kf[4],qr[2],C0,0,0,0),   P1[2],P1[3],P1[4],P1[5],     pw2[0]=PKW(P1,0), pw2[1]=PKW(P1,2), pw2); \
    VRD(6); SBAR(); GAPA(C1=__builtin_amdgcn_mfma_f32_32x32x16_bf16(kf[5],qr[2],C1,0,0,0),   P1[6],P1[7],P1[8],P1[9],     pw2[2]=PKW(P1,4), pw2[3]=PKW(P1,6), pw2); \
    VRD(3); SBAR(); GAPA(C0=__builtin_amdgcn_mfma_f32_32x32x16_bf16(kf[6],qr[3],C0,0,0,0),   P1[10],P1[11],P1[12],P1[13], pw3[0]=PKW(P1,8), pw3[1]=PKW(P1,10), pw3); \
    VRD(7); SBAR(); GAPA(C1=__builtin_amdgcn_mfma_f32_32x32x16_bf16(kf[7],qr[3],C1,0,0,0),   P1[14],P1[15],0.f,0.f,       pw3[2]=PKW(P1,12),pw3[3]=PKW(P1,14), pw3); \
    l_reg+=sacc; \
    if(GK){DMA_K((t)+3,sl_cur);} if(GV){DMA_V((t)+1,sl_next);} \
    CMASK(C0,C1,t); \
    { float a=MX3(C0[0],C0[1],C1[0]),b=MX3(C0[2],C0[3],C1[1]); a=MX3(a,C1[2],C1[3]); \
      _Pragma("unroll") for(int r=4;r<16;r+=4){a=MX3(a,C0[r],C0[r+1]);b=MX3(b,C0[r+2],C0[r+3]);a=MX3(a,C1[r],C1[r+1]);b=MX3(b,C1[r+2],C1[r+3]);} \
      float rm=__builtin_fmaxf(a,b); { auto rr=__builtin_amdgcn_permlane32_swap(__float_as_uint(rm),__float_as_uint(rm),false,false); rm=__builtin_fmaxf(__uint_as_float(rr[0]),__uint_as_float(rr[1])); } \
      resc=false; \
      if(__builtin_expect(__any(rm>(float)THRL),0)){ const float dl=__builtin_fmaxf(rm,0.f); mhat+=dl; \
        _Pragma("unroll") for(int r=0;r<16;++r){C0[r]-=dl;C1[r]-=dl;} \
        _Pragma("unroll") for(int r=0;r<16;++r)negm[r]=-mhat; asm volatile("":"+v"(negm)); \
        const float f=__builtin_amdgcn_exp2f(-dl); l_reg*=f; if(hi==0)wsf[r32]=f; resc=true; } } \
    SBAR(); \
    GAPB(o[0]=__builtin_amdgcn_mfma_f32_32x32x16_bf16(PAF(0),VFR(0),o[0],0,0,0), C0,0); \
    GAPB(o[1]=__builtin_amdgcn_mfma_f32_32x32x16_bf16(PAF(0),VFR(4),o[1],0,0,0), C0,4); \
    KRD(GL,0); GAPB(o[0]=__builtin_amdgcn_mfma_f32_32x32x16_bf16(PAF(1),VFR(1),o[0],0,0,0), C0,8); \
    KRD(GL,1); GAPB(o[1]=__builtin_amdgcn_mfma_f32_32x32x16_bf16(PAF(1),VFR(5),o[1],0,0,0), C0,12); \
    KRD(GL,2); GAPB(o[0]=__builtin_amdgcn_mfma_f32_32x32x16_bf16(PAF(2),VFR(2),o[0],0,0,0), C1,0); \
    KRD(GL,3); GAPB(o[1]=__builtin_amdgcn_mfma_f32_32x32x16_bf16(PAF(2),VFR(6),o[1],0,0,0), C1,4); \
    GAPB(o[0]=__builtin_amdgcn_mfma_f32_32x32x16_bf16(PAF(3),VFR(3),o[0],0,0,0), C1,8); \
    GAPB(o[1]=__builtin_amdgcn_mfma_f32_32x32x16_bf16(PAF(3),VFR(7),o[1],0,0,0), C1,12); \
    }while(0)
  int t=1;
  for(;t+5<NT;t+=2){
    STEP(pB0,pB1,pA0,pA1,t,true,true,true);     WAIT_BAR(2); RESC(); ROT();
    STEP(pA0,pA1,pB0,pB1,t+1,true,true,true);   WAIT_BAR(2); RESC(); ROT();
  }
  #define ENDW(tt) do{ if((tt)+3<NT){WAIT_BAR(2);} else if((tt)+2<NT){WAIT_BAR(1);} else {WAIT_BAR(0);} }while(0)
  for(;t+1<NT;t+=2){
    STEP(pB0,pB1,pA0,pA1,t,(t+3<NT),(t+1<NT),(t+1<NT));       ENDW(t);   RESC(); ROT();
    STEP(pA0,pA1,pB0,pB1,t+1,(t+4<NT),(t+2<NT),(t+2<NT));     ENDW(t+1); RESC(); ROT();
  }
  STEP(pB0,pB1,pA0,pA1,NT-1,false,false,false); RESC();
  { float sacc=pB0[0]+pB0[1]; _Pragma("unroll") for(int r=2;r<16;++r)sacc+=pB0[r]; _Pragma("unroll") for(int r=0;r<16;++r)sacc+=pB1[r]; l_reg+=sacc;
    pw0=(u32x4){PKW(pB0,0),PKW(pB0,2),PKW(pB0,4),PKW(pB0,6)};pw1=(u32x4){PKW(pB0,8),PKW(pB0,10),PKW(pB0,12),PKW(pB0,14)};pw2=(u32x4){PKW(pB1,0),PKW(pB1,2),PKW(pB1,4),PKW(pB1,6)};pw3=(u32x4){PKW(pB1,8),PKW(pB1,10),PKW(pB1,12),PKW(pB1,14)};
    SBAR(); pv(o,vb0+sl_cur,PAF(0),PAF(1),PAF(2),PAF(3)); }
  #undef PKW
  #undef PAF
  #undef VFR
  #undef PIN
  #undef MX3
  #undef GAPA
  #undef GAPB
  #undef EX
  #undef VRD
  #undef KRD
  #undef STEP
  #undef ENDW
  {auto rr=__builtin_amdgcn_permlane32_swap(__float_as_uint(l_reg),__float_as_uint(l_reg),false,false);l_reg=__uint_as_float(rr[0])+__uint_as_float(rr[1]);}
  if(KIND==0)l_reg+=__builtin_amdgcn_exp2f(ud.sink2-mhat);
  if(hi==0)wsf[32+r32]=l_reg;asm volatile("s_waitcnt lgkmcnt(0)":::"memory");
  float rli[16];
  #pragma unroll
  for(int r=0;r<16;++r)rli[r]=__builtin_amdgcn_rcpf(wsf[32+crow(r,hi)]);
  bf16*Ow=Y+(long)(ud.qrow0+wid*QBLK)*QP+ud.qcol;
  { bf16*stg=(bf16*)(shm+LDS_OST)+wid*2048;
    #pragma unroll
    for(int r=0;r<16;++r){const int orow=crow(r,hi);
      #pragma unroll
      for(int d0=0;d0<2;++d0)stg[orow*64+d0*32+r32]=__float2bfloat16(o[d0][r]*rli[r]);}
    asm volatile("s_waitcnt lgkmcnt(0)":::"memory");
    #pragma unroll
    for(int i=0;i<4;++i){const int row=i*8+(lane>>3),ch=lane&7; const u32x4 v=*(const u32x4*)(stg+row*64+ch*8); ATTN_STORE16(Ow+(long)row*QP+ch*8,v);} }
  asm volatile("s_waitcnt lgkmcnt(0)\n\ts_barrier":::"memory");
  #undef DMA_K
  #undef DMA_V
  #undef TROW
  #undef CMASK
  #undef START
  #undef RESC
  #undef ROT
}
constexpr int ATTN_LDS_BYTES=LDS_BYTES;
#undef SBAR
#undef WAIT_BAR
}

#ifndef PG8_SP2
#define PG8_SP2 true
#endif
#ifndef PG8_ALIGN
#define PG8_ALIGN true
#endif

#ifndef PG8_SP2
#define PG8_SP2 true
#endif
#ifndef PG8_ALIGN
#define PG8_ALIGN true
#endif
constexpr int NWAVES = 8;
constexpr int RING_OFF = 0, RING_BYTES = 131072;
constexpr int LDSCTL_OFF = RING_BYTES, MISC_OFF = LDSCTL_OFF + 320;
constexpr int LDS_BYTES = 147456;
constexpr size_t WS_W = 1 * MiB;
constexpr size_t WO_IN = 0, WO_MERGE = 13 * MiB, WO_OUT = 17 * MiB, WO_FF1 = 19 * MiB, WO_FF2 = 27 * MiB, WO_LRU = 35 * MiB;
constexpr int CW_TMO = 0, CW_CODE = 1, CW_BAR = 4096;
constexpr size_t CTL_ZERO_BYTES = 64 * 1024;

#define GAS __attribute__((address_space(1)))
#define LAS __attribute__((address_space(3)))
typedef unsigned v4u __attribute__((ext_vector_type(4)));
typedef float f32x4 __attribute__((ext_vector_type(4)));
typedef short bf16x8 __attribute__((ext_vector_type(8)));
typedef GAS unsigned gu32;
typedef GAS unsigned long long gu64;
#define RLX_AGENT __ATOMIC_RELAXED, __HIP_MEMORY_SCOPE_AGENT
#define LDS_WAIT() asm volatile("s_waitcnt lgkmcnt(0)" ::: "memory")
#define VM_WAIT() asm volatile("s_waitcnt vmcnt(0)" ::: "memory")
__device__ __forceinline__ unsigned long long rt() { return __builtin_amdgcn_s_memrealtime(); }
__device__ __forceinline__ unsigned f2bfu(float f) { unsigned u = __builtin_bit_cast(unsigned, f); return (u + 0x7fffu + ((u >> 16) & 1u)) >> 16; }
__device__ __forceinline__ unsigned pk2(float lo, float hi) { return f2bfu(lo) | (f2bfu(hi) << 16); }

#define XB_TMO      128
#define XB_XCNT(j)  (256  + 64 * (j))
#define XB_XSUB(j)  (1280 + 64 * (j))
#define XB_XGEN(j)  (2304 + 64 * (j))
#define XB_TOP      3328
#define XB_TOPGEN   3392
#define XCD_BAR_WORDS 3456
#define XB_SPIN_CAP (1u << 18)

__device__ __forceinline__ unsigned xb_ld(unsigned* p)              { return __hip_atomic_load(p, __ATOMIC_RELAXED, __HIP_MEMORY_SCOPE_AGENT); }
__device__ __forceinline__ unsigned xb_add(unsigned* p, unsigned v) { return __hip_atomic_fetch_add(p, v, __ATOMIC_RELAXED, __HIP_MEMORY_SCOPE_AGENT); }
__device__ __forceinline__ unsigned xb_xcc_id() { return (unsigned)__builtin_amdgcn_s_getreg((3 << 11) | 20) & 0xFu; }
#define XB_SPIN(cond, bar) do { unsigned _sp = 0; while (cond) { __builtin_amdgcn_s_sleep(1); \
    if ((++_sp & 255u) == 0u) { if (xb_ld(&(bar)[XB_TMO])) break; if (_sp > XB_SPIN_CAP) { atomicAdd(&(bar)[XB_TMO], 1u); break; } } } } while (0)

struct XcdBarrier {
    unsigned* bar; unsigned x;
    volatile LAS unsigned* st;
};

__device__ __forceinline__ XcdBarrier xcd_barrier_post(unsigned* bar, volatile LAS unsigned* st) {
    XcdBarrier b; b.bar = bar; b.x = xb_xcc_id(); b.st = st;
    if (threadIdx.x == 0) (void)xb_add(&bar[XB_XCNT(b.x)], 1u);
    return b;
}
__device__ __forceinline__ void xcd_barrier_complete(unsigned* bar, unsigned x, unsigned& nloc, unsigned& nx) {
    const unsigned G = gridDim.x * gridDim.y * gridDim.z;
    unsigned sum, cnt, mine, sp = 0u;
    for (;;) {
        sum = 0u; cnt = 0u; mine = 0u;
#pragma unroll
        for (unsigned j = 0; j < 16; ++j) { const unsigned c = xb_ld(&bar[XB_XCNT(j)]); sum += c; cnt += (c > 0u) ? 1u : 0u; mine = (j == x) ? c : mine; }
        if (sum == G) break;
        __builtin_amdgcn_s_sleep(1);
        if ((++sp & 255u) == 0u) { if (xb_ld(&bar[XB_TMO])) break; if (sp > XB_SPIN_CAP) { atomicAdd(&bar[XB_TMO], 1u); break; } }
    }
    nloc = mine > 0u ? mine : 1u; nx = cnt > 0u ? cnt : 1u;
}

__device__ __forceinline__ void xcd_barrier(const XcdBarrier& b, int tid_in) {
    asm volatile("s_waitcnt vmcnt(0)" ::: "memory");
    __syncthreads();
    if (tid_in == 0) {
        unsigned long long bari_ = (unsigned long long)b.bar; asm volatile("" : "+s"(bari_));
        unsigned* bar = (unsigned*)(GAS unsigned*)bari_;
        __builtin_amdgcn_s_waitcnt(0);
        unsigned nloc = b.st[0], nx = b.st[1];
        unsigned bx_ = b.x; asm volatile("" : "+s"(bx_));
        if (nloc == 0u) { xcd_barrier_complete(bar, bx_, nloc, nx); b.st[0] = nloc; b.st[1] = nx; }
        const unsigned old = xb_add(&bar[XB_XSUB(bx_)], 1u);
        const unsigned gen = old / nloc;
        if (old + 1u == (gen + 1u) * nloc) {
            __builtin_amdgcn_fence(__ATOMIC_RELEASE, "agent");
            asm volatile("s_waitcnt vmcnt(0)" ::: "memory");
            const unsigned og = xb_add(&bar[XB_TOP], 1u);
            const unsigned tg = og / nx;
            if (og + 1u == (tg + 1u) * nx) xb_add(&bar[XB_TOPGEN], 1u);
            else XB_SPIN(xb_ld(&bar[XB_TOPGEN]) == tg, bar);
            __builtin_amdgcn_fence(__ATOMIC_ACQUIRE, "agent");
            xb_add(&bar[XB_XGEN(bx_)], 1u);
            asm volatile("s_waitcnt vmcnt(0)" ::: "memory");
        } else {
            XB_SPIN(xb_ld(&bar[XB_XGEN(bx_)]) == gen, bar);
            __builtin_amdgcn_fence(__ATOMIC_ACQUIRE, "agent");
            asm volatile("s_waitcnt vmcnt(0)" ::: "memory");
        }
    }
    __syncthreads();
}


template <int KIND> __device__ __forceinline__ void attn_latent(char* lds, bf16* Y, const bf16* K, const bf16* V, int vcu, int G, const float* sink, int tid_in) {
    for (int U = vcu; U < 512; U += G) {
        const int grp = (U & 255) >> 5, loc = U & 31, u = loc * 2 + (U >> 8), b = grp >> 1, kvh = grp & 1, h = kvh * 4 + (u >> 4), qb = u & 15;
        attn_body::UnitDesc ud; ud.qrow0 = b * SEQ + 256 * qb; ud.qcol = (KIND == 0 ? 0 : 512) + h * 64; ud.kvcol = kvh * 64;
        if (KIND == 1) { ud.NT = 68; ud.n0 = 64; ud.r0 = b * SEQ; ud.r1 = NLAT + b * CTXL; ud.mq0 = 0; ud.mk0 = 0; ud.sink2 = 0.f; }
        else { const int tl0 = 4 * qb - 2 < 0 ? 0 : 4 * qb - 2, tl1 = 4 * qb + 5 > 63 ? 63 : 4 * qb + 5;
            ud.NT = 4 + (tl1 - tl0 + 1); ud.n0 = 4; ud.r0 = NLAT + b * CTXL; ud.r1 = b * SEQ + 64 * tl0; ud.mq0 = 256 * qb; ud.mk0 = 64 * tl0; ud.sink2 = sink[h] * LOG2E; }
        attn_body::attn_unit<KIND, 8>(ud, (attn_body::bf16*)Y, (const attn_body::bf16*)K, (const attn_body::bf16*)V, lds, tid_in);
    }
}
template <int KIND> __device__ __forceinline__ void attn_context(char* lds, bf16* Y, const bf16* K, const bf16* V, int vcu, int G, const float* sink, int tid_in) {
    for (int j = 0; j < 32; ++j) {
        const int b = j >> 3, h = j & 7, kvh = h >> 2, tgt = ((b * 2 + kvh) * 32 + 8 + (h & 3) + 4 * KIND) % G;
        if (tgt != vcu) continue;
        attn_body::UnitDesc ud; ud.qrow0 = NLAT + b * CTXL; ud.qcol = (KIND == 0 ? 0 : 512) + h * 64; ud.kvcol = kvh * 64;
        ud.NT = 4; ud.n0 = 4; ud.r0 = NLAT + b * CTXL; ud.r1 = 0; ud.mq0 = 0; ud.mk0 = 0; ud.sink2 = KIND == 0 ? sink[h] * LOG2E : 0.f;
        attn_body::attn_unit<KIND, 8>(ud, (attn_body::bf16*)Y, (const attn_body::bf16*)K, (const attn_body::bf16*)V, lds, tid_in);
    }
}

#ifndef ATTN_ON
#define ATTN_ON 1
#endif
#ifndef PHMASK
#define PHMASK 0xffffffffu
#endif
#define PHM(p) ((PHMASK >> (p)) & 1u)
struct MkArgs { const float* in[27]; float* out; unsigned char* ws; int ph_lo, ph_hi, layer, pad; };
typedef const __attribute__((address_space(4))) MkArgs& KArgs;
struct Frame {
    LAS unsigned char* lds; volatile LAS unsigned* MISC; gu32* ctl;
    int tid, lane, wave, vcu, G, bid;
};
enum { PH_PRO = 0, PH_W = 1, PH_G1A = 2, PH_MIX1 = 3, PH_MIX2 = 4, PH_G1B = 5, PH_MERGE = 6, PH_OUT = 7, PH_LN1 = 8, PH_FF1 = 9, PH_FF2 = 10, PH_LN2 = 11, PH_COUNT = 12 };

__device__ __forceinline__ int tt_of_tile(int kind, int tile) { return kind == 0 ? pg8::TT_IDENT : kind == 1 ? pg8::TT_NAT8 : (tile < 6 ? pg8::TT_HEAD : pg8::TT_NAT8); }
__device__ __forceinline__ void transpose_item(const float* W, int ldw, int N, bf16* WT, int dpitch, int koff, int kind, LAS float* scr, int item, int lane) {
    const int nblk = N / 32, kb = item / nblk, nb = item % nblk, k0 = 64 * kb, n0 = 32 * nb;
#pragma unroll 8
    for (int i = 0; i < 32; ++i) { const int kk = 2 * i + (lane >> 5); scr[kk * 33 + (lane & 31)] = W[(size_t)(k0 + kk) * ldw + n0 + (lane & 31)]; }
    LDS_WAIT(); asm volatile("" ::: "memory");
    const int c = lane & 7;
#pragma unroll
    for (int j = 0; j < 4; ++j) { const int n = (lane >> 3) + 8 * j; const LAS float* s = scr + (8 * c) * 33 + n;
        v4u o; o.x = pk2(s[0 * 33], s[1 * 33]); o.y = pk2(s[2 * 33], s[3 * 33]); o.z = pk2(s[4 * 33], s[5 * 33]); o.w = pk2(s[6 * 33], s[7 * 33]);
        const int cl = n0 + n, tile = cl >> 8, drow = tile * 256 + pg8::tile_pos_of_logical(tt_of_tile(kind, tile), cl & 255);
        *(GAS v4u*)(WT + (size_t)drow * dpitch + koff + k0 + 8 * c) = o; }
    LDS_WAIT(); asm volatile("" ::: "memory");
}
__device__ __forceinline__ void phase_weights(Frame& F, KArgs a, int l) {
    LAS float* scr = (LAS float*)(F.lds + RING_OFF + F.wave * 16384);
    const int gw = F.vcu * NWAVES + F.wave, NGW = F.G * NWAVES;
    bf16* wb = (bf16*)(a.ws + WS_W);
    bf16 *Wi = wb + WO_IN / 2, *Wm = wb + WO_MERGE / 2, *Wo = wb + WO_OUT / 2, *W1 = wb + WO_FF1 / 2, *W2 = wb + WO_FF2 / 2;
    const float* w_in = a.in[6] + (size_t)l * DM * INC; const float* wa = a.in[17] + (size_t)l * 512 * DM; const float* wbb = a.in[18] + (size_t)l * 512 * DM; const float* wc = a.in[19] + (size_t)l * DM * DM;
    const float* wo = a.in[20] + (size_t)l * DM * DM; const float* w1 = a.in[23] + (size_t)l * DM * DFF; const float* w2 = a.in[24] + (size_t)l * DFF * DM;
    constexpr int I_IN = 16 * (INC / 32), I_A = 8 * 32, I_C = 16 * 32, I_O = 16 * 32, I_1 = 16 * (DFF / 32), I_2 = 64 * 32;
    constexpr int NITEMS = I_IN + 2 * I_A + I_C + I_O + I_1 + I_2;
    for (int it = gw; it < NITEMS; it += NGW) {
        int r = it;
        if (r < I_IN) { transpose_item(w_in, INC, INC, Wi, DM, 0, 2, scr, r, F.lane); continue; } r -= I_IN;
        if (r < I_A) { transpose_item(wa, DM, DM, Wm, YC, 0, 1, scr, r, F.lane); continue; } r -= I_A;
        if (r < I_A) { transpose_item(wbb, DM, DM, Wm, YC, 512, 1, scr, r, F.lane); continue; } r -= I_A;
        if (r < I_C) { transpose_item(wc, DM, DM, Wm, YC, 1024, 1, scr, r, F.lane); continue; } r -= I_C;
        if (r < I_O) { transpose_item(wo, DM, DM, Wo, DM, 0, 0, scr, r, F.lane); continue; } r -= I_O;
        if (r < I_1) { transpose_item(w1, DFF, DFF, W1, DM, 0, 1, scr, r, F.lane); continue; } r -= I_1;
        transpose_item(w2, DM, DM, W2, DFF, 0, 0, scr, r, F.lane);
    }
    { bf16* Wg = wb + WO_LRU / 2; const float* wr = a.in[12] + (size_t)l * 2 * 16 * 4096; const float* wi = a.in[14] + (size_t)l * 2 * 16 * 4096;
      for (int idx = gw * 64 + F.lane; idx < 2 * 2 * 16 * 64 * 8; idx += NGW * 64) {
          const int dc = idx & 7, rho = (idx >> 3) & 63, blk = (idx >> 9) & 15, gate = (idx >> 13) & 1, dir = idx >> 14;
          const int n = rho >> 4, i = rho & 15, e = 32 * (n >> 1) + 8 * (i >> 2) + 4 * (n & 1) + (i & 3);
          const float* src = (gate ? wi : wr) + ((size_t)(dir * 16 + blk) * 64 + dc * 8) * 64 + e;
          v4u o; o.x = pk2(src[0], src[64]); o.y = pk2(src[128], src[192]); o.z = pk2(src[256], src[320]); o.w = pk2(src[384], src[448]);
          *(GAS v4u*)(Wg + (size_t)(idx >> 3) * 64 + dc * 8) = o; }
      float* c2 = (float*)(a.ws + WS_LRUC); const float* lam = a.in[16] + (size_t)l * 2 * DM;
      for (int idx = gw * 64 + F.lane; idx < 2 * DM; idx += NGW * 64) {
          const float x = __builtin_amdgcn_exp2f(-1.4426950408889634f * lam[idx]);
          const float sp = x < 0.03f ? x * (1.f - x * (0.5f - x * (0.33333334f - x * (0.25f - x * 0.2f)))) : 0.6931471805599453f * __builtin_amdgcn_logf(1.f + x);
          c2[idx] = -8.f * 1.4426950408889634f * sp; } }
}


__device__ __forceinline__ float wave_sum(float v, int lane) {
#pragma unroll
    for (int o = 1; o < 64; o <<= 1) v += __int_as_float(__builtin_amdgcn_ds_bpermute((lane ^ o) << 2, __float_as_int(v)));
    return v;
}
__device__ __forceinline__ void phase_pro(Frame& F, KArgs a, float* mod, float* rope) {
    LAS float* red = (LAS float*)(F.lds + RING_OFF);
    const float* c = a.in[1]; const float* c_ctx = a.in[3]; const float* w_ada = a.in[4]; const float* b_ada = a.in[5];
    for (int it = F.vcu; it < DEPTH * 96; it += F.G) {
        const int l = it / 96, n = (it % 96) * 64 + F.lane;
        float acc[5] = {0.f, 0.f, 0.f, 0.f, 0.f};
        const float* wp = w_ada + ((size_t)l * DM + F.wave * 128) * 6144 + n;
#pragma unroll 4
        for (int k = 0; k < 128; ++k) { const float w = wp[(size_t)k * 6144]; const int kk = F.wave * 128 + k;
#pragma unroll
            for (int v = 0; v < 5; ++v) { const float x = v < 4 ? c[v * DM + kk] : c_ctx[kk]; acc[v] += (x * __builtin_amdgcn_rcpf(1.f + __builtin_amdgcn_exp2f(-1.4426950408889634f * x))) * w; } }
        __syncthreads();
#pragma unroll
        for (int v = 0; v < 5; ++v) red[(F.wave * 5 + v) * 64 + F.lane] = acc[v];
        __syncthreads();
        if (F.wave < 5) { float s = b_ada[l * 6144 + n];
#pragma unroll
            for (int w = 0; w < 8; ++w) s += red[(w * 5 + F.wave) * 64 + F.lane];
            mod[((size_t)l * 5 + F.wave) * 6144 + n] = s; }
    }
    if (blockIdx.x == 0) for (int i = F.tid; i < 1024; i += NWAVES * 64) { const int pos = i / 16, f = i % 16;
        float inv = 1.f;
        inv = f == 1 ? 5.623413324e-01f : inv; inv = f == 2 ? 3.162277639e-01f : inv; inv = f == 3 ? 1.778279394e-01f : inv; inv = f == 4 ? 1.000000015e-01f : inv; inv = f == 5 ? 5.623413250e-02f : inv;
        inv = f == 6 ? 3.162277490e-02f : inv; inv = f == 7 ? 1.778279431e-02f : inv; inv = f == 8 ? 9.999999776e-03f : inv; inv = f == 9 ? 5.623413250e-03f : inv; inv = f == 10 ? 3.162277630e-03f : inv;
        inv = f == 11 ? 1.778279431e-03f : inv; inv = f == 12 ? 1.000000047e-03f : inv; inv = f == 13 ? 5.623413017e-04f : inv; inv = f == 14 ? 3.162277571e-04f : inv; inv = f == 15 ? 1.778279402e-04f : inv;
        const float ang = (float)pos * inv; rope[i] = cosf(ang); rope[1024 + i] = sinf(ang); }
}
__device__ __forceinline__ void phase_modulate(Frame& F, const float* xlat, const float* xctx, const float* modl, int sh_off, int sc_off, bf16* H) {
    const int gw = F.vcu * NWAVES + F.wave, NGW = F.G * NWAVES;
    for (int row = gw; row < NROW; row += NGW) {
        const float* xr = row < NLAT ? xlat + (size_t)row * DM : xctx + (size_t)(row - NLAT) * DM; const float* m = modl + (size_t)(row < NLAT ? row / SEQ : 4) * 6144;
        GAS unsigned long long* o8 = (GAS unsigned long long*)(H + (size_t)row * DM) + F.lane;
#pragma unroll
        for (int j = 0; j < 4; ++j) { const int c = 4 * F.lane + 256 * j; const f32x4 v = *(const f32x4*)(xr + c), sc = *(const f32x4*)(m + sc_off + c), sh = *(const f32x4*)(m + sh_off + c);
            const f32x4 y = v * (sc + 1.f) + sh; o8[64 * j] = (unsigned long long)pk2(y.x, y.y) | ((unsigned long long)pk2(y.z, y.w) << 32); }
    }
}
__device__ __forceinline__ void phase_ln(Frame& F, float* xlat, float* xctx, const float* g, const float* bta, const float* modl, int sh_off, int sc_off, bf16* H, int nrows) {
    const int gw = F.vcu * NWAVES + F.wave, NGW = F.G * NWAVES;
    for (int row = gw; row < nrows; row += NGW) {
        float* xr = row < NLAT ? xlat + (size_t)row * DM : xctx + (size_t)(row - NLAT) * DM;
        f32x4 v[4]; float s = 0.f;
#pragma unroll
        for (int j = 0; j < 4; ++j) { v[j] = *(const f32x4*)(xr + 4 * F.lane + 256 * j); s += (v[j].x + v[j].y) + (v[j].z + v[j].w); }
        const float mean = wave_sum(s, F.lane) * (1.f / DM); float q = 0.f;
#pragma unroll
        for (int j = 0; j < 4; ++j) { v[j] = v[j] - mean; q += (v[j].x * v[j].x + v[j].y * v[j].y) + (v[j].z * v[j].z + v[j].w * v[j].w); }
        const float rstd = __builtin_amdgcn_rsqf(wave_sum(q, F.lane) * (1.f / DM) + LN_EPS);
        const float* m = modl ? modl + (size_t)(row < NLAT ? row / SEQ : 4) * 6144 : nullptr;
        GAS unsigned long long* o8 = (GAS unsigned long long*)(H + (size_t)row * DM) + F.lane;
#pragma unroll
        for (int j = 0; j < 4; ++j) { const int c = 4 * F.lane + 256 * j; const f32x4 y = v[j] * rstd * *(const f32x4*)(g + c) + *(const f32x4*)(bta + c);
            *(f32x4*)(xr + c) = y;
            if (modl) { const f32x4 z = y * (*(const f32x4*)(m + sc_off + c) + 1.f) + *(const f32x4*)(m + sh_off + c); o8[64 * j] = (unsigned long long)pk2(z.x, z.y) | ((unsigned long long)pk2(z.z, z.w) << 32); } }
    }
}

__global__ void __launch_bounds__(NWAVES * 64, 2) mk_fwd(MkArgs args_k) {
    extern __shared__ __attribute__((aligned(16))) unsigned char lds[];
    Frame F;
    F.lds = (LAS unsigned char*)lds; F.MISC = (volatile LAS unsigned*)(F.lds + MISC_OFF);
    F.tid = threadIdx.x; F.lane = F.tid & 63; F.wave = __builtin_amdgcn_readfirstlane(F.tid >> 6);
    const int wave0 = F.wave;
    F.G = gridDim.x; { const int bx = blockIdx.x; F.vcu = (F.G % 8 == 0) ? (bx % 8) * (F.G / 8) + bx / 8 : bx; }
    F.ctl = (gu32*)(args_k.ws + WS_CTL);
    for (int u = F.tid; u < (LDS_BYTES - LDSCTL_OFF) / 4; u += NWAVES * 64) ((LAS unsigned*)(F.lds + LDSCTL_OFF))[u] = 0u;
    __syncthreads();
    XcdBarrier bar = xcd_barrier_post((unsigned*)(F.ctl + CW_BAR), F.MISC + 8);
    const int lo = args_k.ph_lo, hi = args_k.ph_hi;
    if (lo == 0 && PHM(PH_PRO)) {
        unsigned char* ws0 = (unsigned char*)(GAS unsigned char*)args_k.ws;
        phase_pro(F, *(const __attribute__((address_space(4))) MkArgs*)__builtin_amdgcn_kernarg_segment_ptr(), (float*)(ws0 + WS_MOD), (float*)(ws0 + WS_ROPE));
        if (hi > 1) xcd_barrier(bar, F.tid);
    }
#if defined(PROBE_GP)
    for (int gpe = lo; gpe < hi + PROBE_N; ++gpe) {
      const int gp = gpe <= PROBE_GP ? gpe : (gpe <= PROBE_GP + PROBE_N ? PROBE_GP : gpe - PROBE_N); const int rep_ = (gpe > PROBE_GP && gpe <= PROBE_GP + PROBE_N) ? 1 : 0;
#else
    for (int gp = lo; gp < hi; ++gp) {
      const int rep_ = 0;
#endif
      if (gp % PH_COUNT == PH_PRO || (gp >= PH_COUNT && gp % PH_COUNT == PH_W)) continue;
      {
        const int l = gp / PH_COUNT, ph = gp % PH_COUNT;
        unsigned long long kpi_ = (unsigned long long)__builtin_amdgcn_kernarg_segment_ptr(); asm volatile("" : "+s"(kpi_));
        KArgs args = *(const __attribute__((address_space(4))) MkArgs*)kpi_;
        unsigned long long wsi_ = (unsigned long long)args.ws; asm volatile("" : "+s"(wsi_)); unsigned char* ws = (unsigned char*)(GAS unsigned char*)wsi_;
        float* mod = (float*)(ws + WS_MOD); float* rope = (float*)(ws + WS_ROPE); float* ctxs = (float*)(ws + WS_CTXS);
        bf16* H = (bf16*)(ws + WS_H); bf16* Y = (bf16*)(ws + WS_Y); bf16* KA = (bf16*)(ws + WS_KA); bf16* VA = (bf16*)(ws + WS_VA); bf16* KB = (bf16*)(ws + WS_KB); bf16* VB = (bf16*)(ws + WS_VB);
        bf16* XR = (bf16*)(ws + WS_XR); bf16* G = (bf16*)(ws + WS_G); bf16* HID = (bf16*)(ws + WS_HID);
        bf16* wb = (bf16*)(ws + WS_W);
        { const int t_ = tid_from_wave(wave0); F.tid = t_; F.lane = t_ & 63; F.wave = __builtin_amdgcn_readfirstlane(t_ >> 6);
          int g_ = gridDim.x, b_ = blockIdx.x; asm volatile("" : "+s"(g_), "+s"(b_)); F.G = g_; F.vcu = (g_ % 8 == 0) ? (b_ % 8) * (g_ / 8) + b_ / 8 : b_; F.bid = b_; }
        const float* modl = mod + (size_t)l * 5 * 6144;
        const int MR = NLAT;
        const bool ctx_on = (l + 1 < DEPTH);
        const int LNR = ctx_on ? NROW : NLAT;
        if (PHM(PH_W) && ph == PH_W) { phase_weights(F, args, l); if (l == 0) phase_modulate(F, args.in[0], args.in[2], modl, 0, 1024, H); }
        else if ((PHM(PH_MIX1) && ph == PH_MIX1) || (PHM(PH_MIX2) && ph == PH_MIX2)) {
            lru::Params LP{XR, args.in[10] + (size_t)l * 4 * DM, args.in[11] + (size_t)l * DM, wb + WO_LRU / 2, args.in[13] + (size_t)l * 2 * DM, args.in[15] + (size_t)l * 2 * DM, (const float*)(ws + WS_LRUC), (float*)(ws + WS_AGG), Y};
            LAS lru::f32x4* hfl = (LAS lru::f32x4*)(F.lds + RING_OFF + F.wave * 8192);
            if (ph == PH_MIX1) lru::phase<1>(LP, F.vcu * NWAVES + F.wave, F.G * NWAVES, F.lane, hfl, false); else lru::phase<2>(LP, F.vcu * NWAVES + F.wave, F.G * NWAVES, F.lane, hfl, l + 1 == DEPTH);
            __syncthreads();
            const float* sink = args.in[7] + l * 8;
            if (ATTN_ON && rep_ == 0) {
            if (ph == PH_MIX1) { attn_latent<0>((char*)lds, Y, KA, VA, F.vcu, F.G, sink, F.tid); if (l == 0) { attn_context<0>((char*)lds, Y, KA, VA, F.vcu, F.G, sink, F.tid); attn_context<1>((char*)lds, Y, KB, VB, F.vcu, F.G, sink, F.tid); } }
            else attn_latent<1>((char*)lds, Y, KB, VB, F.vcu, F.G, sink, F.tid);
            }
        }
        else if (PHM(PH_LN1) && ph == PH_LN1) phase_ln(F, args.out, ctxs, args.in[21] + l * DM, args.in[22] + l * DM, modl, 3072, 4096, H, LNR);
        else if (PHM(PH_LN2) && ph == PH_LN2) { phase_ln(F, args.out, ctxs, args.in[25] + l * DM, args.in[26] + l * DM, l + 1 < DEPTH ? modl + 5 * 6144 : nullptr, 0, 1024, H, LNR); if (l + 1 < DEPTH) phase_weights(F, args, l + 1); }
        else if (PHM(PH_G1A) && ph == PH_G1A) {
            pg8::Gemm g{H, wb + WO_IN / 2, NROW, 3584, DM}; pg8::StaticOrder S; S.init(NROW, 3584, F.G, F.bid);
            pg8::EpiG1 E{Y, KA, VA, KB, VB, XR, G, rope, args.in[8] + l * 64, args.in[9] + l * 64, 0, 0};
            pg8::gemm_phase<pg8::EpiG1, pg8::StaticOrder, PG8_ALIGN, PG8_SP2>(F.lds + RING_OFF, g, S, E, F.tid);
        } else if (PHM(PH_G1B) && ph == PH_G1B) {
            pg8::Gemm g{H, wb + WO_IN / 2 + (size_t)3584 * DM, MR, 3072, DM}; pg8::StaticOrder S; S.init(MR, 3072, F.G, F.bid);
            pg8::EpiG1 E{Y, KA, VA, KB, VB, XR, G, rope, args.in[8] + l * 64, args.in[9] + l * 64, 14, 0};
            pg8::gemm_phase<pg8::EpiG1, pg8::StaticOrder, PG8_ALIGN, PG8_SP2>(F.lds + RING_OFF, g, S, E, F.tid);
            if (ctx_on) cg::gemm_ctx<2, false>(F.lds + RING_OFF, H + (size_t)NLAT * DM, DM, wb + WO_IN / 2 + (size_t)3584 * DM, DM, 3072, DM, F.vcu, F.G, G + (size_t)NLAT * 3072, 3072, nullptr, nullptr, nullptr, F.tid);
        } else if (PHM(PH_MERGE) && ph == PH_MERGE) {
            pg8::Gemm g{Y, wb + WO_MERGE / 2, MR, DM, YC}; pg8::StaticOrder S; S.init(MR, DM, F.G, F.bid);
            pg8::EpiMerge E{G, H};
            pg8::gemm_phase<pg8::EpiMerge, pg8::StaticOrder, PG8_ALIGN, PG8_SP2>(F.lds + RING_OFF, g, S, E, F.tid);
            if (ctx_on) cg::merge_ctx(F.lds + RING_OFF, Y + (size_t)NLAT * YC, wb + WO_MERGE / 2, G + (size_t)NLAT * 3072, H + (size_t)NLAT * DM, F.vcu, F.G, F.tid);
        } else if (PHM(PH_OUT) && ph == PH_OUT) {
            pg8::Gemm g{H, wb + WO_OUT / 2, MR, DM, DM}; pg8::StaticOrder S; S.init(MR, DM, F.G, F.bid);
            pg8::EpiResid E{l == 0 ? args.in[0] : args.out, l == 0 ? args.in[2] : ctxs, args.out, ctxs, modl, 2048, 0};
            pg8::gemm_phase<pg8::EpiResid, pg8::StaticOrder, PG8_ALIGN, PG8_SP2>(F.lds + RING_OFF, g, S, E, F.tid);
            if (ctx_on) cg::gemm_ctx<0, true>(F.lds + RING_OFF, H + (size_t)NLAT * DM, DM, wb + WO_OUT / 2, DM, DM, DM, F.vcu, F.G, nullptr, 0, l == 0 ? args.in[2] : ctxs, ctxs, modl + 4 * 6144 + 2048, F.tid);
        } else if (PHM(PH_FF1) && ph == PH_FF1) {
            pg8::Gemm g{H, wb + WO_FF1 / 2, MR, DFF, DM}; pg8::StaticOrder S; S.init(MR, DFF, F.G, F.bid);
            pg8::EpiNat8<3> E{HID, DFF};
            pg8::gemm_phase<pg8::EpiNat8<3>, pg8::StaticOrder, PG8_ALIGN, PG8_SP2>(F.lds + RING_OFF, g, S, E, F.tid);
            if (ctx_on) cg::gemm_ctx<3, false>(F.lds + RING_OFF, H + (size_t)NLAT * DM, DM, wb + WO_FF1 / 2, DM, DFF, DM, F.vcu, F.G, HID + (size_t)NLAT * DFF, DFF, nullptr, nullptr, nullptr, F.tid);
        } else if (PHM(PH_FF2) && ph == PH_FF2) {
            pg8::Gemm g{HID, wb + WO_FF2 / 2, MR, DM, DFF}; pg8::StaticOrder S; S.init(MR, DM, F.G, F.bid);
            pg8::EpiResid E{args.out, ctxs, args.out, ctxs, modl, 5120, 0};
            pg8::gemm_phase<pg8::EpiResid, pg8::StaticOrder, PG8_ALIGN, PG8_SP2>(F.lds + RING_OFF, g, S, E, F.tid);
            if (ctx_on) cg::gemm_ctx<0, true>(F.lds + RING_OFF, HID + (size_t)NLAT * DFF, DFF, wb + WO_FF2 / 2, DFF, DM, DFF, F.vcu, F.G, nullptr, 0, ctxs, ctxs, modl + 4 * 6144 + 5120, F.tid);
        }
        if (gp + 1 < hi) xcd_barrier(bar, F.tid);
      }
    }
}

static void launch_mk(const MkArgs& base, int l, int ph, int grid, hipStream_t stream) {
    MkArgs a = base; a.ph_lo = l * PH_COUNT + ph; a.ph_hi = a.ph_lo + 1; a.layer = l;
    hipLaunchKernelGGL(mk_fwd, dim3(grid), dim3(NWAVES * 64), LDS_BYTES, stream, a);
}
extern "C" void kernel_launch(void* const* d_in, const int* in_sizes, int n_in, void* d_out, int out_size, void* d_ws, size_t ws_size, hipStream_t stream) {
    if (n_in != 27 || ws_size < WS_END) { fprintf(stderr, "kernel_launch: unexpected n_in %d / ws_size %zu\n", n_in, ws_size); return; }
    static int grid = 0;
    if (grid == 0) {
        int dev = 0, cus = 0;
        if (hipGetDevice(&dev) != hipSuccess || hipDeviceGetAttribute(&cus, hipDeviceAttributeMultiprocessorCount, dev) != hipSuccess) { grid = -1; return; }
        if (hipFuncSetAttribute((const void*)mk_fwd, hipFuncAttributeMaxDynamicSharedMemorySize, LDS_BYTES) != hipSuccess) { fprintf(stderr, "hipFuncSetAttribute failed\n"); grid = -1; return; }
        grid = cus;
    }
    if (grid < 0) return;
    char* ws = (char*)d_ws; float* out = (float*)d_out;
    MkArgs base; memset(&base, 0, sizeof(base));
    for (int i = 0; i < 27; ++i) base.in[i] = (const float*)d_in[i];
    base.out = out; base.ws = (unsigned char*)d_ws;

    hipMemsetAsync(ws + WS_CTL, 0, CTL_ZERO_BYTES, stream);
#if defined(MK_MULTI)
    launch_mk(base, 0, PH_PRO, grid, stream); launch_mk(base, 0, PH_W, grid, stream);
    for (int l = 0; l < DEPTH; ++l) for (int ph = PH_G1A; ph < PH_COUNT; ++ph) launch_mk(base, l, ph, grid, stream);
#else
    { MkArgs a = base; a.ph_lo = 0; a.ph_hi = DEPTH * PH_COUNT; a.layer = 0; hipLaunchKernelGGL(mk_fwd, dim3(grid), dim3(NWAVES * 64), LDS_BYTES, stream, a); }
#endif
}
```
